# Optimizing an MI355X kernel written in HIP

```python
import jax, jax.numpy as jnp
from jax import lax
import numpy as np

D_MODEL = 1024
BATCH = 16
SEQ = 2048
DEPTH = 1
DEC_BATCH = 32
DEC_SEQ = 64
PAST_LEN = 4096

CHUNK = 64
GDN_HEADS = 8
GDN_DK = 128
GDN_DV = 128
GDN_QK_DIM = GDN_HEADS * GDN_DK
GDN_V_DIM = GDN_HEADS * GDN_DV
GDN_CONV_DIM = 2 * GDN_QK_DIM + GDN_V_DIM
CONV_W = 4
SWA_HQ = 16
SWA_HKV = 4
SWA_HD = 64
SWA_GROUP = SWA_HQ // SWA_HKV
WINDOW = 128
WIN_CHUNKS = WINDOW // CHUNK
D_FF = 2816
N_MOD = 9
EPS = 1e-6
IN_SIZES = (GDN_CONV_DIM, GDN_V_DIM, GDN_HEADS, GDN_HEADS, SWA_HQ * SWA_HD, SWA_HKV * SWA_HD, SWA_HKV * SWA_HD, 2 * D_MODEL)
IN_DIM = GDN_CONV_DIM + GDN_V_DIM + 2 * GDN_HEADS + SWA_HQ * SWA_HD + 2 * SWA_HKV * SWA_HD + 2 * D_MODEL

kernel_name = 'streaming_gdn_swa_macaron_adaln'


def rms_norm(x, gain):
    xf = x.astype(jnp.float32)
    y = xf * lax.rsqrt(jnp.mean(xf * xf, axis=-1, keepdims=True) + EPS)
    return (y * gain.astype(jnp.float32)).astype(x.dtype)


def l2_norm(x):
    xf = x.astype(jnp.float32)
    return xf * lax.rsqrt(jnp.sum(xf * xf, axis=-1, keepdims=True) + EPS)


def modulate(x, gain, shift, scale):
    return rms_norm(x, gain) * (1 + scale) + shift


def swiglu(h, w_in, w_out):
    gate, up = jnp.split(h @ w_in, 2, axis=-1)
    return (jax.nn.silu(gate) * up) @ w_out


def causal_conv(x, prefix, w):
    T = x.shape[1]
    xp = jnp.concatenate([prefix.astype(x.dtype), x], axis=1)
    y = xp[:, 0:T] * w[0]
    for i in range(1, CONV_W):
        y = y + xp[:, i:i + T] * w[i]
    return jax.nn.silu(y), xp[:, -(CONV_W - 1):]


def gated_delta_chunked(q, k, v, g, beta, S0):
    B, T, H, DK = q.shape
    DV = v.shape[-1]
    L = min(CHUNK, T)
    NC = T // L

    def blk(a):
        a = a.reshape((B, NC, L, H) + a.shape[3:])
        return jnp.moveaxis(a, 3, 1)

    q, k, v, g, beta = blk(q), blk(k), blk(v), blk(g), blk(beta)
    G = jnp.cumsum(g, axis=-1)
    incl = jnp.tril(jnp.ones((L, L), bool))
    strict = jnp.tril(jnp.ones((L, L), bool), -1)
    gamma = jnp.exp(jnp.where(incl, G[..., :, None] - G[..., None, :], -jnp.inf))
    kk = jnp.einsum('bhcid,bhcjd->bhcij', k, k)
    A = jnp.eye(L, dtype=jnp.float32) + jnp.where(strict, beta[..., :, None] * kk * gamma, 0.0)
    rhs = jnp.concatenate([v * beta[..., None], k * (beta * jnp.exp(G))[..., None]], axis=-1)
    X = lax.linalg.triangular_solve(A, rhs, left_side=True, lower=True, unit_diagonal=True)
    u, w = X[..., :DV], X[..., DV:]
    qk = jnp.einsum('bhcid,bhcjd->bhcij', q, k) * gamma
    q_dec = q * jnp.exp(G)[..., None]
    k_dec = k * jnp.exp(G[..., -1:] - G)[..., None]
    d_last = jnp.exp(G[..., -1])

    def step(S, xs):
        u_c, w_c, qk_c, qd_c, kd_c, dl_c = xs
        v_new = u_c - jnp.einsum('bhid,bhde->bhie', w_c, S)
        o = jnp.einsum('bhid,bhde->bhie', qd_c, S) + jnp.einsum('bhij,bhje->bhie', qk_c, v_new)
        S = dl_c[..., None, None] * S + jnp.einsum('bhid,bhie->bhde', kd_c, v_new)
        return S, o

    xs = tuple(jnp.moveaxis(a, 2, 0) for a in (u, w, qk, q_dec, k_dec, d_last))
    S, o = lax.scan(step, S0, xs)
    o = jnp.moveaxis(o, 0, 2).reshape(B, H, T, DV)
    return jnp.transpose(o, (0, 2, 1, 3)), S


def sink_attention(q, k, v, mask, sinks):
    s = jnp.einsum('bclkgd,bcskd->bckgls', q, k, preferred_element_type=jnp.float32) * (SWA_HD ** -0.5)
    s = jnp.where(mask[None, :, None, None], s, -jnp.inf)
    sink = sinks.astype(jnp.float32).reshape(SWA_HKV, SWA_GROUP)[None, None, :, :, None, None]
    m = jnp.maximum(jnp.max(s, axis=-1, keepdims=True), sink)
    p = jnp.exp(s - m)
    p = p / (jnp.sum(p, axis=-1, keepdims=True) + jnp.exp(sink - m))
    return jnp.einsum('bckgls,bcskd->bclkgd', p.astype(v.dtype), v)


def swa_prompt(q, k, v, sinks):
    B, T = q.shape[:2]
    NC = T // CHUNK
    qb = q.reshape(B, NC, CHUNK, SWA_HKV, SWA_GROUP, SWA_HD)

    def band(a):
        pad = jnp.zeros((B, WINDOW) + a.shape[2:], a.dtype)
        ac = jnp.concatenate([pad, a], axis=1).reshape((B, NC + WIN_CHUNKS, CHUNK) + a.shape[2:])
        return jnp.concatenate([ac[:, j:j + NC] for j in range(WIN_CHUNKS + 1)], axis=2)

    key_chunk = jnp.arange(NC)[:, None] - WIN_CHUNKS + jnp.arange(WIN_CHUNKS + 1)[None, :]
    valid = jnp.repeat(key_chunk >= 0, CHUNK, axis=1)
    o = sink_attention(qb, band(k), band(v), valid[:, None, :], sinks)
    return o.reshape(B, T, SWA_HQ * SWA_HD)


def swa_sample(q, k, v, k_cache, v_cache, sinks):
    B, T = q.shape[:2]
    kf = jnp.concatenate([k_cache.astype(k.dtype), k], axis=1)
    vf = jnp.concatenate([v_cache.astype(v.dtype), v], axis=1)
    qb = q.reshape(B, 1, T, SWA_HKV, SWA_GROUP, SWA_HD)
    mask = jnp.ones((1, 1, WINDOW + T), bool)
    o = sink_attention(qb, kf[:, None], vf[:, None], mask, sinks)
    return o.reshape(B, T, SWA_HQ * SWA_HD), kf[:, -WINDOW:], vf[:, -WINDOW:]


def trunk_layer(x, c, conv_prefix, S0, k_cache, v_cache, lp, is_prompt):
    (w_ada, b_ada, norm_ffn1, ffn1_w_in, ffn1_w_out, norm_mix, w_in, gdn_conv_w,
     gdn_a_log, gdn_dt_bias, gdn_norm, swa_q_norm, swa_k_norm, swa_sinks, b_merge,
     w_out, norm_ffn2, ffn2_w_in, ffn2_w_out) = lp
    B, T, _ = x.shape
    mod = (jax.nn.silu(c) @ w_ada + b_ada)[:, None, :]
    sh1, sc1, gt1, sh2, sc2, gt2, sh3, sc3, gt3 = jnp.split(mod, N_MOD, axis=-1)

    x = x + 0.5 * gt1 * swiglu(modulate(x, norm_ffn1, sh1, sc1), ffn1_w_in, ffn1_w_out)

    h = modulate(x, norm_mix, sh2, sc2)
    offsets = [int(o) for o in np.cumsum(IN_SIZES)[:-1]]
    conv_in, z, a, b, q_s, k_s, v_s, gate_logits = jnp.split(h @ w_in, offsets, axis=-1)

    conv_out, new_conv = causal_conv(conv_in, conv_prefix, gdn_conv_w)
    qg, kg, vg = jnp.split(conv_out, [GDN_QK_DIM, 2 * GDN_QK_DIM], axis=-1)
    qg = l2_norm(qg.reshape(B, T, GDN_HEADS, GDN_DK)) * (GDN_DK ** -0.5)
    kg = l2_norm(kg.reshape(B, T, GDN_HEADS, GDN_DK))
    vg = vg.reshape(B, T, GDN_HEADS, GDN_DV).astype(jnp.float32)
    g = -jnp.exp(gdn_a_log.astype(jnp.float32)) * jax.nn.softplus(a.astype(jnp.float32) + gdn_dt_bias.astype(jnp.float32))
    beta = jax.nn.sigmoid(b.astype(jnp.float32))
    o_g, new_S = gated_delta_chunked(qg, kg, vg, g, beta, S0.astype(jnp.float32))
    o_g = rms_norm(o_g, gdn_norm).astype(x.dtype).reshape(B, T, GDN_V_DIM) * jax.nn.silu(z)

    q_s = rms_norm(q_s.reshape(B, T, SWA_HQ, SWA_HD), swa_q_norm)
    k_s = rms_norm(k_s.reshape(B, T, SWA_HKV, SWA_HD), swa_k_norm)
    v_s = v_s.reshape(B, T, SWA_HKV, SWA_HD)
    if is_prompt:
        o_s = swa_prompt(q_s, k_s, v_s, swa_sinks)
        new_k, new_v = k_s[:, -WINDOW:], v_s[:, -WINDOW:]
    else:
        o_s, new_k, new_v = swa_sample(q_s, k_s, v_s, k_cache, v_cache, swa_sinks)

    g_a, g_b = jnp.split(jax.nn.sigmoid(gate_logits + b_merge), 2, axis=-1)
    x = x + gt2 * ((g_a * o_g + g_b * o_s) @ w_out)

    x = x + 0.5 * gt3 * swiglu(modulate(x, norm_ffn2, sh3, sc3), ffn2_w_in, ffn2_w_out)
    return x, new_conv, new_S, new_k, new_v


def setup_inputs(seed: int = 0) -> dict:
    key = jax.random.key(seed)
    ks = jax.random.split(key, 32)

    def nrm(k, shape, s):
        return jax.random.normal(k, shape, jnp.float32) * s

    dt = jnp.exp(jax.random.uniform(ks[17], (DEPTH, GDN_HEADS), jnp.float32, np.log(1e-3), np.log(1e-1)))
    return {
        'x_prompt': nrm(ks[0], (BATCH, SEQ, D_MODEL), 1.0),
        'x_sample': nrm(ks[1], (DEC_BATCH, DEC_SEQ, D_MODEL), 1.0),
        'state_gdn_conv': nrm(ks[2], (DEPTH, DEC_BATCH, CONV_W - 1, GDN_CONV_DIM), 1.0),
        'state_gdn': nrm(ks[3], (DEPTH, DEC_BATCH, GDN_HEADS, GDN_DK, GDN_DV), 0.1),
        'cache_swa_k': nrm(ks[4], (DEPTH, DEC_BATCH, WINDOW, SWA_HKV, SWA_HD), 1.0),
        'cache_swa_v': nrm(ks[5], (DEPTH, DEC_BATCH, WINDOW, SWA_HKV, SWA_HD), 1.0),
        'c_prompt': nrm(ks[6], (BATCH, D_MODEL), 1.0),
        'c_sample': nrm(ks[7], (DEC_BATCH, D_MODEL), 1.0),
        'w_ada': nrm(ks[8], (DEPTH, D_MODEL, N_MOD * D_MODEL), 0.3 * D_MODEL ** -0.5),
        'b_ada': nrm(ks[9], (DEPTH, N_MOD * D_MODEL), 0.01),
        'norm_ffn1': 1.0 + nrm(ks[10], (DEPTH, D_MODEL), 0.01),
        'ffn1_w_in': nrm(ks[11], (DEPTH, D_MODEL, 2 * D_FF), D_MODEL ** -0.5),
        'ffn1_w_out': nrm(ks[12], (DEPTH, D_FF, D_MODEL), D_FF ** -0.5),
        'norm_mix': 1.0 + nrm(ks[13], (DEPTH, D_MODEL), 0.01),
        'w_in': nrm(ks[14], (DEPTH, D_MODEL, IN_DIM), D_MODEL ** -0.5),
        'gdn_conv_w': nrm(ks[15], (DEPTH, CONV_W, GDN_CONV_DIM), CONV_W ** -0.5),
        'gdn_a_log': jnp.log(jax.random.uniform(ks[16], (DEPTH, GDN_HEADS), jnp.float32, 1.0, 16.0)),
        'gdn_dt_bias': dt + jnp.log(-jnp.expm1(-dt)),
        'gdn_norm': 1.0 + nrm(ks[18], (DEPTH, GDN_DV), 0.01),
        'swa_q_norm': 1.0 + nrm(ks[19], (DEPTH, SWA_HD), 0.01),
        'swa_k_norm': 1.0 + nrm(ks[20], (DEPTH, SWA_HD), 0.01),
        'swa_sinks': nrm(ks[21], (DEPTH, SWA_HQ), 0.5),
        'b_merge': nrm(ks[22], (DEPTH, 2 * D_MODEL), 0.01),
        'w_out': nrm(ks[23], (DEPTH, D_MODEL, D_MODEL), D_MODEL ** -0.5),
        'norm_ffn2': 1.0 + nrm(ks[24], (DEPTH, D_MODEL), 0.01),
        'ffn2_w_in': nrm(ks[25], (DEPTH, D_MODEL, 2 * D_FF), D_MODEL ** -0.5),
        'ffn2_w_out': nrm(ks[26], (DEPTH, D_FF, D_MODEL), D_FF ** -0.5),
    }


def reference(x_prompt, x_sample, state_gdn_conv, state_gdn, cache_swa_k, cache_swa_v, c_prompt, c_sample,
              w_ada, b_ada, norm_ffn1, ffn1_w_in, ffn1_w_out, norm_mix, w_in, gdn_conv_w, gdn_a_log,
              gdn_dt_bias, gdn_norm, swa_q_norm, swa_k_norm, swa_sinks, b_merge, w_out, norm_ffn2,
              ffn2_w_in, ffn2_w_out):
    yp, ys = x_prompt, x_sample
    conv_p, gdn_p, k_p, v_p = [], [], [], []
    conv_s, gdn_s, k_s, v_s = [], [], [], []
    for l in range(DEPTH):
        lp = (w_ada[l], b_ada[l], norm_ffn1[l], ffn1_w_in[l], ffn1_w_out[l], norm_mix[l], w_in[l],
              gdn_conv_w[l], gdn_a_log[l], gdn_dt_bias[l], gdn_norm[l], swa_q_norm[l], swa_k_norm[l],
              swa_sinks[l], b_merge[l], w_out[l], norm_ffn2[l], ffn2_w_in[l], ffn2_w_out[l])
        zero_conv = jnp.zeros((yp.shape[0], CONV_W - 1, GDN_CONV_DIM), yp.dtype)
        zero_S = jnp.zeros((yp.shape[0], GDN_HEADS, GDN_DK, GDN_DV), jnp.float32)
        yp, cp, sp, kp, vp = trunk_layer(yp, c_prompt, zero_conv, zero_S, None, None, lp, True)
        ys, cs, ss, kss, vss = trunk_layer(ys, c_sample, state_gdn_conv[l], state_gdn[l],
                                           cache_swa_k[l], cache_swa_v[l], lp, False)
        conv_p.append(cp); gdn_p.append(sp); k_p.append(kp); v_p.append(vp)
        conv_s.append(cs); gdn_s.append(ss); k_s.append(kss); v_s.append(vss)
    return (yp, ys,
            jnp.stack(conv_p), jnp.stack(gdn_p), jnp.stack(k_p), jnp.stack(v_p),
            jnp.stack(conv_s), jnp.stack(gdn_s), jnp.stack(k_s), jnp.stack(v_s))
```

```cpp
#include <hip/hip_runtime.h>
#include <hip/hip_cooperative_groups.h>
#include <cstdio>
#include <cstdint>
namespace cg = cooperative_groups;
namespace pg8 {
#define PG8_LAS __attribute__((address_space(3)))
typedef unsigned short bf16_t;
typedef short bf16x8 __attribute__((ext_vector_type(8)));
typedef float f32x4 __attribute__((ext_vector_type(4)));
typedef unsigned u32x4 __attribute__((ext_vector_type(4)));
constexpr int BM = 256, BK = 64, HALF = 128, HTB = HALF * BK * 2  , STAGE_BYTES = 8 * HTB, NXCD = 8, WGM = 8;

__host__ __device__ __forceinline__ int lds_byte(int r, int c) { const int st = (r >> 4) * 2 + (c >> 5), rr = r & 15, cc = c & 31, ob = rr * 64 + cc * 2; return st * 1024 + (ob ^ (((ob >> 9) & 1) << 5)); }
__host__ __device__ __forceinline__ void stage_rc(int b, int& R, int& C) { const int st = b / 1024, sb = b % 1024, swz = sb ^ (((sb >> 9) & 1) << 5); R = (st >> 1) * 16 + swz / 64; C = (st & 1) * 32 + (swz % 64) / 2; }
__host__ __device__ __forceinline__ int perm32(int rho) { const int n = rho >> 4, i = rho & 15; return 8 * (i >> 2) + 4 * n + (i & 3); }

struct Unit { int pm, pn; };
struct Gemm { const bf16_t* A; const bf16_t* Bt; int M, N, K; };

struct StaticOrder {
    int nM, nN, nwg, G, c;
    __host__ __device__ void init(int M, int N, int G_, int c_) { nM = M / BM; nN = N / BM; nwg = nM * nN; G = G_; c = c_; }
    __host__ __device__ bool next(int i, Unit& u) const {
        const long L = (long)i * G + c; if (L >= nwg) return false;
        int wgid = (int)L; { const int q = nwg / NXCD, r = nwg % NXCD, xcd = wgid % NXCD, off = wgid / NXCD; wgid = (xcd < r ? xcd * (q + 1) : r * (q + 1) + (xcd - r) * q) + off; }
        const int nig = WGM * nN, gid = wgid / nig, fm = gid * WGM, gsz = (nM - fm) < WGM ? (nM - fm) : WGM;
        u.pm = fm + ((wgid % nig) % gsz); u.pn = (wgid % nig) / gsz; return true;
    }
    __device__ __forceinline__ void a_ready(const Unit&) const {}
    __device__ __forceinline__ void done(const Unit&) const {}
};

__device__ __forceinline__ unsigned cvt_pk_bf16(float lo, float hi) { unsigned r; asm volatile("v_cvt_pk_bf16_f32 %0, %1, %2" : "=v"(r) : "v"(lo), "v"(hi)); return r; }
typedef float f32x2 __attribute__((ext_vector_type(2)));
template <class Epi, class Sched, bool ALIGN_EPI = false, bool SP2 = false>
__device__ __forceinline__ void gemm_phase(PG8_LAS unsigned char* lds, const Gemm g, const Sched& S, const Epi& E, const int tid_in) {
    const int tid = tid_in, wid = __builtin_amdgcn_readfirstlane(tid >> 6), lane = tid & 63, wr = wid >> 2, wc = wid & 3, fr = lane & 15, fq = lane >> 4;
    const int K = g.K, nt = K / BK;
    unsigned voffA[2], voffB[2];
#pragma unroll
    for (int i = 0; i < 2; ++i) { int R, C; stage_rc(tid * 16 + i * 8192, R, C); const int Rb = Epi::PERM ? ((R & ~31) + perm32(R & 31)) : R;
        voffA[i] = (unsigned)(R * K + C) * 2u; voffB[i] = (unsigned)(Rb * K + C) * 2u; }
    const size_t kstep = (size_t)(BK * 2);
    const size_t hstep = (size_t)HALF * K * 2;
    const size_t tstep = 2 * hstep;
    const unsigned ldsw = (unsigned)wid * 1024u;
    const int aoff = lds_byte(wr * 64 + fr, fq * 8), boff = lds_byte(wc * 32 + fr, fq * 8);
#define PG8_SA(b, h) (((b) * 2 + (h)) * HTB)
#define PG8_SB(b, h) ((4 + (b) * 2 + (h)) * HTB)
#define PG8_STAGE(bufoff, gbase, voff) do { _Pragma("unroll") for (int _i = 0; _i < 2; ++_i) \
        __builtin_amdgcn_global_load_lds((const unsigned*)((const char*)(gbase) + (voff)[_i]), (PG8_LAS unsigned*)(lds + (bufoff) + ldsw + _i * 8192), 16, 0, 0); } while (0)
#define PG8_LDA(dst, b, h) do { _Pragma("unroll") for (int m = 0; m < 4; ++m) _Pragma("unroll") for (int k = 0; k < 2; ++k) dst[m][k] = *(const PG8_LAS bf16x8*)(lds + PG8_SA(b, h) + aoff + m * 2048 + k * 1024); } while (0)
#define PG8_LDB(dst, b, h) do { _Pragma("unroll") for (int n = 0; n < 2; ++n) _Pragma("unroll") for (int k = 0; k < 2; ++k) dst[n][k] = *(const PG8_LAS bf16x8*)(lds + PG8_SB(b, h) + boff + n * 2048 + k * 1024); } while (0)
#define PG8_MMA(ai, bj, At, Bt) do { __builtin_amdgcn_s_setprio(1); _Pragma("unroll") for (int m = 0; m < 4; ++m) _Pragma("unroll") for (int n = 0; n < 2; ++n) _Pragma("unroll") for (int k = 0; k < 2; ++k) \
        acc[ai][bj][m][n] = __builtin_amdgcn_mfma_f32_16x16x32_bf16(Bt[n][k], At[m][k], acc[ai][bj][m][n], 0, 0, 0); __builtin_amdgcn_s_setprio(0); } while (0)
#define PG8_WAIT_V(n) asm volatile("s_waitcnt vmcnt(" #n ")" ::: "memory")
#define PG8_WAIT_L(n) asm volatile("s_waitcnt lgkmcnt(" #n ")" ::: "memory")
#define PG8_BAR __builtin_amdgcn_s_barrier()
#define PG8_SCHED __builtin_amdgcn_sched_barrier(0)
    Unit cur, nxt; int ui = 0;
    if (!S.next(0, cur)) return;
    f32x4 acc[2][2][4][2];
#pragma unroll
    for (int a = 0; a < 2; ++a)
#pragma unroll
        for (int b = 0; b < 2; ++b)
#pragma unroll
            for (int m = 0; m < 4; ++m)
#pragma unroll
                for (int n = 0; n < 2; ++n) acc[a][b][m][n] = (f32x4){0.f, 0.f, 0.f, 0.f};
    bf16x8 At[4][2], B0[2][2], B1[2][2];
    const char* cA = (const char*)g.A + (size_t)cur.pm * tstep; const char* cB = (const char*)g.Bt + (size_t)cur.pn * tstep;
    S.a_ready(cur);
    if constexpr (SP2) {
        PG8_STAGE(PG8_SB(0, 0), cB, voffB); PG8_STAGE(PG8_SB(0, 1), cB + hstep, voffB); PG8_STAGE(PG8_SA(0, 0), cA, voffA); PG8_STAGE(PG8_SA(0, 1), cA + hstep, voffA);
        if (wr == 1) PG8_BAR;
        PG8_WAIT_V(2); PG8_BAR;
        PG8_STAGE(PG8_SB(1, 0), cB + kstep, voffB); PG8_STAGE(PG8_SA(1, 0), cA + kstep, voffA); PG8_STAGE(PG8_SB(1, 1), cB + hstep + kstep, voffB);
        PG8_WAIT_V(6); PG8_BAR;
    } else {
        PG8_STAGE(PG8_SB(0, 0), cB, voffB); PG8_STAGE(PG8_SA(0, 0), cA, voffA); PG8_STAGE(PG8_SB(0, 1), cB + hstep, voffB); PG8_STAGE(PG8_SA(0, 1), cA + hstep, voffA);
        if (wr == 1) PG8_BAR;
        PG8_WAIT_V(4); PG8_BAR;
        PG8_STAGE(PG8_SB(1, 0), cB + kstep, voffB); PG8_STAGE(PG8_SA(1, 0), cA + kstep, voffA); PG8_STAGE(PG8_SB(1, 1), cB + hstep + kstep, voffB);
        PG8_WAIT_V(6); PG8_BAR;
    }
    for (;;) {
        const bool has_next = S.next(ui + 1, nxt);
        const char* nA = has_next ? (const char*)g.A + (size_t)nxt.pm * tstep : cA; const char* nB = has_next ? (const char*)g.Bt + (size_t)nxt.pn * tstep : cB;
        for (int t = 0; t < nt; t += 2) {
            const bool last = (t == nt - 2);
            const char* a1 = cA + (size_t)(t + 1) * kstep;
            const char* a2 = last ? nA : cA + (size_t)(t + 2) * kstep; const char* b2 = last ? nB : cB + (size_t)(t + 2) * kstep;
            const char* a3 = a2 + kstep; const char* b3 = b2 + kstep;
            if (last && has_next) S.a_ready(nxt);
            if constexpr (SP2) {
            PG8_LDB(B0, 0, 0); PG8_LDB(B1, 0, 1); PG8_SCHED; PG8_LDA(At, 0, 0); PG8_STAGE(PG8_SA(1, 1), a1 + hstep, voffA);
            PG8_WAIT_V(8); PG8_WAIT_L(0); PG8_BAR; PG8_MMA(0, 0, At, B0); PG8_MMA(0, 1, At, B1); PG8_BAR; PG8_SCHED;
            PG8_LDA(At, 0, 1); PG8_STAGE(PG8_SB(0, 0), b2, voffB); PG8_STAGE(PG8_SB(0, 1), b2 + hstep, voffB); PG8_STAGE(PG8_SA(0, 0), a2, voffA);
            PG8_WAIT_V(8); PG8_WAIT_L(0); PG8_BAR; PG8_MMA(1, 0, At, B0); PG8_MMA(1, 1, At, B1); PG8_BAR; PG8_SCHED;
            PG8_LDB(B0, 1, 0); PG8_LDB(B1, 1, 1); PG8_SCHED; PG8_LDA(At, 1, 0); PG8_STAGE(PG8_SA(0, 1), a2 + hstep, voffA);
            PG8_WAIT_V(8); PG8_WAIT_L(0); PG8_BAR; PG8_MMA(0, 0, At, B0); PG8_MMA(0, 1, At, B1); PG8_BAR; PG8_SCHED;
            PG8_LDA(At, 1, 1); PG8_STAGE(PG8_SB(1, 0), b3, voffB); PG8_STAGE(PG8_SB(1, 1), b3 + hstep, voffB); PG8_STAGE(PG8_SA(1, 0), a3, voffA);
            PG8_WAIT_V(8); PG8_WAIT_L(0); PG8_BAR; PG8_MMA(1, 0, At, B0); PG8_MMA(1, 1, At, B1); PG8_BAR; PG8_SCHED;
            } else {
            PG8_LDB(B0, 0, 0); PG8_SCHED; PG8_LDA(At, 0, 0); PG8_STAGE(PG8_SA(1, 1), a1 + hstep, voffA);
            PG8_WAIT_L(8); PG8_BAR; PG8_WAIT_L(0); PG8_MMA(0, 0, At, B0); PG8_BAR; PG8_SCHED;
            PG8_LDB(B1, 0, 1); PG8_STAGE(PG8_SB(0, 0), b2, voffB);
            PG8_BAR; PG8_WAIT_L(0); PG8_MMA(0, 1, At, B1); PG8_BAR;
            PG8_LDA(At, 0, 1); PG8_STAGE(PG8_SA(0, 0), a2, voffA);
            PG8_BAR; PG8_WAIT_L(0); PG8_MMA(1, 0, At, B0); PG8_BAR; PG8_SCHED;
            PG8_STAGE(PG8_SB(0, 1), b2 + hstep, voffB);
            PG8_WAIT_V(6); PG8_BAR; PG8_MMA(1, 1, At, B1); PG8_BAR;
            PG8_LDB(B0, 1, 0); PG8_SCHED; PG8_LDA(At, 1, 0); PG8_STAGE(PG8_SA(0, 1), a2 + hstep, voffA);
            PG8_WAIT_L(8); PG8_BAR; PG8_WAIT_L(0); PG8_MMA(0, 0, At, B0); PG8_BAR; PG8_SCHED;
            PG8_LDB(B1, 1, 1); PG8_STAGE(PG8_SB(1, 0), b3, voffB);
            PG8_BAR; PG8_WAIT_L(0); PG8_MMA(0, 1, At, B1); PG8_BAR;
            PG8_LDA(At, 1, 1); PG8_STAGE(PG8_SA(1, 0), a3, voffA);
            PG8_BAR; PG8_WAIT_L(0); PG8_MMA(1, 0, At, B0); PG8_BAR; PG8_SCHED;
            PG8_STAGE(PG8_SB(1, 1), b3 + hstep, voffB);
            PG8_WAIT_V(6); PG8_BAR; PG8_MMA(1, 1, At, B1); PG8_BAR;
            }
        }
        if constexpr (ALIGN_EPI) { if (wr == 0) PG8_BAR; }
        if constexpr (!Epi::AFTER_DRAIN) { E(acc, cur, wr, wc, fr, fq); S.done(cur); }
        if (!has_next) break;
#pragma unroll
        for (int a = 0; a < 2; ++a)
#pragma unroll
            for (int b = 0; b < 2; ++b)
#pragma unroll
                for (int m = 0; m < 4; ++m)
#pragma unroll
                    for (int n = 0; n < 2; ++n) acc[a][b][m][n] = (f32x4){0.f, 0.f, 0.f, 0.f};
        cur = nxt; cA = nA; cB = nB; ++ui;
        if constexpr (ALIGN_EPI) { if (wr == 1) PG8_BAR; }
    }
    PG8_WAIT_V(0);
    if constexpr (!ALIGN_EPI) { if (wr == 0) PG8_BAR; }
    PG8_BAR;
    if constexpr (Epi::AFTER_DRAIN) { E.fused(acc, cur, wr, wc, fr, fq, lds, wid, lane); S.done(cur); }
#undef PG8_SA
#undef PG8_SB
#undef PG8_STAGE
#undef PG8_LDA
#undef PG8_LDB
#undef PG8_MMA
#undef PG8_WAIT_V
#undef PG8_WAIT_L
#undef PG8_BAR
#undef PG8_SCHED
}
}
#define LAS __attribute__((address_space(3)))
typedef unsigned short bf16;
typedef short bf16x8 __attribute__((ext_vector_type(8)));
typedef float f32x4 __attribute__((ext_vector_type(4)));
typedef unsigned u32x4 __attribute__((ext_vector_type(4)));
typedef unsigned u32x2 __attribute__((ext_vector_type(2)));
using pg8::cvt_pk_bf16;

constexpr int D = 1024, NROWS = 34816, NPROMPT = 32768, FF = 2816, NPROJ = 7680, WIN_N = 7696, NMOD = 9216;
constexpr int GROWS = 17408;
constexpr int NCU_G = 272;
constexpr float EPS = 1e-6f;
constexpr int PC_Z = 3072, PC_QS = 4096, PC_KS = 5120, PC_VS = 5376, PC_GA = 5632, PC_GB = 6656;
constexpr size_t O_Y = 0, O_CONVP = 35651584, O_GDNP = 35799040, O_KP = 37896192, O_VP = 38420480, O_CONVS = 38944768, O_GDNS = 39239680, O_KS = 43433984, O_VS = 44482560;
constexpr size_t MiB = 1u << 20;
constexpr size_t WS_MOD = 0, WS_GB = 2 * MiB, WS_DL = 4 * MiB, WS_W1IN = 5 * MiB, WS_W1OUT = 16 * MiB, WS_WIN = 22 * MiB, WS_WOUT = 37 * MiB, WS_W2IN = 39 * MiB, WS_W2OUT = 50 * MiB;
constexpr size_t WS_H = 56 * MiB;
constexpr size_t WS_EX = 56 * MiB, WS_BIG = 209 * MiB;
constexpr size_t WS_MERGED = 464 * MiB, WS_END = 498 * MiB;
constexpr int EX_ITEM = 73728, EX_UT = 0, EX_WN = 16384, EX_QD = 32768, EX_KDT = 49152, EX_QK = 65536;
constexpr int LDS_BYTES = 147456;

struct Params {
    const float *x_prompt, *x_sample, *state_conv, *state_gdn, *cache_k, *cache_v, *c_prompt, *c_sample, *w_ada, *b_ada, *norm_ffn1, *ffn1_w_in, *ffn1_w_out,
        *norm_mix, *w_in, *conv_w, *a_log, *dt_bias, *gdn_norm, *q_norm, *k_norm, *sinks, *b_merge, *w_out, *norm_ffn2, *ffn2_w_in, *ffn2_w_out;
    float* out; unsigned char* ws;
};

__device__ __forceinline__ float bflo(unsigned w) { return __uint_as_float(w << 16); }
__device__ __forceinline__ float bfhi(unsigned w) { return __uint_as_float(w & 0xffff0000u); }
__device__ __forceinline__ unsigned short f2bf(float f) { return (unsigned short)(cvt_pk_bf16(f, 0.f) & 0xffffu); }
__device__ __forceinline__ float sigmoidf_(float x) { return __builtin_amdgcn_rcpf(1.f + __expf(-x)); }
__device__ __forceinline__ float siluf_(float x) { return x * sigmoidf_(x); }
__device__ __forceinline__ void unpack8(const u32x4 w, float (&f)[8]) { f[0] = bflo(w.x); f[1] = bfhi(w.x); f[2] = bflo(w.y); f[3] = bfhi(w.y); f[4] = bflo(w.z); f[5] = bfhi(w.z); f[6] = bflo(w.w); f[7] = bfhi(w.w); }
__device__ __forceinline__ u32x4 pack8(const float (&f)[8]) { u32x4 w; w.x = cvt_pk_bf16(f[0], f[1]); w.y = cvt_pk_bf16(f[2], f[3]); w.z = cvt_pk_bf16(f[4], f[5]); w.w = cvt_pk_bf16(f[6], f[7]); return w; }
__device__ __forceinline__ bf16x8 as_bf16x8(u32x4 w) { return __builtin_bit_cast(bf16x8, w); }
__device__ __forceinline__ float wave_sum(float v) {
#pragma unroll
    for (int o = 1; o < 64; o <<= 1) v += __shfl_xor(v, o);
    return v;
}
__device__ __forceinline__ int grow_of(int g, int lr) { return lr < 16384 ? 16384 * g + lr : NPROMPT + 1024 * g + (lr - 16384); }
__device__ __forceinline__ int modrow_of(int m) { return m < NPROMPT ? (m >> 11) : 16 + ((m - NPROMPT) >> 6); }

struct EpiSwiglu {
    static constexpr bool PERM = true, AFTER_DRAIN = false;
    bf16* O;
    __device__ __forceinline__ void operator()(const pg8::f32x4 (&acc)[2][2][4][2], const pg8::Unit& u, int wr, int wc, int fr, int fq) const {
        const int row0 = u.pm * 256 + wr * 64 + fr, col0 = u.pn * 128 + wc * 32 + 8 * fq;
#pragma unroll
        for (int ai = 0; ai < 2; ++ai)
#pragma unroll
            for (int m = 0; m < 4; ++m) {
                float v[8];
#pragma unroll
                for (int n = 0; n < 2; ++n)
#pragma unroll
                    for (int i = 0; i < 4; ++i) { const float gt = acc[ai][0][m][n][i], up = acc[ai][1][m][n][i]; v[n * 4 + i] = siluf_(gt) * up; }
                *(u32x4*)(O + (size_t)(row0 + ai * 128 + m * 16) * FF + col0) = pack8(v);
            }
    }
};
struct EpiBf16Plain {
    static constexpr bool PERM = true, AFTER_DRAIN = false;
    bf16* O; int ldc;
    __device__ __forceinline__ void operator()(const pg8::f32x4 (&acc)[2][2][4][2], const pg8::Unit& u, int wr, int wc, int fr, int fq) const {
        const int row0 = u.pm * 256 + wr * 64 + fr, col0 = u.pn * 256 + wc * 32 + 8 * fq;
#pragma unroll
        for (int ai = 0; ai < 2; ++ai)
#pragma unroll
            for (int m = 0; m < 4; ++m)
#pragma unroll
                for (int bj = 0; bj < 2; ++bj) {
                    float v[8];
#pragma unroll
                    for (int n = 0; n < 2; ++n)
#pragma unroll
                        for (int i = 0; i < 4; ++i) v[n * 4 + i] = acc[ai][bj][m][n][i];
                    *(u32x4*)(O + (size_t)(row0 + ai * 128 + m * 16) * ldc + col0 + bj * 128) = pack8(v);
                }
    }
};
struct EpiRes {
    static constexpr bool PERM = false, AFTER_DRAIN = false;
    const float* xin_p; const float* xin_s; float* out; const float* mod; int goff; float gscale; int grp;
    __device__ __forceinline__ void operator()(const pg8::f32x4 (&acc)[2][2][4][2], const pg8::Unit& u, int wr, int wc, int fr, int fq) const {
        const int col0 = u.pn * 256 + wc * 32 + 4 * fq;
#pragma unroll
        for (int ai = 0; ai < 2; ++ai)
#pragma unroll
            for (int m = 0; m < 4; ++m) {
                const int R = u.pm * 256 + ai * 128 + wr * 64 + m * 16 + fr;
                const int gm = grp < 0 ? R : grow_of(grp, R);
                const float* xr = gm < NPROMPT ? xin_p + (size_t)gm * D : xin_s + (size_t)(gm - NPROMPT) * D;
                const float* mr = mod + (size_t)modrow_of(gm) * NMOD + goff;
                float* orow = out + (size_t)gm * D;
#pragma unroll
                for (int bj = 0; bj < 2; ++bj)
#pragma unroll
                    for (int n = 0; n < 2; ++n) {
                        const int c = col0 + bj * 128 + n * 16;
                        const f32x4 xv = *(const f32x4*)(xr + c), gv = *(const f32x4*)(mr + c);
                        *(f32x4*)(orow + c) = xv + gscale * gv * acc[ai][bj][m][n];
                    }
            }
    }
};

__device__ __forceinline__ void transpose_tile(const float* W, int ldw, int K, bf16* WT, int dst_row0, int src_col0, int k0, LAS float* scr, int lane) {
#pragma unroll 8
    for (int i = 0; i < 32; ++i) { const int kk = 2 * i + (lane >> 5); scr[kk * 33 + (lane & 31)] = W[(size_t)(k0 + kk) * ldw + src_col0 + (lane & 31)]; }
    asm volatile("s_waitcnt lgkmcnt(0)" ::: "memory");
    const int c = lane & 7;
#pragma unroll
    for (int j = 0; j < 4; ++j) { const int n = (lane >> 3) + 8 * j; const LAS float* s = scr + (8 * c) * 33 + n;
        u32x4 o; o.x = cvt_pk_bf16(s[0 * 33], s[1 * 33]); o.y = cvt_pk_bf16(s[2 * 33], s[3 * 33]); o.z = cvt_pk_bf16(s[4 * 33], s[5 * 33]); o.w = cvt_pk_bf16(s[6 * 33], s[7 * 33]);
        *(u32x4*)(WT + (size_t)(dst_row0 + n) * K + k0 + 8 * c) = o; }
    asm volatile("s_waitcnt lgkmcnt(0)" ::: "memory");
}
__device__ __forceinline__ int swiglu_src(int n) { const int pn = n >> 8, r = n & 255; return r < 128 ? 128 * pn + r : FF + 128 * pn + (r - 128); }
__device__ __forceinline__ void p0_phase(const Params& p, LAS unsigned char* lds, int tid, int wave, int lane) {
    unsigned char* ws = p.ws;
    if (blockIdx.x < 144) {
        const int n0 = blockIdx.x * 64;
        LAS float* sc = (LAS float*)lds; LAS float* part = (LAS float*)(lds + 65536);
        float* MOD = (float*)(ws + WS_MOD);
        for (int pass = 0; pass < 3; ++pass) {
            for (int i = 0; i < 32; ++i) { const int idx = tid + 512 * i, r = idx >> 10, k = idx & 1023, row = 16 * pass + r;
                const float c = row < 16 ? p.c_prompt[row * D + k] : p.c_sample[(row - 16) * D + k]; sc[idx] = c / (1.f + __expf(-c)); }
            __syncthreads();
            float acc[16];
#pragma unroll
            for (int r = 0; r < 16; ++r) acc[r] = 0.f;
            const int kb = wave * 128;
            for (int kk = 0; kk < 128; kk += 4) {
                float w[4];
#pragma unroll
                for (int i = 0; i < 4; ++i) w[i] = p.w_ada[(size_t)(kb + kk + i) * NMOD + n0 + lane];
#pragma unroll
                for (int r = 0; r < 16; ++r) { const f32x4 s4 = *(const LAS f32x4*)(sc + r * 1024 + kb + kk); acc[r] += s4[0] * w[0] + s4[1] * w[1] + s4[2] * w[2] + s4[3] * w[3]; }
            }
#pragma unroll
            for (int r = 0; r < 16; ++r) part[(wave * 16 + r) * 64 + lane] = acc[r];
            __syncthreads();
#pragma unroll
            for (int i = 0; i < 2; ++i) { const int idx = tid + 512 * i, r = idx >> 6, col = idx & 63; float s = p.b_ada[n0 + col];
#pragma unroll
                for (int w = 0; w < 8; ++w) s += part[(w * 16 + r) * 64 + col];
                MOD[(size_t)(16 * pass + r) * NMOD + n0 + col] = s; }
            __syncthreads();
        }
    }
    LAS float* scr = (LAS float*)(lds + wave * 16384);
    const int gw = blockIdx.x * 8 + wave, NGW = gridDim.x * 8;
    constexpr int I0 = 16 * 176, I1 = 44 * 32, I2 = 16 * 240, I3 = 16 * 32;
    constexpr int NIT = 2 * I0 + 2 * I1 + I2 + I3;
    for (int it = gw; it < NIT; it += NGW) {
        int r = it;
        if (r < I0) { const int nb = r % 176, kb = r / 176; transpose_tile(p.ffn1_w_in, 2 * FF, D, (bf16*)(ws + WS_W1IN), 32 * nb, swiglu_src(32 * nb), 64 * kb, scr, lane); continue; } r -= I0;
        if (r < I0) { const int nb = r % 176, kb = r / 176; transpose_tile(p.ffn2_w_in, 2 * FF, D, (bf16*)(ws + WS_W2IN), 32 * nb, swiglu_src(32 * nb), 64 * kb, scr, lane); continue; } r -= I0;
        if (r < I1) { const int nb = r % 32, kb = r / 32; transpose_tile(p.ffn1_w_out, D, FF, (bf16*)(ws + WS_W1OUT), 32 * nb, 32 * nb, 64 * kb, scr, lane); continue; } r -= I1;
        if (r < I1) { const int nb = r % 32, kb = r / 32; transpose_tile(p.ffn2_w_out, D, FF, (bf16*)(ws + WS_W2OUT), 32 * nb, 32 * nb, 64 * kb, scr, lane); continue; } r -= I1;
        if (r < I2) { const int nb = r % 240, kb = r / 240; const int n = 32 * nb; transpose_tile(p.w_in, WIN_N, D, (bf16*)(ws + WS_WIN), n, n < 4096 ? n : n + 16, 64 * kb, scr, lane); continue; } r -= I2;
        { const int nb = r % 32, kb = r / 32; transpose_tile(p.w_out, D, D, (bf16*)(ws + WS_WOUT), 32 * nb, 32 * nb, 64 * kb, scr, lane); }
    }
}

__device__ __forceinline__ void mod_phase(const Params& p, const bool AB, const float* xin_p, const float* xin_s, const float* gain, int moff, bf16* H, int grp, int nrows, LAS unsigned char* lds, int tid, int wave, int lane) {
    const float* MOD = (const float*)(p.ws + WS_MOD);
    LAS float* wabt = (LAS float*)lds;
    if (AB) {
        for (int i = 0; i < 8; ++i) { const int idx = tid + 512 * i, k = idx >> 2, j4 = idx & 3; const f32x4 w = *(const f32x4*)(p.w_in + (size_t)k * WIN_N + 4096 + 4 * j4);
#pragma unroll
            for (int e = 0; e < 4; ++e) wabt[(4 * j4 + e) * 1024 + k] = w[e]; }
        __syncthreads();
    }
    const int gw = blockIdx.x * 8 + wave, NGW = gridDim.x * 8;
    f32x4 gn[4];
#pragma unroll
    for (int j = 0; j < 4; ++j) gn[j] = *(const f32x4*)(gain + 4 * lane + 256 * j);
    for (int r = gw; r < nrows; r += NGW) {
        const int gm = grp < 0 ? r : grow_of(grp, r);
        const float* xr = gm < NPROMPT ? xin_p + (size_t)gm * D : xin_s + (size_t)(gm - NPROMPT) * D;
        const float* mr = MOD + (size_t)modrow_of(gm) * NMOD + moff;
        f32x4 v[4]; float ss = 0.f;
#pragma unroll
        for (int j = 0; j < 4; ++j) { v[j] = *(const f32x4*)(xr + 4 * lane + 256 * j); ss += (v[j][0] * v[j][0] + v[j][1] * v[j][1]) + (v[j][2] * v[j][2] + v[j][3] * v[j][3]); }
        const float rstd = rsqrtf(wave_sum(ss) * (1.f / D) + EPS);
#pragma unroll
        for (int j = 0; j < 4; ++j) { const f32x4 sh = *(const f32x4*)(mr + 4 * lane + 256 * j), sc = *(const f32x4*)(mr + 1024 + 4 * lane + 256 * j);
            v[j] = v[j] * rstd * gn[j] * (1.f + sc) + sh;
            u32x2 o; o.x = cvt_pk_bf16(v[j][0], v[j][1]); o.y = cvt_pk_bf16(v[j][2], v[j][3]);
            *(u32x2*)(H + (size_t)r * D + 4 * lane + 256 * j) = o; }
        if (AB) {
            float mine = 0.f;
#pragma unroll
            for (int o = 0; o < 16; ++o) { float s = 0.f;
#pragma unroll
                for (int j = 0; j < 4; ++j) { const f32x4 w = *(const LAS f32x4*)(wabt + o * 1024 + 4 * lane + 256 * j); s += (v[j][0] * w[0] + v[j][1] * w[1]) + (v[j][2] * w[2] + v[j][3] * w[3]); }
                s = wave_sum(s); if (lane == o) mine = s; }
            if (lane < 16) { float res;
                if (lane < 8) { const float A = __expf(p.a_log[lane]); const float xx = mine + p.dt_bias[lane]; const float sp = xx > 20.f ? xx : log1pf(__expf(xx)); res = -A * sp; }
                else res = 1.f / (1.f + __expf(-mine));
                ((float*)(p.ws + WS_GB))[(size_t)r * 16 + lane] = res; }
        }
    }
}
#define MFMA16(a, b, c) __builtin_amdgcn_mfma_f32_16x16x32_bf16((a), (b), (c), 0, 0, 0)
__device__ __forceinline__ bf16x8 lds_frag16(const LAS unsigned char* base) { return *(const LAS bf16x8*)base; }
__device__ __forceinline__ bf16x8 lds_frag8x2(const LAS unsigned char* lo, const LAS unsigned char* hi) {
    const u32x2 a = *(const LAS u32x2*)lo, b = *(const LAS u32x2*)hi; u32x4 w; w.x = a.x; w.y = a.y; w.z = b.x; w.w = b.y; return as_bf16x8(w); }
__device__ __forceinline__ bf16x8 pack_acc2(const f32x4 a, const f32x4 b) { u32x4 w; w.x = cvt_pk_bf16(a[0], a[1]); w.y = cvt_pk_bf16(a[2], a[3]); w.z = cvt_pk_bf16(b[0], b[1]); w.w = cvt_pk_bf16(b[2], b[3]); return as_bf16x8(w); }

constexpr int PL_QL = 0, PL_KL = 17408, PL_RT = 34816, PL_KDT = 71680, PL_AM = 90112, PL_TB = 106496, PL_GS = 115712;
__device__ __forceinline__ void gdn_prep_item(const Params& p, int g, int cu, int h, LAS unsigned char* lds, int tid, int wave, int lane) {
    const bool is_sample = cu >= 256; const int c = is_sample ? 0 : (cu & 31); const int lr0 = 64 * cu;
    const int bseq = is_sample ? 16 * g + (cu - 256) : 8 * g + (cu >> 5);
    const bf16* PROJ = (const bf16*)(p.ws + WS_BIG);
    unsigned char* ex = p.ws + WS_EX + (size_t)(cu * 8 + h) * EX_ITEM;
    LAS float* GS = (LAS float*)(lds + PL_GS);
    const int fr = lane & 15, fq = lane >> 4;
    if (wave == 0) {
        const float* GB = (const float*)(p.ws + WS_GB) + (size_t)(lr0 + lane) * 16;
        float gv = GB[h]; const float bt = GB[8 + h];
#pragma unroll
        for (int o = 1; o < 64; o <<= 1) { const float t = __shfl_up(gv, o); if (lane >= o) gv += t; }
        GS[lane] = gv; GS[64 + lane] = bt;
    }
    __syncthreads();
    {
        const int r = tid >> 3, ch0 = (tid & 7) * 16;
        const float Gr = GS[r], Gl = GS[63], br = GS[64 + r];
        const float eg = __expf(Gr), egl = __expf(Gl - Gr);
        const bool lastc = is_sample || c == 31;
#pragma nounroll
        for (int arr = 0; arr < 3; ++arr) {
            const int col = arr * 1024 + h * 128 + ch0;
            float acc[16];
#pragma unroll
            for (int j = 0; j < 16; ++j) acc[j] = 0.f;
#pragma nounroll
            for (int i = 0; i < 4; ++i) {
                const int rr = r - 3 + i; float raw[16];
                if (rr >= 0 || c > 0) { const bf16* src = PROJ + (size_t)(lr0 + rr) * NPROJ + col; float t[8]; unpack8(*(const u32x4*)src, t);
#pragma unroll
                    for (int j = 0; j < 8; ++j) raw[j] = t[j];
                    unpack8(*(const u32x4*)(src + 8), t);
#pragma unroll
                    for (int j = 0; j < 8; ++j) raw[8 + j] = t[j];
                } else if (is_sample) { const float* src = p.state_conv + ((size_t)bseq * 3 + (3 + rr)) * 3072 + col;
#pragma unroll
                    for (int j4 = 0; j4 < 4; ++j4) { const f32x4 t = *(const f32x4*)(src + 4 * j4); raw[4 * j4] = t[0]; raw[4 * j4 + 1] = t[1]; raw[4 * j4 + 2] = t[2]; raw[4 * j4 + 3] = t[3]; }
                } else {
#pragma unroll
                    for (int j = 0; j < 16; ++j) raw[j] = 0.f;
                }
                const float* wsrc = p.conv_w + i * 3072 + col;
#pragma unroll
                for (int j4 = 0; j4 < 4; ++j4) { const f32x4 w = *(const f32x4*)(wsrc + 4 * j4);
#pragma unroll
                    for (int e = 0; e < 4; ++e) acc[4 * j4 + e] += raw[4 * j4 + e] * w[e]; }
                if (i == 3 && lastc && r >= 61) {
                    float* o = p.out + (is_sample ? O_CONVS : O_CONVP) + ((size_t)bseq * 3 + (r - 61)) * 3072 + col;
#pragma unroll
                    for (int j4 = 0; j4 < 4; ++j4) *(f32x4*)(o + 4 * j4) = (f32x4){raw[4 * j4], raw[4 * j4 + 1], raw[4 * j4 + 2], raw[4 * j4 + 3]};
                }
            }
            float ss = 0.f;
#pragma unroll
            for (int j = 0; j < 16; ++j) { acc[j] = siluf_(acc[j]); ss += acc[j] * acc[j]; }
            if (arr < 2) { ss += __shfl_xor(ss, 1); ss += __shfl_xor(ss, 2); ss += __shfl_xor(ss, 4);
                const float sc = rsqrtf(ss + EPS) * (arr == 0 ? 0.08838834764831845f : 1.f);
#pragma unroll
                for (int j = 0; j < 16; ++j) acc[j] *= sc; }
            if (arr == 0) {
                float t[8];
#pragma unroll
                for (int hh = 0; hh < 2; ++hh) {
#pragma unroll
                    for (int j = 0; j < 8; ++j) t[j] = acc[8 * hh + j];
                    *(LAS u32x4*)(lds + PL_QL + r * 272 + (ch0 + 8 * hh) * 2) = pack8(t);
#pragma unroll
                    for (int j = 0; j < 8; ++j) t[j] = acc[8 * hh + j] * eg;
                    *(u32x4*)(ex + EX_QD + r * 256 + (ch0 + 8 * hh) * 2) = pack8(t);
                }
            } else if (arr == 1) {
                float t[8];
#pragma unroll
                for (int hh = 0; hh < 2; ++hh) {
#pragma unroll
                    for (int j = 0; j < 8; ++j) t[j] = acc[8 * hh + j];
                    *(LAS u32x4*)(lds + PL_KL + r * 272 + (ch0 + 8 * hh) * 2) = pack8(t);
                }
                const float wsc = br * eg;
#pragma unroll
                for (int j = 0; j < 16; ++j) {
                    *(LAS unsigned short*)(lds + PL_KDT + (ch0 + j) * 144 + r * 2) = f2bf(acc[j] * egl);
                    *(LAS unsigned short*)(lds + PL_RT + (128 + ch0 + j) * 144 + r * 2) = f2bf(acc[j] * wsc);
                }
            } else {
#pragma unroll
                for (int j = 0; j < 16; ++j) *(LAS unsigned short*)(lds + PL_RT + (ch0 + j) * 144 + r * 2) = f2bf(acc[j] * br);
            }
        }
    }
    __syncthreads();
    {
#pragma unroll
        for (int n = 0; n < 4; ++n) {
            const int job = wave * 4 + n, typ = job >> 4, t = job & 15, ib = t >> 2, jb = t & 3;
            if (jb > ib) continue;
            f32x4 acc = (f32x4){0.f, 0.f, 0.f, 0.f};
            if (typ == 0) {
#pragma unroll
                for (int ks = 0; ks < 4; ++ks) { const bf16x8 a = lds_frag16(lds + PL_KL + (16 * ib + fr) * 272 + (32 * ks + 8 * fq) * 2), b = lds_frag16(lds + PL_KL + (16 * jb + fr) * 272 + (32 * ks + 8 * fq) * 2);
                    acc = MFMA16(a, b, acc); }
                const int j = 16 * jb + fr; const float Gj = GS[j];
#pragma unroll
                for (int e = 0; e < 4; ++e) { const int i = 16 * ib + 4 * fq + e; const float v = (j < i) ? GS[64 + i] * acc[e] * __expf(GS[i] - Gj) : 0.f; *(LAS float*)(lds + PL_AM + (i * 64 + j) * 4) = v; }
            } else {
#pragma unroll
                for (int ks = 0; ks < 4; ++ks) { const bf16x8 a = lds_frag16(lds + PL_KL + (16 * jb + fr) * 272 + (32 * ks + 8 * fq) * 2), b = lds_frag16(lds + PL_QL + (16 * ib + fr) * 272 + (32 * ks + 8 * fq) * 2);
                    acc = MFMA16(a, b, acc); }
                const int i = 16 * ib + fr; const float Gi = GS[i]; float v[4];
#pragma unroll
                for (int e = 0; e < 4; ++e) { const int j = 16 * jb + 4 * fq + e; v[e] = (j <= i) ? acc[e] * __expf(Gi - GS[j]) : 0.f; }
                u32x2 o; o.x = cvt_pk_bf16(v[0], v[1]); o.y = cvt_pk_bf16(v[2], v[3]);
                *(u32x2*)(ex + EX_QK + (i * 64 + 16 * jb + 4 * fq) * 2) = o;
            }
        }
#pragma unroll
        for (int n = 0; n < 4; ++n) {
            const int job = wave * 4 + n, typ = job >> 4, t = job & 15, ib = t >> 2, jb = t & 3;
            if (jb <= ib) continue;
            if (typ == 0) {
#pragma unroll
                for (int e = 0; e < 4; ++e) *(LAS float*)(lds + PL_AM + ((16 * ib + 4 * fq + e) * 64 + 16 * jb + fr) * 4) = 0.f;
            } else { u32x2 o; o.x = 0u; o.y = 0u; *(u32x2*)(ex + EX_QK + ((16 * ib + fr) * 64 + 16 * jb + 4 * fq) * 2) = o; }
        }
    }
    __syncthreads();
    if (wave == 0) {
        float t[64]; const float lanef = (float)lane;
        const LAS unsigned char* am = lds + PL_AM; asm volatile("" : "+v"(am));
#pragma unroll
        for (int i = 0; i < 64; ++i) t[i] = 0.f;
#pragma unroll
        for (int i = 0; i < 64; ++i) {
            float s = fmaxf(1.f - fabsf(lanef - (float)i), 0.f);
#pragma unroll
            for (int j4 = 0; j4 < (i + 3) / 4; ++j4) { const f32x4 a = *(const LAS f32x4*)(am + (i * 64 + 4 * j4) * 4);
                s -= a[0] * t[4 * j4]; s -= a[1] * t[4 * j4 + 1]; s -= a[2] * t[4 * j4 + 2]; s -= a[3] * t[4 * j4 + 3]; }
            t[i] = s;
            *(LAS unsigned short*)(lds + PL_TB + i * 144 + lane * 2) = f2bf(s);
        }
    } else if (wave == 1) {
        if (lane == 0) ((float*)(p.ws + WS_DL))[cu * 8 + h] = __expf(GS[63]);
    }
    __syncthreads();
    {
#pragma unroll
        for (int mb = 0; mb < 4; ++mb) {
            f32x4 au = (f32x4){0.f, 0.f, 0.f, 0.f}, aw = (f32x4){0.f, 0.f, 0.f, 0.f};
#pragma unroll
            for (int ks = 0; ks < 2; ++ks) {
                const bf16x8 tf = lds_frag16(lds + PL_TB + (16 * mb + fr) * 144 + (32 * ks + 8 * fq) * 2);
                const bf16x8 rv = lds_frag16(lds + PL_RT + (16 * wave + fr) * 144 + (32 * ks + 8 * fq) * 2);
                const bf16x8 rk = lds_frag16(lds + PL_RT + (128 + 16 * wave + fr) * 144 + (32 * ks + 8 * fq) * 2);
                au = MFMA16(tf, rv, au);
                aw = MFMA16(rk, tf, aw);
            }
            u32x2 o; o.x = cvt_pk_bf16(au[0], au[1]); o.y = cvt_pk_bf16(au[2], au[3]);
            *(u32x2*)(ex + EX_UT + ((16 * wave + fr) * 64 + 16 * mb + 4 * fq) * 2) = o;
            o.x = cvt_pk_bf16(-aw[0], -aw[1]); o.y = cvt_pk_bf16(-aw[2], -aw[3]);
            *(u32x2*)(ex + EX_WN + ((16 * mb + fr) * 128 + 16 * wave + 4 * fq) * 2) = o;
        }
#pragma unroll
        for (int k = 0; k < 2; ++k) { const int idx = tid + 512 * k, d = idx >> 3, c8 = idx & 7;
            *(u32x4*)(ex + EX_KDT + d * 128 + c8 * 16) = *(const LAS u32x4*)(lds + PL_KDT + d * 144 + c8 * 16); }
    }
    __syncthreads();
}

constexpr int SL_K = 0, SL_V = 27648;
__device__ __forceinline__ void swa_item(const Params& p, int g, int cu, int kvh, LAS unsigned char* lds, int tid, int wave, int lane) {
    const bool is_sample = cu >= 256; const int c = is_sample ? 0 : (cu & 31); const int lr0 = 64 * cu;
    const int bseq = is_sample ? 16 * g + (cu - 256) : 8 * g + (cu >> 5);
    const int nkc = is_sample ? 3 : (c < 2 ? c + 1 : 3);
    bf16* PROJ = (bf16*)(p.ws + WS_BIG);
    const int fr = lane & 15, fq = lane >> 4;
    {
        const int row = tid >> 3, d8 = tid & 7;
        f32x4 kn0 = *(const f32x4*)(p.k_norm + d8 * 8), kn1 = *(const f32x4*)(p.k_norm + d8 * 8 + 4);
#pragma unroll
        for (int s = 0; s < 3; ++s) {
            if (s >= nkc) continue;
            float kv[8], vv[8];
            if (is_sample && s < 2) {
                const size_t off = (((size_t)bseq * 128 + 64 * s + row) * 4 + kvh) * 64 + d8 * 8;
                const f32x4 a = *(const f32x4*)(p.cache_k + off), b = *(const f32x4*)(p.cache_k + off + 4), cc = *(const f32x4*)(p.cache_v + off), dd = *(const f32x4*)(p.cache_v + off + 4);
#pragma unroll
                for (int j = 0; j < 4; ++j) { kv[j] = a[j]; kv[4 + j] = b[j]; vv[j] = cc[j]; vv[4 + j] = dd[j]; }
                if (s == 1) { const size_t oo = (((size_t)bseq * 128 + row) * 4 + kvh) * 64 + d8 * 8;
                    *(f32x4*)(p.out + O_KS + oo) = a; *(f32x4*)(p.out + O_KS + oo + 4) = b; *(f32x4*)(p.out + O_VS + oo) = cc; *(f32x4*)(p.out + O_VS + oo + 4) = dd; }
            } else {
                const int lrk = lr0 - 64 * (nkc - 1 - s) + row;
                unpack8(*(const u32x4*)(PROJ + (size_t)lrk * NPROJ + PC_KS + kvh * 64 + d8 * 8), kv);
                unpack8(*(const u32x4*)(PROJ + (size_t)lrk * NPROJ + PC_VS + kvh * 64 + d8 * 8), vv);
                float ss = 0.f;
#pragma unroll
                for (int j = 0; j < 8; ++j) ss += kv[j] * kv[j];
                ss += __shfl_xor(ss, 1); ss += __shfl_xor(ss, 2); ss += __shfl_xor(ss, 4);
                const float sc = rsqrtf(ss * (1.f / 64.f) + EPS);
#pragma unroll
                for (int j = 0; j < 4; ++j) { kv[j] *= sc * kn0[j]; kv[4 + j] *= sc * kn1[j]; }
                if (s == nkc - 1 && (is_sample || c >= 30)) {
                    const int orow = is_sample ? 64 + row : 64 * (c - 30) + row;
                    const size_t oo = (((size_t)bseq * 128 + orow) * 4 + kvh) * 64 + d8 * 8;
                    float* ok = p.out + (is_sample ? O_KS : O_KP) + oo; float* ov = p.out + (is_sample ? O_VS : O_VP) + oo;
                    *(f32x4*)ok = (f32x4){kv[0], kv[1], kv[2], kv[3]}; *(f32x4*)(ok + 4) = (f32x4){kv[4], kv[5], kv[6], kv[7]};
                    *(f32x4*)ov = (f32x4){vv[0], vv[1], vv[2], vv[3]}; *(f32x4*)(ov + 4) = (f32x4){vv[4], vv[5], vv[6], vv[7]};
                }
            }
            const int key = 64 * s + row;
            *(LAS u32x4*)(lds + SL_K + key * 144 + d8 * 16) = pack8(kv);
#pragma unroll
            for (int j = 0; j < 8; ++j) *(LAS unsigned short*)(lds + SL_V + (d8 * 8 + j) * 392 + key * 2) = f2bf(vv[j]);
        }
    }
    __syncthreads();
    const int hq = kvh * 4 + (wave >> 1), t0 = 32 * (wave & 1);
    bf16x8 qf[2][2];
#pragma unroll
    for (int mb = 0; mb < 2; ++mb) {
        const bf16* qsrc = PROJ + (size_t)(lr0 + t0 + 16 * mb + fr) * NPROJ + PC_QS + hq * 64 + 8 * fq;
        float q0[8], q1[8]; unpack8(*(const u32x4*)qsrc, q0); unpack8(*(const u32x4*)(qsrc + 32), q1);
        float ss = 0.f;
#pragma unroll
        for (int j = 0; j < 8; ++j) ss += q0[j] * q0[j] + q1[j] * q1[j];
        ss += __shfl_xor(ss, 16); ss += __shfl_xor(ss, 32);
        const float sc = rsqrtf(ss * (1.f / 64.f) + EPS) * 0.125f;
#pragma unroll
        for (int j = 0; j < 8; ++j) { q0[j] *= sc * p.q_norm[8 * fq + j]; q1[j] *= sc * p.q_norm[32 + 8 * fq + j]; }
        qf[mb][0] = as_bf16x8(pack8(q0)); qf[mb][1] = as_bf16x8(pack8(q1));
    }
    f32x4 sacc[12][2];
#pragma unroll
    for (int nb = 0; nb < 12; ++nb) {
#pragma unroll
        for (int mb = 0; mb < 2; ++mb) sacc[nb][mb] = (f32x4){0.f, 0.f, 0.f, 0.f};
        if (nb < 4 * nkc) {
#pragma unroll
            for (int ks = 0; ks < 2; ++ks) { const bf16x8 a = lds_frag16(lds + SL_K + (16 * nb + fr) * 144 + (32 * ks + 8 * fq) * 2);
#pragma unroll
                for (int mb = 0; mb < 2; ++mb) sacc[nb][mb] = MFMA16(a, qf[mb][ks], sacc[nb][mb]); }
        }
    }
    const float sink = p.sinks[hq]; float inv[2];
#pragma unroll
    for (int mb = 0; mb < 2; ++mb) {
        float mx = sink;
#pragma unroll
        for (int nb = 0; nb < 12; ++nb) if (nb < 4 * nkc) {
#pragma unroll
            for (int e = 0; e < 4; ++e) mx = fmaxf(mx, sacc[nb][mb][e]); }
        mx = fmaxf(mx, __shfl_xor(mx, 16)); mx = fmaxf(mx, __shfl_xor(mx, 32));
        float sum = 0.f;
#pragma unroll
        for (int nb = 0; nb < 12; ++nb) {
#pragma unroll
            for (int e = 0; e < 4; ++e) { const float pv = (nb < 4 * nkc) ? __expf(sacc[nb][mb][e] - mx) : 0.f; sacc[nb][mb][e] = pv; sum += pv; } }
        sum += __shfl_xor(sum, 16); sum += __shfl_xor(sum, 32);
        inv[mb] = 1.f / (sum + __expf(sink - mx));
    }
    f32x4 oacc[4][2];
#pragma unroll
    for (int db = 0; db < 4; ++db)
#pragma unroll
        for (int mb = 0; mb < 2; ++mb) oacc[db][mb] = (f32x4){0.f, 0.f, 0.f, 0.f};
#pragma unroll
    for (int ks2 = 0; ks2 < 6; ++ks2) {
        if (ks2 < 2 * nkc) {
            bf16x8 bp[2];
#pragma unroll
            for (int mb = 0; mb < 2; ++mb) bp[mb] = pack_acc2(sacc[2 * ks2][mb], sacc[2 * ks2 + 1][mb]);
#pragma unroll
            for (int db = 0; db < 4; ++db) {
                const LAS unsigned char* vb = lds + SL_V + (16 * db + fr) * 392 + (32 * ks2 + 4 * fq) * 2;
                const bf16x8 a = lds_frag8x2(vb, vb + 32);
#pragma unroll
                for (int mb = 0; mb < 2; ++mb) oacc[db][mb] = MFMA16(a, bp[mb], oacc[db][mb]);
            }
        }
    }
#pragma unroll
    for (int mb = 0; mb < 2; ++mb) {
        bf16* od = PROJ + (size_t)(lr0 + t0 + 16 * mb + fr) * NPROJ + PC_QS + hq * 64 + 4 * fq;
#pragma unroll
        for (int db = 0; db < 4; ++db) { const f32x4 v = oacc[db][mb] * inv[mb]; u32x2 o; o.x = cvt_pk_bf16(v[0], v[1]); o.y = cvt_pk_bf16(v[2], v[3]); *(u32x2*)(od + 16 * db) = o; }
    }
    __syncthreads();
}

constexpr int CL_WN = 0, CL_QD = 17408, CL_UT = 34816, CL_KDT = 52224, CL_QK = 69632, CL_OT = 78336, CL_SSQ = 112128;
__device__ __forceinline__ void scan_chain(const Params& p, int g, int s, int h, LAS unsigned char* lds, int tid, int wave, int lane) {
    const bool is_sample = s >= 8; const int nsteps = is_sample ? 1 : 32; const int cu0 = is_sample ? 256 + (s - 8) : 32 * s;
    const int bseq = is_sample ? 16 * g + (s - 8) : 8 * g + s;
    const int fr = lane & 15, fq = lane >> 4;
    const bf16* PROJ = (const bf16*)(p.ws + WS_BIG); bf16* MERGED = (bf16*)(p.ws + WS_MERGED);
    const float* DL = (const float*)(p.ws + WS_DL);
    f32x4 sacc[8];
    const int e = 16 * wave + fr;
    if (is_sample) { const float* S0 = p.state_gdn + ((size_t)bseq * 8 + h) * 16384;
#pragma unroll
        for (int db = 0; db < 8; ++db) { const float* pb = S0 + (4 * fq) * 128 + e + db * 2048; asm volatile("" : "+v"(pb));
#pragma unroll
            for (int j = 0; j < 4; ++j) sacc[db][j] = pb[j * 128]; }
    } else {
#pragma unroll
        for (int db = 0; db < 8; ++db) sacc[db] = (f32x4){0.f, 0.f, 0.f, 0.f};
    }
    u32x4 pf[9];
    const unsigned char* exb = p.ws + WS_EX + (size_t)(cu0 * 8 + h) * EX_ITEM;
#define SCAN_LOAD(ptr) do { _Pragma("unroll") for (int k = 0; k < 9; ++k) pf[k] = *(const u32x4*)((ptr) + (size_t)(tid + 512 * k) * 16); } while (0)
#define SCAN_STORE() do { _Pragma("unroll") for (int k = 0; k < 9; ++k) { const int off = (tid + 512 * k) * 16, wi = off & 16383; \
        if (k == 2 || k == 3) *(LAS u32x4*)(lds + CL_WN + (wi >> 8) * 272 + (wi & 255)) = pf[k]; \
        else if (k == 4 || k == 5) *(LAS u32x4*)(lds + CL_QD + (wi >> 8) * 272 + (wi & 255)) = pf[k]; \
        else { const int base = (k < 2) ? CL_UT : (k < 8 ? CL_KDT : CL_QK); LAS unsigned char* d = lds + base + (wi >> 7) * 136 + (wi & 127); \
            u32x2 lo, hi; lo.x = pf[k].x; lo.y = pf[k].y; hi.x = pf[k].z; hi.y = pf[k].w; *(LAS u32x2*)d = lo; *(LAS u32x2*)(d + 8) = hi; } } } while (0)
    SCAN_LOAD(exb); SCAN_STORE();
    __syncthreads();
    for (int st = 0; st < nsteps; ++st) {
        const int cu = cu0 + st, lr0 = 64 * cu;
        if (st + 1 < nsteps) SCAN_LOAD(exb + (size_t)(st + 1) * 8 * EX_ITEM);
        const float dl = DL[cu * 8 + h];
        bf16x8 Bs[4];
#pragma unroll
        for (int ks = 0; ks < 4; ++ks) Bs[ks] = pack_acc2(sacc[2 * ks], sacc[2 * ks + 1]);
        f32x4 vacc[4], oacc[4];
#pragma unroll
        for (int mb = 0; mb < 4; ++mb) {
            const u32x2 uu = *(const LAS u32x2*)(lds + CL_UT + e * 136 + (16 * mb + 4 * fq) * 2);
            vacc[mb] = (f32x4){bflo(uu.x), bfhi(uu.x), bflo(uu.y), bfhi(uu.y)};
            oacc[mb] = (f32x4){0.f, 0.f, 0.f, 0.f};
#pragma unroll
            for (int ks = 0; ks < 4; ++ks) {
                const LAS unsigned char* wb = lds + CL_WN + (16 * mb + fr) * 272 + (32 * ks + 4 * fq) * 2;
                const LAS unsigned char* qb = lds + CL_QD + (16 * mb + fr) * 272 + (32 * ks + 4 * fq) * 2;
                vacc[mb] = MFMA16(lds_frag8x2(wb, wb + 32), Bs[ks], vacc[mb]);
                oacc[mb] = MFMA16(lds_frag8x2(qb, qb + 32), Bs[ks], oacc[mb]);
            }
            __builtin_amdgcn_sched_barrier(0);
        }
        bf16x8 Bv[2];
#pragma unroll
        for (int k2 = 0; k2 < 2; ++k2) Bv[k2] = pack_acc2(vacc[2 * k2], vacc[2 * k2 + 1]);
#pragma unroll
        for (int mb = 0; mb < 4; ++mb)
#pragma unroll
            for (int k2 = 0; k2 < 2; ++k2) { const LAS unsigned char* kb = lds + CL_QK + (16 * mb + fr) * 136 + (32 * k2 + 4 * fq) * 2; oacc[mb] = MFMA16(lds_frag8x2(kb, kb + 32), Bv[k2], oacc[mb]); }
#pragma unroll
        for (int db = 0; db < 8; ++db) {
            sacc[db] = sacc[db] * dl;
#pragma unroll
            for (int k2 = 0; k2 < 2; ++k2) { const LAS unsigned char* kb = lds + CL_KDT + (16 * db + fr) * 136 + (32 * k2 + 4 * fq) * 2; sacc[db] = MFMA16(lds_frag8x2(kb, kb + 32), Bv[k2], sacc[db]); }
            __builtin_amdgcn_sched_barrier(0);
        }
#pragma unroll
        for (int mb = 0; mb < 4; ++mb)
#pragma unroll
            for (int j = 0; j < 4; ++j) {
                const int i = 16 * mb + 4 * fq + j; const float v = oacc[mb][j];
                *(LAS float*)(lds + CL_OT + (i * 132 + e) * 4) = v;
                float q = v * v; q += __shfl_xor(q, 1); q += __shfl_xor(q, 2); q += __shfl_xor(q, 4); q += __shfl_xor(q, 8);
                if (fr == 0) *(LAS float*)(lds + CL_SSQ + (wave * 64 + i) * 4) = q;
            }
        __syncthreads();
        {
            const int i = tid >> 3, c0 = (tid & 7) * 16;
            float ssq = 0.f;
#pragma unroll
            for (int w = 0; w < 8; ++w) ssq += *(const LAS float*)(lds + CL_SSQ + (w * 64 + i) * 4);
            const float rstd = rsqrtf(ssq * (1.f / 128.f) + EPS);
            const bf16* prow = PROJ + (size_t)(lr0 + i) * NPROJ + h * 128 + c0;
#pragma unroll
            for (int hh = 0; hh < 2; ++hh) {
                float z[8], ga[8], gb[8], os[8], r[8];
                unpack8(*(const u32x4*)(prow + PC_Z + 8 * hh), z); unpack8(*(const u32x4*)(prow + PC_GA + 8 * hh), ga);
                unpack8(*(const u32x4*)(prow + PC_GB + 8 * hh), gb); unpack8(*(const u32x4*)(prow + PC_QS + 8 * hh), os);
#pragma unroll
                for (int j = 0; j < 8; ++j) { const int cc = c0 + 8 * hh + j;
                    const float o = *(const LAS float*)(lds + CL_OT + (i * 132 + cc) * 4) * rstd * p.gdn_norm[cc] * siluf_(z[j]);
                    r[j] = sigmoidf_(ga[j] + p.b_merge[h * 128 + cc]) * o + sigmoidf_(gb[j] + p.b_merge[1024 + h * 128 + cc]) * os[j]; }
                *(u32x4*)(MERGED + (size_t)(lr0 + i) * D + h * 128 + c0 + 8 * hh) = pack8(r);
                __builtin_amdgcn_sched_barrier(0);
            }
        }
        __syncthreads();
        if (st + 1 < nsteps) { SCAN_STORE(); __syncthreads(); }
    }
    {   float* So = p.out + (is_sample ? O_GDNS : O_GDNP) + ((size_t)bseq * 8 + h) * 16384;
#pragma unroll
        for (int db = 0; db < 8; ++db) { float* pb = So + (4 * fq) * 128 + e + db * 2048; asm volatile("" : "+v"(pb));
#pragma unroll
            for (int j = 0; j < 4; ++j) pb[j * 128] = sacc[db][j]; }
    }
#undef SCAN_LOAD
#undef SCAN_STORE
}
__global__ void __launch_bounds__(512, 2) mega_fwd(Params p) {
    extern __shared__ __attribute__((aligned(16))) unsigned char lds_raw[];
    cg::grid_group grid = cg::this_grid();
    LAS unsigned char* lds = (LAS unsigned char*)lds_raw;
    const int G = gridDim.x;
    unsigned char* ws = p.ws;
    float* MOD = (float*)(ws + WS_MOD);
    bf16* H = (bf16*)(ws + WS_H); bf16* ACT = (bf16*)(ws + WS_BIG); bf16* PROJ = (bf16*)(ws + WS_BIG); bf16* MERGED = (bf16*)(ws + WS_MERGED);
    float* Y = p.out + O_Y;

    enum { K_P0, K_MOD, K_SWIGLU, K_RES, K_PROJ, K_MIX, K_SCAN };
#pragma nounroll
    for (int ph = 0; ph < 17; ++ph) {
        int tid_ = threadIdx.x; asm volatile("" : "+v"(tid_));
        const int tid = tid_, lane = tid & 63, wave = __builtin_amdgcn_readfirstlane(tid >> 6);
        int bx_ = blockIdx.x; asm volatile("" : "+s"(bx_)); const int bx = bx_;
        int kind, g = -1, ffn = 0;
        if (ph == 0) kind = K_P0;
        else if (ph <= 3) { kind = ph == 1 ? K_MOD : (ph == 2 ? K_SWIGLU : K_RES); }
        else if (ph <= 13) { const int q = ph - 4; g = q / 5; const int r = q - 5 * g; kind = r == 0 ? K_MOD : (r == 1 ? K_PROJ : (r == 2 ? K_MIX : (r == 3 ? K_SCAN : K_RES))); }
        else { ffn = 1; kind = ph == 14 ? K_MOD : (ph == 15 ? K_SWIGLU : K_RES); }
        const bool first = (ph <= 3);
        switch (kind) {
        case K_P0: p0_phase(p, lds, tid, wave, lane); break;
        case K_MOD: {
            const float* xp = first ? p.x_prompt : Y; const float* xs = first ? p.x_sample : Y + (size_t)NPROMPT * D;
            const float* gain = g >= 0 ? p.norm_mix : (ffn ? p.norm_ffn2 : p.norm_ffn1);
            mod_phase(p, g >= 0, xp, xs, gain, g >= 0 ? 3072 : (ffn ? 6144 : 0), H, g, g >= 0 ? GROWS : NROWS, lds, tid, wave, lane);
        } break;
        case K_SWIGLU: { pg8::Gemm gm{H, (const bf16*)(ws + (ffn ? WS_W2IN : WS_W1IN)), NROWS, 2 * FF, D}; pg8::StaticOrder S; S.init(NROWS, 2 * FF, G, bx); EpiSwiglu E{ACT};
            pg8::gemm_phase<EpiSwiglu, pg8::StaticOrder, true, true>(lds, gm, S, E, tid); } break;
        case K_RES: {
            const float* xp = first ? p.x_prompt : Y; const float* xs = first ? p.x_sample : Y + (size_t)NPROMPT * D;
            pg8::Gemm gm; EpiRes E{xp, xs, Y, MOD, 0, 0.5f, g};
            if (g >= 0) { gm = pg8::Gemm{MERGED, (const bf16*)(ws + WS_WOUT), GROWS, D, D}; E.goff = 5120; E.gscale = 1.0f; }
            else { gm = pg8::Gemm{ACT, (const bf16*)(ws + (ffn ? WS_W2OUT : WS_W1OUT)), NROWS, D, FF}; E.goff = ffn ? 8192 : 2048; }
            pg8::StaticOrder S; S.init(gm.M, gm.N, G, bx);
            pg8::gemm_phase<EpiRes, pg8::StaticOrder, true, true>(lds, gm, S, E, tid); } break;
        case K_PROJ: { pg8::Gemm gm{H, (const bf16*)(ws + WS_WIN), GROWS, NPROJ, D}; pg8::StaticOrder S; S.init(GROWS, NPROJ, G, bx); EpiBf16Plain E{PROJ, NPROJ};
            pg8::gemm_phase<EpiBf16Plain, pg8::StaticOrder, true, true>(lds, gm, S, E, tid); } break;
        case K_MIX:
#pragma nounroll
            for (int it = bx; it < NCU_G * 8; it += G) { int t2 = tid; asm volatile("" : "+v"(t2)); gdn_prep_item(p, g, it >> 3, it & 7, lds, t2, __builtin_amdgcn_readfirstlane(t2 >> 6), t2 & 63); }
#pragma nounroll
            for (int it = (bx + 128) % G; it < NCU_G * 4; it += G) { int t2 = tid; asm volatile("" : "+v"(t2)); swa_item(p, g, it >> 2, it & 3, lds, t2, __builtin_amdgcn_readfirstlane(t2 >> 6), t2 & 63); }
            break;
        default:
#pragma nounroll
            for (int ch = bx; ch < 192; ch += G) { int t2 = tid; asm volatile("" : "+v"(t2)); scan_chain(p, g, ch >> 3, ch & 7, lds, t2, __builtin_amdgcn_readfirstlane(t2 >> 6), t2 & 63); }
            break;
        }
        if (ph != 16) grid.sync();
    }
}

extern "C" void kernel_launch(void* const* d_in, const int* in_sizes, int n_in, void* d_out, int out_size, void* d_ws, size_t ws_size, hipStream_t stream) {
    static int grid_blocks = 0;
    if (grid_blocks == 0) {
        if (n_in != 27 || ws_size < WS_END) { fprintf(stderr, "kernel_launch: unexpected n_in %d / ws_size %zu (need %zu)\n", n_in, ws_size, (size_t)WS_END); grid_blocks = -1; return; }
        int dev = 0, cus = 0, per_cu = 0;
        (void)hipGetDevice(&dev); (void)hipDeviceGetAttribute(&cus, hipDeviceAttributeMultiprocessorCount, dev);
        (void)hipFuncSetAttribute((const void*)mega_fwd, hipFuncAttributeMaxDynamicSharedMemorySize, LDS_BYTES);
        (void)hipOccupancyMaxActiveBlocksPerMultiprocessor(&per_cu, (const void*)mega_fwd, 512, LDS_BYTES);
        if (per_cu < 1) { fprintf(stderr, "kernel_launch: occupancy query says %d blocks per CU\n", per_cu); per_cu = 1; }
        grid_blocks = cus;
    }
    if (grid_blocks < 0) return;
    Params p{};
    const float** pp = (const float**)&p;
    for (int i = 0; i < 27; ++i) pp[i] = (const float*)d_in[i];
    p.out = (float*)d_out; p.ws = (unsigned char*)d_ws;
    void* args[] = {&p};
    hipError_t e = hipLaunchCooperativeKernel((const void*)mega_fwd, dim3(grid_blocks), dim3(512), args, LDS_BYTES, stream);
    if (e != hipSuccess) fprintf(stderr, "cooperative launch failed: %s (grid %d)\n", hipGetErrorString(e), grid_blocks);
}
```

```cpp
#include <hip/hip_runtime.h>
#include <hip/hip_cooperative_groups.h>
#include <cstdio>
#include <cstdint>
namespace cg = cooperative_groups;
namespace pg8 {
#define PG8_LAS __attribute__((address_space(3)))
typedef unsigned short bf16_t;
typedef short bf16x8 __attribute__((ext_vector_type(8)));
typedef float f32x4 __attribute__((ext_vector_type(4)));
typedef unsigned u32x4 __attribute__((ext_vector_type(4)));
constexpr int BM = 256, BK = 64, HALF = 128, HTB = HALF * BK * 2  , STAGE_BYTES = 8 * HTB, NXCD = 8, WGM = 4;

__host__ __device__ __forceinline__ int lds_byte(int r, int c) { const int st = (r >> 4) * 2 + (c >> 5), rr = r & 15, cc = c & 31, ob = rr * 64 + cc * 2; return st * 1024 + (ob ^ (((ob >> 9) & 1) << 5)); }
__host__ __device__ __forceinline__ void stage_rc(int b, int& R, int& C) { const int st = b / 1024, sb = b % 1024, swz = sb ^ (((sb >> 9) & 1) << 5); R = (st >> 1) * 16 + swz / 64; C = (st & 1) * 32 + (swz % 64) / 2; }
__host__ __device__ __forceinline__ int perm32(int rho) { const int n = rho >> 4, i = rho & 15; return 8 * (i >> 2) + 4 * n + (i & 3); }

struct Unit { int pm, pn; };
struct Gemm { const bf16_t* A; const bf16_t* Bt; int M, N, K, lda, ldb, a_kstep, a_tstep; };

struct StaticOrder {
    int nM, nN, nwg, G, c;
    __host__ __device__ void init(int M, int N, int G_, int c_) { nM = M / BM; nN = N / BM; nwg = nM * nN; G = G_; c = c_; }
    __host__ __device__ bool next(int i, Unit& u) const {
        const long L = (long)i * G + c; if (L >= nwg) return false;
        int wgid = (int)L; { const int q = nwg / NXCD, r = nwg % NXCD, xcd = wgid % NXCD, off = wgid / NXCD; wgid = (xcd < r ? xcd * (q + 1) : r * (q + 1) + (xcd - r) * q) + off; }
        const int nig = WGM * nN, gid = wgid / nig, fm = gid * WGM, gsz = (nM - fm) < WGM ? (nM - fm) : WGM;
        u.pm = fm + ((wgid % nig) % gsz); u.pn = (wgid % nig) / gsz; return true;
    }
    __device__ __forceinline__ void a_ready(const Unit&) const {}
    __device__ __forceinline__ void done(const Unit&) const {}
};

__device__ __forceinline__ unsigned cvt_pk_bf16(float lo, float hi) { unsigned r; asm volatile("v_cvt_pk_bf16_f32 %0, %1, %2" : "=v"(r) : "v"(lo), "v"(hi)); return r; }
typedef float f32x2 __attribute__((ext_vector_type(2)));
template <class Epi, class Sched, bool ALIGN_EPI = false, bool SP2 = false>
__device__ __forceinline__ void gemm_phase(PG8_LAS unsigned char* lds, const Gemm g, const Sched& S, const Epi& E, const int tid_in) {
    const int tid = tid_in, wid = __builtin_amdgcn_readfirstlane(tid >> 6), lane = tid & 63, wr = wid >> 2, wc = wid & 3, fr = lane & 15, fq = lane >> 4;
    const int K = g.K, nt = K / BK;
    unsigned voffA[2], voffB[2];
#pragma unroll
    for (int i = 0; i < 2; ++i) { int R, C; stage_rc(tid * 16 + i * 8192, R, C); const int Rb = Epi::PERM ? ((R & ~31) + perm32(R & 31)) : R;
        voffA[i] = (unsigned)(R * g.lda + C) * 2u; voffB[i] = (unsigned)(Rb * g.ldb + C) * 2u; }
    const size_t kstep = (size_t)(BK * 2);
    const size_t hstep = (size_t)HALF * g.ldb * 2;
    const size_t tstep = 2 * hstep;
    const size_t hstepA = (size_t)HALF * g.lda * 2, tstepA = (size_t)g.a_tstep, kstepA = (size_t)g.a_kstep;
    const unsigned ldsw = (unsigned)wid * 1024u;
    const int aoff = lds_byte(wr * 64 + fr, fq * 8), boff = lds_byte(wc * 32 + fr, fq * 8);
#define PG8_SA(b, h) (((b) * 2 + (h)) * HTB)
#define PG8_SB(b, h) ((4 + (b) * 2 + (h)) * HTB)
#define PG8_STAGE(bufoff, gbase, voff) do { _Pragma("unroll") for (int _i = 0; _i < 2; ++_i) \
        __builtin_amdgcn_global_load_lds((const unsigned*)((const char*)(gbase) + (voff)[_i]), (PG8_LAS unsigned*)(lds + (bufoff) + ldsw + _i * 8192), 16, 0, 0); } while (0)
#define PG8_LDA(dst, b, h) do { _Pragma("unroll") for (int m = 0; m < 4; ++m) _Pragma("unroll") for (int k = 0; k < 2; ++k) dst[m][k] = *(const PG8_LAS bf16x8*)(lds + PG8_SA(b, h) + aoff + m * 2048 + k * 1024); } while (0)
#define PG8_LDB(dst, b, h) do { _Pragma("unroll") for (int n = 0; n < 2; ++n) _Pragma("unroll") for (int k = 0; k < 2; ++k) dst[n][k] = *(const PG8_LAS bf16x8*)(lds + PG8_SB(b, h) + boff + n * 2048 + k * 1024); } while (0)
#define PG8_MMA(ai, bj, At, Bt) do { __builtin_amdgcn_s_setprio(1); _Pragma("unroll") for (int m = 0; m < 4; ++m) _Pragma("unroll") for (int n = 0; n < 2; ++n) _Pragma("unroll") for (int k = 0; k < 2; ++k) \
        acc[ai][bj][m][n] = __builtin_amdgcn_mfma_f32_16x16x32_bf16(Bt[n][k], At[m][k], acc[ai][bj][m][n], 0, 0, 0); __builtin_amdgcn_s_setprio(0); } while (0)
#define PG8_WAIT_V(n) asm volatile("s_waitcnt vmcnt(" #n ")" ::: "memory")
#define PG8_WAIT_L(n) asm volatile("s_waitcnt lgkmcnt(" #n ")" ::: "memory")
#define PG8_BAR __builtin_amdgcn_s_barrier()
#define PG8_SCHED __builtin_amdgcn_sched_barrier(0)
    Unit cur, nxt; int ui = 0;
    if (!S.next(0, cur)) return;
    f32x4 acc[2][2][4][2];
#pragma unroll
    for (int a = 0; a < 2; ++a)
#pragma unroll
        for (int b = 0; b < 2; ++b)
#pragma unroll
            for (int m = 0; m < 4; ++m)
#pragma unroll
                for (int n = 0; n < 2; ++n) acc[a][b][m][n] = (f32x4){0.f, 0.f, 0.f, 0.f};
    bf16x8 At[4][2], B0[2][2], B1[2][2];
    const char* cA = (const char*)g.A + (size_t)cur.pm * tstepA; const char* cB = (const char*)g.Bt + (size_t)cur.pn * tstep;
    S.a_ready(cur);
    if constexpr (SP2) {
        PG8_STAGE(PG8_SB(0, 0), cB, voffB); PG8_STAGE(PG8_SB(0, 1), cB + hstep, voffB); PG8_STAGE(PG8_SA(0, 0), cA, voffA); PG8_STAGE(PG8_SA(0, 1), cA + hstepA, voffA);
        if (wr == 1) PG8_BAR;
        PG8_WAIT_V(2); PG8_BAR;
        PG8_STAGE(PG8_SB(1, 0), cB + kstep, voffB); PG8_STAGE(PG8_SA(1, 0), cA + kstepA, voffA); PG8_STAGE(PG8_SB(1, 1), cB + hstep + kstep, voffB);
        PG8_WAIT_V(6); PG8_BAR;
    } else {
        PG8_STAGE(PG8_SB(0, 0), cB, voffB); PG8_STAGE(PG8_SA(0, 0), cA, voffA); PG8_STAGE(PG8_SB(0, 1), cB + hstep, voffB); PG8_STAGE(PG8_SA(0, 1), cA + hstepA, voffA);
        if (wr == 1) PG8_BAR;
        PG8_WAIT_V(4); PG8_BAR;
        PG8_STAGE(PG8_SB(1, 0), cB + kstep, voffB); PG8_STAGE(PG8_SA(1, 0), cA + kstepA, voffA); PG8_STAGE(PG8_SB(1, 1), cB + hstep + kstep, voffB);
        PG8_WAIT_V(6); PG8_BAR;
    }
    for (;;) {
        const bool has_next = S.next(ui + 1, nxt);
        const char* nA = has_next ? (const char*)g.A + (size_t)nxt.pm * tstepA : cA; const char* nB = has_next ? (const char*)g.Bt + (size_t)nxt.pn * tstep : cB;
        for (int t = 0; t < nt; t += 2) {
            const bool last = (t == nt - 2);
            const char* a1 = cA + (size_t)(t + 1) * kstepA;
            const char* a2 = last ? nA : cA + (size_t)(t + 2) * kstepA; const char* b2 = last ? nB : cB + (size_t)(t + 2) * kstep;
            const char* a3 = a2 + kstepA; const char* b3 = b2 + kstep;
            if (last && has_next) S.a_ready(nxt);
            if constexpr (SP2) {
            PG8_LDB(B0, 0, 0); PG8_LDB(B1, 0, 1); PG8_SCHED; PG8_LDA(At, 0, 0); PG8_STAGE(PG8_SA(1, 1), a1 + hstepA, voffA);
            PG8_WAIT_V(8); PG8_WAIT_L(0); PG8_BAR; PG8_MMA(0, 0, At, B0); PG8_MMA(0, 1, At, B1); PG8_BAR; PG8_SCHED;
            PG8_LDA(At, 0, 1); PG8_STAGE(PG8_SB(0, 0), b2, voffB); PG8_STAGE(PG8_SB(0, 1), b2 + hstep, voffB); PG8_STAGE(PG8_SA(0, 0), a2, voffA);
            PG8_WAIT_V(8); PG8_WAIT_L(0); PG8_BAR; PG8_MMA(1, 0, At, B0); PG8_MMA(1, 1, At, B1); PG8_BAR; PG8_SCHED;
            PG8_LDB(B0, 1, 0); PG8_LDB(B1, 1, 1); PG8_SCHED; PG8_LDA(At, 1, 0); PG8_STAGE(PG8_SA(0, 1), a2 + hstepA, voffA);
            PG8_WAIT_V(8); PG8_WAIT_L(0); PG8_BAR; PG8_MMA(0, 0, At, B0); PG8_MMA(0, 1, At, B1); PG8_BAR; PG8_SCHED;
            PG8_LDA(At, 1, 1); PG8_STAGE(PG8_SB(1, 0), b3, voffB); PG8_STAGE(PG8_SB(1, 1), b3 + hstep, voffB); PG8_STAGE(PG8_SA(1, 0), a3, voffA);
            PG8_WAIT_V(8); PG8_WAIT_L(0); PG8_BAR; PG8_MMA(1, 0, At, B0); PG8_MMA(1, 1, At, B1); PG8_BAR; PG8_SCHED;
            } else {
            PG8_LDB(B0, 0, 0); PG8_SCHED; PG8_LDA(At, 0, 0); PG8_STAGE(PG8_SA(1, 1), a1 + hstepA, voffA);
            PG8_WAIT_L(8); PG8_BAR; PG8_WAIT_L(0); PG8_MMA(0, 0, At, B0); PG8_BAR; PG8_SCHED;
            PG8_LDB(B1, 0, 1); PG8_STAGE(PG8_SB(0, 0), b2, voffB);
            PG8_BAR; PG8_WAIT_L(0); PG8_MMA(0, 1, At, B1); PG8_BAR;
            PG8_LDA(At, 0, 1); PG8_STAGE(PG8_SA(0, 0), a2, voffA);
            PG8_BAR; PG8_WAIT_L(0); PG8_MMA(1, 0, At, B0); PG8_BAR; PG8_SCHED;
            PG8_STAGE(PG8_SB(0, 1), b2 + hstep, voffB);
            PG8_WAIT_V(6); PG8_BAR; PG8_MMA(1, 1, At, B1); PG8_BAR;
            PG8_LDB(B0, 1, 0); PG8_SCHED; PG8_LDA(At, 1, 0); PG8_STAGE(PG8_SA(0, 1), a2 + hstepA, voffA);
            PG8_WAIT_L(8); PG8_BAR; PG8_WAIT_L(0); PG8_MMA(0, 0, At, B0); PG8_BAR; PG8_SCHED;
            PG8_LDB(B1, 1, 1); PG8_STAGE(PG8_SB(1, 0), b3, voffB);
            PG8_BAR; PG8_WAIT_L(0); PG8_MMA(0, 1, At, B1); PG8_BAR;
            PG8_LDA(At, 1, 1); PG8_STAGE(PG8_SA(1, 0), a3, voffA);
            PG8_BAR; PG8_WAIT_L(0); PG8_MMA(1, 0, At, B0); PG8_BAR; PG8_SCHED;
            PG8_STAGE(PG8_SB(1, 1), b3 + hstep, voffB);
            PG8_WAIT_V(6); PG8_BAR; PG8_MMA(1, 1, At, B1); PG8_BAR;
            }
        }
        if constexpr (ALIGN_EPI) { if (wr == 0) PG8_BAR; }
        if constexpr (!Epi::AFTER_DRAIN) { E(acc, cur, wr, wc, fr, fq); S.done(cur); }
        if (!has_next) break;
#pragma unroll
        for (int a = 0; a < 2; ++a)
#pragma unroll
            for (int b = 0; b < 2; ++b)
#pragma unroll
                for (int m = 0; m < 4; ++m)
#pragma unroll
                    for (int n = 0; n < 2; ++n) acc[a][b][m][n] = (f32x4){0.f, 0.f, 0.f, 0.f};
        cur = nxt; cA = nA; cB = nB; ++ui;
        if constexpr (ALIGN_EPI) { if (wr == 1) PG8_BAR; }
    }
    PG8_WAIT_V(0);
    if constexpr (!ALIGN_EPI) { if (wr == 0) PG8_BAR; }
    PG8_BAR;
    if constexpr (Epi::AFTER_DRAIN) { E.fused(acc, cur, wr, wc, fr, fq, lds, wid, lane); S.done(cur); }
#undef PG8_SA
#undef PG8_SB
#undef PG8_STAGE
#undef PG8_LDA
#undef PG8_LDB
#undef PG8_MMA
#undef PG8_WAIT_V
#undef PG8_WAIT_L
#undef PG8_BAR
#undef PG8_SCHED
}
}
#define LAS __attribute__((address_space(3)))
typedef unsigned short bf16;
typedef short bf16x8 __attribute__((ext_vector_type(8)));
typedef float f32x4 __attribute__((ext_vector_type(4)));
typedef unsigned u32x4 __attribute__((ext_vector_type(4)));
typedef unsigned u32x2 __attribute__((ext_vector_type(2)));
typedef float f32x2_t __attribute__((ext_vector_type(2)));
typedef __bf16 bf16x2_t __attribute__((ext_vector_type(2)));
__device__ __forceinline__ unsigned cvt_pk_bf16(float lo, float hi) { const f32x2_t v = {lo, hi}; const bf16x2_t b = __builtin_convertvector(v, bf16x2_t); return __builtin_bit_cast(unsigned, b); }

constexpr int D = 1024, NROWS = 34816, NPROMPT = 32768, FF = 2816, NPROJ = 7680, WIN_N = 7696, NMOD = 9216;
constexpr int GROWS_MAX = 18432;
__host__ __device__ constexpr int grows_of(int g) { return g == 0 ? 18432 : 16384; }
__host__ __device__ constexpr int ncu_of(int g) { return g == 0 ? 288 : 256; }
constexpr float EPS = 1e-6f;
constexpr int PC_Z = 3072, PC_QS = 4096, PC_KS = 5120, PC_VS = 5376, PC_GA = 5632, PC_GB = 6656;
constexpr size_t O_Y = 0, O_CONVP = 35651584, O_GDNP = 35799040, O_KP = 37896192, O_VP = 38420480, O_CONVS = 38944768, O_GDNS = 39239680, O_KS = 43433984, O_VS = 44482560;
constexpr size_t MiB = 1u << 20;
constexpr size_t WS_MOD = 0, WS_GB = 2 * MiB, WS_HALO = 3 * MiB + 512 * 1024  , WS_DL = 4 * MiB, WS_KVT = 5 * MiB  ,
    WS_W1IN = 7 * MiB, WS_W1OUT = 18 * MiB, WS_WIN = 24 * MiB, WS_WOUT = 39 * MiB, WS_W2IN = 41 * MiB, WS_W2OUT = 52 * MiB;
constexpr size_t WS_H = 58 * MiB;
constexpr size_t WS_EX = 58 * MiB, WS_BIG = 220 * MiB;
constexpr size_t WS_END = 490 * MiB;
constexpr int EX_ITEM = 73728, EX_UT = 0, EX_WN = 16384, EX_QD = 32768, EX_KDT = 49152, EX_QK = 65536;
constexpr int LDS_BYTES = 151552;
constexpr size_t WS_BAR = 4 * MiB + 256 * 1024;
constexpr int LDS_BARST = LDS_BYTES - 16;

struct Params {
    const float *x_prompt, *x_sample, *state_conv, *state_gdn, *cache_k, *cache_v, *c_prompt, *c_sample, *w_ada, *b_ada, *norm_ffn1, *ffn1_w_in, *ffn1_w_out,
        *norm_mix, *w_in, *conv_w, *a_log, *dt_bias, *gdn_norm, *q_norm, *k_norm, *sinks, *b_merge, *w_out, *norm_ffn2, *ffn2_w_in, *ffn2_w_out;
    float* out; unsigned char* ws;
};

__device__ __forceinline__ float bflo(unsigned w) { return __uint_as_float(w << 16); }
__device__ __forceinline__ float bfhi(unsigned w) { return __uint_as_float(w & 0xffff0000u); }
__device__ __forceinline__ unsigned short f2bf(float f) { return (unsigned short)(cvt_pk_bf16(f, 0.f) & 0xffffu); }
__device__ __forceinline__ float sigmoidf_(float x) { return __builtin_amdgcn_rcpf(1.f + __expf(-x)); }
__device__ __forceinline__ float siluf_(float x) { return x * sigmoidf_(x); }
__device__ __forceinline__ void unpack8(const u32x4 w, float (&f)[8]) { f[0] = bflo(w.x); f[1] = bfhi(w.x); f[2] = bflo(w.y); f[3] = bfhi(w.y); f[4] = bflo(w.z); f[5] = bfhi(w.z); f[6] = bflo(w.w); f[7] = bfhi(w.w); }
__device__ __forceinline__ u32x4 pack8(const float (&f)[8]) { u32x4 w; w.x = cvt_pk_bf16(f[0], f[1]); w.y = cvt_pk_bf16(f[2], f[3]); w.z = cvt_pk_bf16(f[4], f[5]); w.w = cvt_pk_bf16(f[6], f[7]); return w; }
__device__ __forceinline__ bf16x8 as_bf16x8(u32x4 w) { return __builtin_bit_cast(bf16x8, w); }
__device__ __forceinline__ float wave_sum(float v) {
#pragma unroll
    for (int o = 1; o < 64; o <<= 1) v += __shfl_xor(v, o);
    return v;
}
__device__ __forceinline__ int grow_of(int g, int lr) { return lr < 16384 ? (lr >> 10) * 2048 + 1024 * g + (lr & 1023) : NPROMPT + (lr - 16384); }
__device__ __forceinline__ int modrow_of(int m) { return m < NPROMPT ? (m >> 11) : 16 + ((m - NPROMPT) >> 6); }

struct EpiSwiglu {
    static constexpr bool PERM = true, AFTER_DRAIN = false;
    bf16* O;
    __device__ __forceinline__ void operator()(const pg8::f32x4 (&acc)[2][2][4][2], const pg8::Unit& u, int wr, int wc, int fr, int fq) const {
        const int row0 = u.pm * 256 + wr * 64 + fr, col0 = u.pn * 128 + wc * 32 + 8 * fq; const int kt = col0 >> 6, cin = col0 & 63;
#pragma unroll
        for (int ai = 0; ai < 2; ++ai)
#pragma unroll
            for (int m = 0; m < 4; ++m) {
                float v[8];
#pragma unroll
                for (int n = 0; n < 2; ++n)
#pragma unroll
                    for (int i = 0; i < 4; ++i) { const float gt = acc[ai][0][m][n][i], up = acc[ai][1][m][n][i]; v[n * 4 + i] = siluf_(gt) * up; }
                *(u32x4*)(O + ((size_t)(u.pm * 44 + kt) * 256 + (row0 - u.pm * 256) + ai * 128 + m * 16) * 64 + cin) = pack8(v);
            }
    }
};
struct EpiBf16Plain {
    static constexpr bool PERM = true, AFTER_DRAIN = false;
    bf16* O; int ldc;
    __device__ __forceinline__ void operator()(const pg8::f32x4 (&acc)[2][2][4][2], const pg8::Unit& u, int wr, int wc, int fr, int fq) const {
        const int row0 = u.pm * 256 + wr * 64 + fr, col0 = u.pn * 256 + wc * 32 + 8 * fq;
#pragma unroll
        for (int ai = 0; ai < 2; ++ai)
#pragma unroll
            for (int m = 0; m < 4; ++m)
#pragma unroll
                for (int bj = 0; bj < 2; ++bj) {
                    float v[8];
#pragma unroll
                    for (int n = 0; n < 2; ++n)
#pragma unroll
                        for (int i = 0; i < 4; ++i) v[n * 4 + i] = acc[ai][bj][m][n][i];
                    *(u32x4*)(O + (size_t)(row0 + ai * 128 + m * 16) * ldc + col0 + bj * 128) = pack8(v);
                }
    }
};
struct EpiRes {
    static constexpr bool PERM = false, AFTER_DRAIN = false;
    const float* xin_p; const float* xin_s; float* out; const float* mod; int goff; float gscale; int grp;
    __device__ __forceinline__ void operator()(const pg8::f32x4 (&acc)[2][2][4][2], const pg8::Unit& u, int wr, int wc, int fr, int fq) const {
        const int col0 = u.pn * 256 + wc * 32 + 4 * fq;
#pragma unroll
        for (int ai = 0; ai < 2; ++ai)
#pragma unroll
            for (int m = 0; m < 4; ++m) {
                const int R = u.pm * 256 + ai * 128 + wr * 64 + m * 16 + fr;
                const int gm = grp < 0 ? R : grow_of(grp, R);
                const float* xr = gm < NPROMPT ? xin_p + (size_t)gm * D : xin_s + (size_t)(gm - NPROMPT) * D;
                const float* mr = mod + (size_t)modrow_of(gm) * NMOD + goff;
                float* orow = out + (size_t)gm * D;
#pragma unroll
                for (int bj = 0; bj < 2; ++bj)
#pragma unroll
                    for (int n = 0; n < 2; ++n) {
                        const int c = col0 + bj * 128 + n * 16;
                        const f32x4 xv = *(const f32x4*)(xr + c), gv = *(const f32x4*)(mr + c);
                        *(f32x4*)(orow + c) = xv + gscale * gv * acc[ai][bj][m][n];
                    }
            }
    }
};

__device__ __forceinline__ void transpose_tile(const float* W, int ldw, int K, bf16* WT, int dst_row0, int src_col0, int k0, LAS float* scr, int lane) {
    const int voff = (lane >> 5) * ldw + (lane & 31);
#pragma unroll
    for (int i = 0; i < 32; ++i) { const float* wr = W + (size_t)(k0 + 2 * i) * ldw + src_col0; scr[(2 * i + (lane >> 5)) * 33 + (lane & 31)] = wr[voff]; }
    asm volatile("s_waitcnt lgkmcnt(0)" ::: "memory");
    const int c = lane & 7;
#pragma unroll
    for (int j = 0; j < 4; ++j) { const int n = (lane >> 3) + 8 * j; const LAS float* s = scr + (8 * c) * 33 + n;
        u32x4 o; o.x = cvt_pk_bf16(s[0 * 33], s[1 * 33]); o.y = cvt_pk_bf16(s[2 * 33], s[3 * 33]); o.z = cvt_pk_bf16(s[4 * 33], s[5 * 33]); o.w = cvt_pk_bf16(s[6 * 33], s[7 * 33]);
        *(u32x4*)(WT + (size_t)(dst_row0 + n) * K + k0 + 8 * c) = o; }
    asm volatile("s_waitcnt lgkmcnt(0)" ::: "memory");
}
__device__ __forceinline__ int swiglu_src(int n) { const int pn = n >> 8, r = n & 255; return r < 128 ? 128 * pn + r : FF + 128 * pn + (r - 128); }
__device__ __forceinline__ void p0_phase(const Params& p, LAS unsigned char* lds, int tid, int wave, int lane) {
    unsigned char* ws = p.ws;
    if (blockIdx.x < 144) {
        const int n0 = blockIdx.x * 64, fr = lane & 15, fq = lane >> 4;
        float* MOD = (float*)(ws + WS_MOD);
#pragma unroll 4
        for (int i = 0; i < 12; ++i) { const int idx = tid + 512 * i, r = idx >> 7, k8 = (idx & 127) * 8;
            const float* cp = r < 16 ? p.c_prompt + r * D + k8 : p.c_sample + (r - 16) * D + k8;
            const f32x4 a = *(const f32x4*)cp, b2 = *(const f32x4*)(cp + 4); float v[8];
#pragma unroll
            for (int j = 0; j < 4; ++j) { v[j] = a[j] / (1.f + __expf(-a[j])); v[4 + j] = b2[j] / (1.f + __expf(-b2[j])); }
            *(LAS u32x4*)(lds + r * 2064 + k8 * 2) = pack8(v); }
        __syncthreads();
        f32x4 acc[3][4];
#pragma unroll
        for (int mb = 0; mb < 3; ++mb)
#pragma unroll
            for (int nb = 0; nb < 4; ++nb) acc[mb][nb] = (f32x4){0.f, 0.f, 0.f, 0.f};
        const int kb = wave * 128;
        const int voff = (8 * fq) * NMOD + fr;
#pragma unroll
        for (int ks = 0; ks < 4; ++ks) {
            bf16x8 bfr[4];
#pragma unroll
            for (int nb = 0; nb < 4; ++nb) { float w[8];
#pragma unroll
                for (int j = 0; j < 8; ++j) { const float* wr = p.w_ada + (size_t)(kb + 32 * ks + j) * NMOD + n0 + 16 * nb; w[j] = wr[voff]; }
                bfr[nb] = as_bf16x8(pack8(w)); }
#pragma unroll
            for (int mb = 0; mb < 3; ++mb) { const bf16x8 af = *(const LAS bf16x8*)(lds + (16 * mb + fr) * 2064 + (kb + 32 * ks + 8 * fq) * 2);
#pragma unroll
                for (int nb = 0; nb < 4; ++nb) acc[mb][nb] = __builtin_amdgcn_mfma_f32_16x16x32_bf16(af, bfr[nb], acc[mb][nb], 0, 0, 0); }
        }
        __syncthreads();
        LAS float* part = (LAS float*)lds;
#pragma unroll
        for (int mb = 0; mb < 3; ++mb)
#pragma unroll
            for (int nb = 0; nb < 4; ++nb)
#pragma unroll
                for (int j = 0; j < 4; ++j) part[(wave * 48 + 16 * mb + 4 * fq + j) * 64 + 16 * nb + fr] = acc[mb][nb][j];
        __syncthreads();
#pragma unroll
        for (int i = 0; i < 6; ++i) { const int idx = tid + 512 * i, r = idx >> 6, col = idx & 63; float sm = p.b_ada[n0 + col];
#pragma unroll
            for (int w = 0; w < 8; ++w) sm += part[(w * 48 + r) * 64 + col];
            MOD[(size_t)r * NMOD + n0 + col] = sm; }
        __syncthreads();
    }
    LAS float* scr = (LAS float*)(lds + wave * 16384);
    const int gw = blockIdx.x * 8 + wave, NGW = gridDim.x * 8;
    constexpr int I0 = 16 * 176, I1 = 44 * 32, I2 = 16 * 240, I3 = 16 * 32;
    constexpr int NIT = 2 * I0 + 2 * I1 + I2 + I3;
#pragma unroll 1
    for (int it = gw; it < NIT; it += NGW) {
        int r = it; const float* W; int ldw, K, nb, kb, srcc; size_t wso;
        if (r < I0) { nb = r % 176; kb = r / 176; W = p.ffn1_w_in; ldw = 2 * FF; K = D; wso = WS_W1IN; srcc = swiglu_src(32 * nb); }
        else if ((r -= I0) < I0) { nb = r % 176; kb = r / 176; W = p.ffn2_w_in; ldw = 2 * FF; K = D; wso = WS_W2IN; srcc = swiglu_src(32 * nb); }
        else if ((r -= I0) < I1) { nb = r % 32; kb = r / 32; W = p.ffn1_w_out; ldw = D; K = FF; wso = WS_W1OUT; srcc = 32 * nb; }
        else if ((r -= I1) < I1) { nb = r % 32; kb = r / 32; W = p.ffn2_w_out; ldw = D; K = FF; wso = WS_W2OUT; srcc = 32 * nb; }
        else if ((r -= I1) < I2) { nb = r % 240; kb = r / 240; W = p.w_in; ldw = WIN_N; K = D; wso = WS_WIN; srcc = 32 * nb < 4096 ? 32 * nb : 32 * nb + 16; }
        else { r -= I2; nb = r % 32; kb = r / 32; W = p.w_out; ldw = D; K = D; wso = WS_WOUT; srcc = 32 * nb; }
        transpose_tile(W, ldw, K, (bf16*)(ws + wso), 32 * nb, srcc, 64 * kb, scr, lane);
    }
}

__device__ __forceinline__ void mod_phase(const Params& p, const bool AB, const float* xin_p, const float* xin_s, const float* gain, int moff, bf16* H, int grp, int nrows, LAS unsigned char* lds, int tid, int wave, int lane) {
    const float* MOD = (const float*)(p.ws + WS_MOD);
    LAS float* wabt = (LAS float*)lds;
    if (AB) {
        for (int i = 0; i < 8; ++i) { const int idx = tid + 512 * i, k = idx >> 2, j4 = idx & 3; const f32x4 w = *(const f32x4*)(p.w_in + (size_t)k * WIN_N + 4096 + 4 * j4);
#pragma unroll
            for (int e = 0; e < 4; ++e) wabt[(4 * j4 + e) * 1024 + k] = w[e]; }
        __syncthreads();
    }
    const int gw = blockIdx.x * 8 + wave, NGW = gridDim.x * 8;
    const int rpw = (nrows + NGW - 1) / NGW, rbeg = gw * rpw, rend = (rbeg + rpw < nrows) ? rbeg + rpw : nrows;
    f32x4 gn[4], sh[4], sc[4];
#pragma unroll
    for (int j = 0; j < 4; ++j) gn[j] = *(const f32x4*)(gain + 4 * lane + 256 * j);
    int cur_mod = -1;
    f32x4 xa[4], xb[4];
#define MOD_XPTR(r) ({ const int gm_ = grp < 0 ? (r) : grow_of(grp, (r)); (gm_ < NPROMPT ? xin_p + (size_t)gm_ * D : xin_s + (size_t)(gm_ - NPROMPT) * D); })
#define MOD_LOADX(dst, r) do { const int rc_ = (r) < rend ? (r) : (rend - 1); const float* xr_ = MOD_XPTR(rc_); _Pragma("unroll") for (int j = 0; j < 4; ++j) dst[j] = *(const f32x4*)(xr_ + 4 * lane + 256 * j); } while (0)
    if (rbeg < rend) { MOD_LOADX(xa, rbeg); MOD_LOADX(xb, rbeg + 1); }
#pragma unroll 1
    for (int r = rbeg; r < rend; ++r) {
        f32x4 v[4];
#pragma unroll
        for (int j = 0; j < 4; ++j) { v[j] = xa[j]; xa[j] = xb[j]; }
        MOD_LOADX(xb, r + 2);
        const int gm = grp < 0 ? r : grow_of(grp, r); const int mrow = modrow_of(gm);
        if (mrow != cur_mod) { cur_mod = mrow; const float* mr = MOD + (size_t)mrow * NMOD + moff;
#pragma unroll
            for (int j = 0; j < 4; ++j) { sh[j] = *(const f32x4*)(mr + 4 * lane + 256 * j); sc[j] = *(const f32x4*)(mr + 1024 + 4 * lane + 256 * j); } }
        float ss = 0.f;
#pragma unroll
        for (int j = 0; j < 4; ++j) ss += (v[j][0] * v[j][0] + v[j][1] * v[j][1]) + (v[j][2] * v[j][2] + v[j][3] * v[j][3]);
        const float rstd = rsqrtf(wave_sum(ss) * (1.f / D) + EPS);
#pragma unroll
        for (int j = 0; j < 4; ++j) { v[j] = v[j] * rstd * gn[j] * (1.f + sc[j]) + sh[j];
            u32x2 o; o.x = cvt_pk_bf16(v[j][0], v[j][1]); o.y = cvt_pk_bf16(v[j][2], v[j][3]);
            *(u32x2*)(H + (size_t)r * D + 4 * lane + 256 * j) = o; }
        if (AB) {
            float s16[16];
#pragma unroll
            for (int o = 0; o < 16; ++o) { float s = 0.f;
#pragma unroll
                for (int j = 0; j < 4; ++j) { const f32x4 w = *(const LAS f32x4*)(wabt + o * 1024 + 4 * lane + 256 * j); s += (v[j][0] * w[0] + v[j][1] * w[1]) + (v[j][2] * w[2] + v[j][3] * w[3]); }
                s16[o] = s; }
            const bool b5 = lane & 32, b4 = lane & 16, b3 = lane & 8, b2 = lane & 4;
            float t8[8], t4[4], t2[2], t1;
#pragma unroll
            for (int j = 0; j < 8; ++j) { const float snd = b5 ? s16[j] : s16[8 + j], mine = b5 ? s16[8 + j] : s16[j]; t8[j] = mine + __shfl_xor(snd, 32); }
#pragma unroll
            for (int j = 0; j < 4; ++j) { const float snd = b4 ? t8[j] : t8[4 + j], mine = b4 ? t8[4 + j] : t8[j]; t4[j] = mine + __shfl_xor(snd, 16); }
#pragma unroll
            for (int j = 0; j < 2; ++j) { const float snd = b3 ? t4[j] : t4[2 + j], mine = b3 ? t4[2 + j] : t4[j]; t2[j] = mine + __shfl_xor(snd, 8); }
            { const float snd = b2 ? t2[0] : t2[1], mine = b2 ? t2[1] : t2[0]; t1 = mine + __shfl_xor(snd, 4); }
            t1 += __shfl_xor(t1, 2); t1 += __shfl_xor(t1, 1);
            if ((lane & 3) == 0) { const int o = lane >> 2; float res;
                if (o < 8) { const float A = __expf(p.a_log[o]); const float xx = t1 + p.dt_bias[o]; const float sp = xx > 20.f ? xx : log1pf(__expf(xx)); res = -A * sp; }
                else res = 1.f / (1.f + __expf(-t1));
                ((float*)(p.ws + WS_GB))[(size_t)r * 16 + o] = res; }
        }
    }
#undef MOD_XPTR
#undef MOD_LOADX
}
#define XB_TMO      128
#define XB_XCNT(j)  (256  + 64 * (j))
#define XB_XSUB(j)  (1280 + 64 * (j))
#define XB_XGEN(j)  (2304 + 64 * (j))
#define XB_TOP      3328
#define XB_TOPGEN   3392
#define XCD_BAR_WORDS 3456
#define XB_SPIN_CAP (1u << 18)

__device__ __forceinline__ unsigned xb_ld(unsigned* p)              { return __hip_atomic_load(p, __ATOMIC_RELAXED, __HIP_MEMORY_SCOPE_AGENT); }
__device__ __forceinline__ unsigned xb_add(unsigned* p, unsigned v) { return __hip_atomic_fetch_add(p, v, __ATOMIC_RELAXED, __HIP_MEMORY_SCOPE_AGENT); }
__device__ __forceinline__ unsigned xb_xcc_id() { return (unsigned)__builtin_amdgcn_s_getreg((3 << 11) | 20) & 0xFu; }
#define XB_SPIN(cond, bar) do { unsigned _sp = 0; while (cond) { __builtin_amdgcn_s_sleep(1); \
    if ((++_sp & 255u) == 0u) { if (xb_ld(&(bar)[XB_TMO])) break; if (_sp > XB_SPIN_CAP) { atomicAdd(&(bar)[XB_TMO], 1u); break; } } } } while (0)

struct XcdBarrier {
    unsigned* bar; unsigned x;
    volatile LAS unsigned* st;
};

__device__ __forceinline__ XcdBarrier xcd_barrier_post(unsigned* bar, volatile LAS unsigned* st) {
    XcdBarrier b; b.bar = bar; b.x = xb_xcc_id(); b.st = st;
    if (threadIdx.x == 0) (void)xb_add(&bar[XB_XCNT(b.x)], 1u);
    return b;
}
__device__ __forceinline__ void xcd_barrier_complete(unsigned* bar, unsigned x, unsigned& nloc, unsigned& nx) {
    const unsigned G = gridDim.x * gridDim.y * gridDim.z;
    unsigned sum, cnt, mine, sp = 0u;
    for (;;) {
        sum = 0u; cnt = 0u; mine = 0u;
#pragma unroll
        for (unsigned j = 0; j < 16; ++j) { const unsigned c = xb_ld(&bar[XB_XCNT(j)]); sum += c; cnt += (c > 0u) ? 1u : 0u; mine = (j == x) ? c : mine; }
        if (sum == G) break;
        __builtin_amdgcn_s_sleep(1);
        if ((++sp & 255u) == 0u) { if (xb_ld(&bar[XB_TMO])) break; if (sp > XB_SPIN_CAP) { atomicAdd(&bar[XB_TMO], 1u); break; } }
    }
    nloc = mine > 0u ? mine : 1u; nx = cnt > 0u ? cnt : 1u;
}

__device__ __forceinline__ void xcd_barrier(const XcdBarrier& b) {
    asm volatile("s_waitcnt vmcnt(0)" ::: "memory");
    __syncthreads();
    if (threadIdx.x == 0) {
        unsigned* bar = b.bar;
        __builtin_amdgcn_s_waitcnt(0);
        unsigned nloc = b.st[0], nx = b.st[1];
        if (nloc == 0u) { xcd_barrier_complete(bar, b.x, nloc, nx); b.st[0] = nloc; b.st[1] = nx; }
        const unsigned old = xb_add(&bar[XB_XSUB(b.x)], 1u);
        const unsigned gen = old / nloc;
        if (old + 1u == (gen + 1u) * nloc) {
            __builtin_amdgcn_fence(__ATOMIC_RELEASE, "agent");
            asm volatile("s_waitcnt vmcnt(0)" ::: "memory");
            const unsigned og = xb_add(&bar[XB_TOP], 1u);
            const unsigned tg = og / nx;
            if (og + 1u == (tg + 1u) * nx) xb_add(&bar[XB_TOPGEN], 1u);
            else XB_SPIN(xb_ld(&bar[XB_TOPGEN]) == tg, bar);
            __builtin_amdgcn_fence(__ATOMIC_ACQUIRE, "agent");
            xb_add(&bar[XB_XGEN(b.x)], 1u);
            asm volatile("s_waitcnt vmcnt(0)" ::: "memory");
        } else {
            XB_SPIN(xb_ld(&bar[XB_XGEN(b.x)]) == gen, bar);
            __builtin_amdgcn_fence(__ATOMIC_ACQUIRE, "agent");
            asm volatile("s_waitcnt vmcnt(0)" ::: "memory");
        }
    }
    __syncthreads();
}

#ifdef PROBE_TS
#define SEC(slot) do { if (blockIdx.x == 0 && threadIdx.x == 0) { unsigned long long* TS_ = (unsigned long long*)(p.ws + WS_DL + 512 * 1024); const unsigned long long t_ = __builtin_amdgcn_s_memrealtime(); TS_[(slot)] += t_ - TS_[31]; TS_[31] = t_; } } while (0)
#define SEC0() do { if (blockIdx.x == 0 && threadIdx.x == 0) { unsigned long long* TS_ = (unsigned long long*)(p.ws + WS_DL + 512 * 1024); TS_[31] = __builtin_amdgcn_s_memrealtime(); } } while (0)
#else
#define SEC(slot) do { } while (0)
#define SEC0() do { } while (0)
#endif
#define MFMA16(a, b, c) __builtin_amdgcn_mfma_f32_16x16x32_bf16((a), (b), (c), 0, 0, 0)
__device__ __forceinline__ bf16x8 lds_frag16(const LAS unsigned char* base) { return *(const LAS bf16x8*)base; }
__device__ __forceinline__ bf16x8 lds_frag8x2(const LAS unsigned char* lo, const LAS unsigned char* hi) {
    const u32x2 a = *(const LAS u32x2*)lo, b = *(const LAS u32x2*)hi; u32x4 w; w.x = a.x; w.y = a.y; w.z = b.x; w.w = b.y; return as_bf16x8(w); }
__device__ __forceinline__ bf16x8 pack_acc2(const f32x4 a, const f32x4 b) { u32x4 w; w.x = cvt_pk_bf16(a[0], a[1]); w.y = cvt_pk_bf16(a[2], a[3]); w.z = cvt_pk_bf16(b[0], b[1]); w.w = cvt_pk_bf16(b[2], b[3]); return as_bf16x8(w); }

constexpr int PL_QL = 0, PL_KL = 17408, PL_RT = 34816, PL_KDT = 71680, PL_AM = 90112  , PL_TB = 106752, PL_GS = 115968, PL_CW = 116992, PL_TM = 123136  ,
    PL_UTS = 0  , PL_WNS = 123136  , PL_QKS = 140544  ;
__device__ __forceinline__ void gdn_prep_stage_cw(const Params& p, int h, LAS unsigned char* lds, int tid) {
    for (int idx = tid; idx < 1536; idx += 512) { const int i = idx / 384, rem = idx - 384 * i, arr = rem >> 7, ch = rem & 127; ((LAS float*)(lds + PL_CW))[idx] = p.conv_w[i * 3072 + arr * 1024 + h * 128 + ch]; }
}
__device__ __forceinline__ void gdn_prep_item(const Params& p, int g, int cu, int h, LAS unsigned char* lds, int tid, int wave, int lane) {
    const bool is_sample = cu >= 256; const int cl = is_sample ? 0 : (cu & 15), c = is_sample ? 0 : 16 * g + cl; const int lr0 = 64 * cu;
    const int bseq = is_sample ? (cu - 256) : (cu >> 4);
    const bf16* PROJ = (const bf16*)(p.ws + WS_BIG); bf16* HALO = (bf16*)(p.ws + WS_HALO);
    unsigned char* ex = p.ws + WS_EX + (size_t)(cu * 8 + h) * EX_ITEM;
    LAS float* GS = (LAS float*)(lds + PL_GS);
    const int fr = lane & 15, fq = lane >> 4;
    const int r = tid >> 3, ch0 = (tid & 7) * 16;
    u32x4 raw[3][4][2];
#pragma unroll
    for (int arr = 0; arr < 3; ++arr)
#pragma unroll
        for (int i = 0; i < 4; ++i) {
            const int rr = r - 3 + i, col = arr * 1024 + h * 128 + ch0;
            if (rr >= 0 || cl > 0) { const bf16* src = PROJ + (size_t)(lr0 + rr) * NPROJ + col; raw[arr][i][0] = *(const u32x4*)src; raw[arr][i][1] = *(const u32x4*)(src + 8); }
            else if (!is_sample && g == 1) { const bf16* src = HALO + ((size_t)bseq * 3 + (3 + rr)) * 3072 + col; raw[arr][i][0] = *(const u32x4*)src; raw[arr][i][1] = *(const u32x4*)(src + 8); }
            else if (is_sample) { const float* src = p.state_conv + ((size_t)bseq * 3 + (3 + rr)) * 3072 + col; float t[8];
#pragma unroll
                for (int hh = 0; hh < 2; ++hh) { const f32x4 t0 = *(const f32x4*)(src + 8 * hh), t1 = *(const f32x4*)(src + 8 * hh + 4);
#pragma unroll
                    for (int j = 0; j < 4; ++j) { t[j] = t0[j]; t[4 + j] = t1[j]; }
                    raw[arr][i][hh] = pack8(t); }
            } else { raw[arr][i][0] = (u32x4){0u, 0u, 0u, 0u}; raw[arr][i][1] = (u32x4){0u, 0u, 0u, 0u}; }
        }
    {
        const float* GB = (const float*)(p.ws + WS_GB) + (size_t)(lr0 + lane) * 16;
        float gv = GB[h]; const float bt = GB[8 + h];
#pragma unroll
        for (int o = 1; o < 64; o <<= 1) { const float t = __shfl_up(gv, o); if (lane >= o) gv += t; }
        GS[lane] = gv; GS[64 + lane] = bt;
    }
    {
        const float Gr = GS[r], Gl = GS[63], br = GS[64 + r];
        const float eg = __expf(Gr), egl = __expf(Gl - Gr);
        const bool lastc = is_sample || c == 31;
#pragma unroll
        for (int arr = 0; arr < 3; ++arr) {
            const int col = arr * 1024 + h * 128 + ch0;
            float acc[16];
#pragma unroll
            for (int j = 0; j < 16; ++j) acc[j] = 0.f;
#pragma unroll
            for (int i = 0; i < 4; ++i) {
                float x[16]; { float t[8]; unpack8(raw[arr][i][0], t);
#pragma unroll
                    for (int j = 0; j < 8; ++j) x[j] = t[j];
                    unpack8(raw[arr][i][1], t);
#pragma unroll
                    for (int j = 0; j < 8; ++j) x[8 + j] = t[j]; }
                const LAS float* wsrc = (const LAS float*)(lds + PL_CW) + (i * 3 + arr) * 128 + ch0;
#pragma unroll
                for (int j4 = 0; j4 < 4; ++j4) { const f32x4 w = *(const LAS f32x4*)(wsrc + 4 * j4);
#pragma unroll
                    for (int e = 0; e < 4; ++e) acc[4 * j4 + e] += x[4 * j4 + e] * w[e]; }
                if (i == 3 && g == 0 && !is_sample && cl == 15 && r >= 61) {
                    bf16* hd = HALO + ((size_t)bseq * 3 + (r - 61)) * 3072 + col; *(u32x4*)hd = raw[arr][3][0]; *(u32x4*)(hd + 8) = raw[arr][3][1]; }
                if (i == 3 && lastc && r >= 61) {
                    float* o = p.out + (is_sample ? O_CONVS : O_CONVP) + ((size_t)bseq * 3 + (r - 61)) * 3072 + col;
#pragma unroll
                    for (int j4 = 0; j4 < 4; ++j4) *(f32x4*)(o + 4 * j4) = (f32x4){x[4 * j4], x[4 * j4 + 1], x[4 * j4 + 2], x[4 * j4 + 3]};
                }
            }
            float ss = 0.f;
#pragma unroll
            for (int j = 0; j < 16; ++j) { acc[j] = siluf_(acc[j]); ss += acc[j] * acc[j]; }
            if (arr < 2) { ss += __shfl_xor(ss, 1); ss += __shfl_xor(ss, 2); ss += __shfl_xor(ss, 4);
                const float sc = rsqrtf(ss + EPS) * (arr == 0 ? 0.08838834764831845f : 1.f);
#pragma unroll
                for (int j = 0; j < 16; ++j) acc[j] *= sc; }
            if (arr == 0) {
                float t[8];
#pragma unroll
                for (int hh = 0; hh < 2; ++hh) {
#pragma unroll
                    for (int j = 0; j < 8; ++j) t[j] = acc[8 * hh + j];
                    *(LAS u32x4*)(lds + PL_QL + r * 272 + (ch0 + 8 * hh) * 2) = pack8(t);
#pragma unroll
                    for (int j = 0; j < 8; ++j) t[j] = acc[8 * hh + j] * eg;
                    *(u32x4*)(ex + EX_QD + r * 256 + (ch0 + 8 * hh) * 2) = pack8(t);
                }
            } else if (arr == 1) {
                float t[8];
#pragma unroll
                for (int hh = 0; hh < 2; ++hh) {
#pragma unroll
                    for (int j = 0; j < 8; ++j) t[j] = acc[8 * hh + j];
                    *(LAS u32x4*)(lds + PL_KL + r * 272 + (ch0 + 8 * hh) * 2) = pack8(t);
                }
                const float wsc = br * eg;
#pragma unroll
                for (int j = 0; j < 16; ++j) {
                    *(LAS unsigned short*)(lds + PL_KDT + (ch0 + j) * 144 + r * 2) = f2bf(acc[j] * egl);
                    *(LAS unsigned short*)(lds + PL_RT + (128 + ch0 + j) * 144 + r * 2) = f2bf(acc[j] * wsc);
                }
            } else {
#pragma unroll
                for (int j = 0; j < 16; ++j) *(LAS unsigned short*)(lds + PL_RT + (ch0 + j) * 144 + r * 2) = f2bf(acc[j] * br);
            }
            __builtin_amdgcn_sched_barrier(0);
        }
    }
    __syncthreads();
    {
#pragma unroll
        for (int n = 0; n < 4; ++n) {
            const int job = wave * 4 + n, typ = job >> 4, t = job & 15, ib = t >> 2, jb = t & 3;
            if (jb > ib) continue;
            f32x4 acc = (f32x4){0.f, 0.f, 0.f, 0.f};
            if (typ == 0) {
#pragma unroll
                for (int ks = 0; ks < 4; ++ks) { const bf16x8 a = lds_frag16(lds + PL_KL + (16 * ib + fr) * 272 + (32 * ks + 8 * fq) * 2), b = lds_frag16(lds + PL_KL + (16 * jb + fr) * 272 + (32 * ks + 8 * fq) * 2);
                    acc = MFMA16(a, b, acc); }
                const int j = 16 * jb + fr; const float Gj = GS[j];
#pragma unroll
                for (int e = 0; e < 4; ++e) { const int i = 16 * ib + 4 * fq + e; const float v = (j < i) ? GS[64 + i] * acc[e] * __expf(GS[i] - Gj) : 0.f; *(LAS float*)(lds + PL_AM + (i * 65 + j) * 4) = v; }
            } else {
#pragma unroll
                for (int ks = 0; ks < 4; ++ks) { const bf16x8 a = lds_frag16(lds + PL_KL + (16 * jb + fr) * 272 + (32 * ks + 8 * fq) * 2), b = lds_frag16(lds + PL_QL + (16 * ib + fr) * 272 + (32 * ks + 8 * fq) * 2);
                    acc = MFMA16(a, b, acc); }
                const int i = 16 * ib + fr; const float Gi = GS[i]; float v[4];
#pragma unroll
                for (int e = 0; e < 4; ++e) { const int j = 16 * jb + 4 * fq + e; v[e] = (j <= i) ? acc[e] * __expf(Gi - GS[j]) : 0.f; }
                u32x2 o; o.x = cvt_pk_bf16(v[0], v[1]); o.y = cvt_pk_bf16(v[2], v[3]);
                *(LAS u32x2*)(lds + PL_QKS + i * 144 + (16 * jb + 4 * fq) * 2) = o;
            }
        }
#pragma unroll
        for (int n = 0; n < 4; ++n) {
            const int job = wave * 4 + n, typ = job >> 4, t = job & 15, ib = t >> 2, jb = t & 3;
            if (jb <= ib) continue;
            if (typ == 0) { } else { u32x2 o; o.x = 0u; o.y = 0u; *(LAS u32x2*)(lds + PL_QKS + (16 * ib + fr) * 144 + (16 * jb + 4 * fq) * 2) = o; }
        }
    }
    __syncthreads();
    {
        const LAS float* AMf = (const LAS float*)(lds + PL_AM); LAS float* TMf = (LAS float*)(lds + PL_TM);
        if (wave < 4) {
            const int b0 = 16 * wave; float t[16];
            const LAS float* arow = AMf + b0 * 65 + b0;
#pragma unroll
            for (int i = 0; i < 16; ++i) {
                float sacc_ = fmaxf(1.f - fabsf((float)fr - (float)i), 0.f);
#pragma unroll
                for (int j = 0; j < i; ++j) sacc_ -= arow[i * 65 + j] * t[j];
                t[i] = sacc_;
                if (fq == 0) TMf[(b0 + i) * 65 + b0 + fr] = sacc_;
            }
        } else {
            if (wave == 7 && lane == 0) ((float*)(p.ws + WS_DL))[cu * 8 + h] = __expf(GS[63]);
            const int t2 = tid - 256;
#pragma unroll
            for (int k = 0; k < 4; ++k) { const int idx = t2 + 256 * k, d = idx >> 3, c8 = idx & 7;
                *(u32x4*)(ex + EX_KDT + d * 128 + c8 * 16) = *(const LAS u32x4*)(lds + PL_KDT + d * 144 + c8 * 16); }
#pragma unroll
            for (int k = 0; k < 2; ++k) { const int idx = t2 + 256 * k;
                *(u32x4*)(ex + EX_QK + (idx >> 3) * 128 + (idx & 7) * 16) = *(const LAS u32x4*)(lds + PL_QKS + (idx >> 3) * 144 + (idx & 7) * 16); }
        }
        __syncthreads();
#pragma unroll
        for (int dd = 1; dd < 4; ++dd) {
            if (wave < 4 - dd) {
                const int J = wave, I = wave + dd;
                f32x4 c4 = (f32x4){0.f, 0.f, 0.f, 0.f};
#pragma unroll
                for (int kk = 0; kk < dd; ++kk) { const int K = J + kk;
#pragma unroll
                    for (int k0 = 0; k0 < 16; k0 += 4) { const float a = AMf[(16 * I + fr) * 65 + 16 * K + k0 + fq], b = TMf[(16 * K + k0 + fq) * 65 + 16 * J + fr];
                        c4 = __builtin_amdgcn_mfma_f32_16x16x4f32(a, b, c4, 0, 0, 0); } }
                f32x4 r4 = (f32x4){0.f, 0.f, 0.f, 0.f};
#pragma unroll
                for (int s4 = 0; s4 < 4; ++s4) { const float a = TMf[(16 * I + fr) * 65 + 16 * I + 4 * fq + s4]; r4 = __builtin_amdgcn_mfma_f32_16x16x4f32(a, c4[s4], r4, 0, 0, 0); }
#pragma unroll
                for (int j = 0; j < 4; ++j) TMf[(16 * I + 4 * fq + j) * 65 + 16 * J + fr] = -r4[j];
            }
            __syncthreads();
        }
        {   const int i = tid >> 3, j0 = (tid & 7) * 8; float v[8];
#pragma unroll
            for (int jj = 0; jj < 8; ++jj) v[jj] = ((j0 >> 4) > (i >> 4)) ? 0.f : TMf[i * 65 + j0 + jj];
            *(LAS u32x4*)(lds + PL_TB + i * 144 + j0 * 2) = pack8(v); }
    }
    __syncthreads();
    {
#pragma unroll
        for (int mb = 0; mb < 4; ++mb) {
            f32x4 au = (f32x4){0.f, 0.f, 0.f, 0.f}, aw = (f32x4){0.f, 0.f, 0.f, 0.f};
#pragma unroll
            for (int ks = 0; ks < 2; ++ks) {
                const bf16x8 tf = lds_frag16(lds + PL_TB + (16 * mb + fr) * 144 + (32 * ks + 8 * fq) * 2);
                const bf16x8 rv = lds_frag16(lds + PL_RT + (16 * wave + fr) * 144 + (32 * ks + 8 * fq) * 2);
                const bf16x8 rk = lds_frag16(lds + PL_RT + (128 + 16 * wave + fr) * 144 + (32 * ks + 8 * fq) * 2);
                au = MFMA16(tf, rv, au);
                aw = MFMA16(rk, tf, aw);
            }
            u32x2 o; o.x = cvt_pk_bf16(au[0], au[1]); o.y = cvt_pk_bf16(au[2], au[3]);
            *(LAS u32x2*)(lds + PL_UTS + (16 * wave + fr) * 144 + (16 * mb + 4 * fq) * 2) = o;
            o.x = cvt_pk_bf16(-aw[0], -aw[1]); o.y = cvt_pk_bf16(-aw[2], -aw[3]);
            *(LAS u32x2*)(lds + PL_WNS + (16 * mb + fr) * 272 + (16 * wave + 4 * fq) * 2) = o;
        }
    }
    __syncthreads();
    {
#pragma unroll
        for (int k = 0; k < 2; ++k) { const int idx = tid + 512 * k;
            *(u32x4*)(ex + EX_UT + (idx >> 3) * 128 + (idx & 7) * 16) = *(const LAS u32x4*)(lds + PL_UTS + (idx >> 3) * 144 + (idx & 7) * 16);
            *(u32x4*)(ex + EX_WN + (idx >> 4) * 256 + (idx & 15) * 16) = *(const LAS u32x4*)(lds + PL_WNS + (idx >> 4) * 272 + (idx & 15) * 16); }
    }
    __syncthreads();
}

constexpr int SL_K = 0, SL_V = 27648;
__device__ __forceinline__ void swa_item(const Params& p, int g, int cu, int kvh, LAS unsigned char* lds, int tid, int wave, int lane) {
    const bool is_sample = cu >= 256; const int cl = is_sample ? 0 : (cu & 15), c = is_sample ? 0 : 16 * g + cl; const int lr0 = 64 * cu;
    const int bseq = is_sample ? (cu - 256) : (cu >> 4);
    const int nkc = is_sample ? 3 : (c < 2 ? c + 1 : 3);
    bf16* PROJ = (bf16*)(p.ws + WS_BIG); bf16* KVT = (bf16*)(p.ws + WS_KVT);
    const int fr = lane & 15, fq = lane >> 4;
    const int hq = kvh * 4 + (wave >> 1), t0 = 32 * (wave & 1);
    u32x4 qr[2][2];
#pragma unroll
    for (int mb = 0; mb < 2; ++mb) { const bf16* qsrc = PROJ + (size_t)(lr0 + t0 + 16 * mb + fr) * NPROJ + PC_QS + hq * 64 + 8 * fq; qr[mb][0] = *(const u32x4*)qsrc; qr[mb][1] = *(const u32x4*)(qsrc + 32); }
    const f32x4 qn00 = *(const f32x4*)(p.q_norm + 8 * fq), qn01 = *(const f32x4*)(p.q_norm + 8 * fq + 4), qn10 = *(const f32x4*)(p.q_norm + 32 + 8 * fq), qn11 = *(const f32x4*)(p.q_norm + 32 + 8 * fq + 4);
    const float sink = p.sinks[hq];
    {
        const int row = tid >> 3, d8 = tid & 7;
        const f32x4 kn0 = *(const f32x4*)(p.k_norm + d8 * 8), kn1 = *(const f32x4*)(p.k_norm + d8 * 8 + 4);
        u32x4 kr[3], vr[3]; f32x4 ck[2][2], cv[2][2];
#pragma unroll
        for (int s = 0; s < 3; ++s) {
            if (s >= nkc) continue;
            if (is_sample && s < 2) {
                const size_t off = (((size_t)bseq * 128 + 64 * s + row) * 4 + kvh) * 64 + d8 * 8;
                ck[s][0] = *(const f32x4*)(p.cache_k + off); ck[s][1] = *(const f32x4*)(p.cache_k + off + 4); cv[s][0] = *(const f32x4*)(p.cache_v + off); cv[s][1] = *(const f32x4*)(p.cache_v + off + 4);
            } else if (!is_sample && cl - (nkc - 1 - s) < 0) {
                const bf16* src = KVT + ((size_t)bseq * 128 + 64 * (cl - (nkc - 1 - s) + 2) + row) * 512 + kvh * 64 + d8 * 8; kr[s] = *(const u32x4*)src; vr[s] = *(const u32x4*)(src + 256);
            } else {
                const int lrk = lr0 - 64 * (nkc - 1 - s) + row;
                kr[s] = *(const u32x4*)(PROJ + (size_t)lrk * NPROJ + PC_KS + kvh * 64 + d8 * 8); vr[s] = *(const u32x4*)(PROJ + (size_t)lrk * NPROJ + PC_VS + kvh * 64 + d8 * 8);
            }
        }
#pragma unroll
        for (int s = 0; s < 3; ++s) {
            if (s >= nkc) continue;
            float kv[8], vv[8];
            if (is_sample && s < 2) {
                if (s < 2) {
#pragma unroll
                    for (int j = 0; j < 4; ++j) { kv[j] = ck[s < 2 ? s : 0][0][j]; kv[4 + j] = ck[s < 2 ? s : 0][1][j]; vv[j] = cv[s < 2 ? s : 0][0][j]; vv[4 + j] = cv[s < 2 ? s : 0][1][j]; }
                }
                if (s == 1) { const size_t oo = (((size_t)bseq * 128 + row) * 4 + kvh) * 64 + d8 * 8;
                    *(f32x4*)(p.out + O_KS + oo) = ck[1][0]; *(f32x4*)(p.out + O_KS + oo + 4) = ck[1][1]; *(f32x4*)(p.out + O_VS + oo) = cv[1][0]; *(f32x4*)(p.out + O_VS + oo + 4) = cv[1][1]; }
            } else if (!is_sample && cl - (nkc - 1 - s) < 0) {
                unpack8(kr[s], kv); unpack8(vr[s], vv);
            } else {
                unpack8(kr[s], kv); unpack8(vr[s], vv);
                float ss = 0.f;
#pragma unroll
                for (int j = 0; j < 8; ++j) ss += kv[j] * kv[j];
                ss += __shfl_xor(ss, 1); ss += __shfl_xor(ss, 2); ss += __shfl_xor(ss, 4);
                const float sc = rsqrtf(ss * (1.f / 64.f) + EPS);
#pragma unroll
                for (int j = 0; j < 4; ++j) { kv[j] *= sc * kn0[j]; kv[4 + j] *= sc * kn1[j]; }
                if (s == nkc - 1 && !is_sample && g == 0 && cl >= 14) {
                    bf16* dst = KVT + ((size_t)bseq * 128 + 64 * (cl - 14) + row) * 512 + kvh * 64 + d8 * 8; *(u32x4*)dst = pack8(kv); *(u32x4*)(dst + 256) = pack8(vv); }
                if (s == nkc - 1 && (is_sample || c >= 30)) {
                    const int orow = is_sample ? 64 + row : 64 * (c - 30) + row;
                    const size_t oo = (((size_t)bseq * 128 + orow) * 4 + kvh) * 64 + d8 * 8;
                    float* ok = p.out + (is_sample ? O_KS : O_KP) + oo; float* ov = p.out + (is_sample ? O_VS : O_VP) + oo;
                    *(f32x4*)ok = (f32x4){kv[0], kv[1], kv[2], kv[3]}; *(f32x4*)(ok + 4) = (f32x4){kv[4], kv[5], kv[6], kv[7]};
                    *(f32x4*)ov = (f32x4){vv[0], vv[1], vv[2], vv[3]}; *(f32x4*)(ov + 4) = (f32x4){vv[4], vv[5], vv[6], vv[7]};
                }
            }
            const int key = 64 * s + row;
            *(LAS u32x4*)(lds + SL_K + key * 144 + d8 * 16) = pack8(kv);
#pragma unroll
            for (int j = 0; j < 8; ++j) *(LAS unsigned short*)(lds + SL_V + (d8 * 8 + j) * 392 + key * 2) = f2bf(vv[j]);
        }
    }
    __syncthreads();
    bf16x8 qf[2][2];
#pragma unroll
    for (int mb = 0; mb < 2; ++mb) {
        float q0[8], q1[8]; unpack8(qr[mb][0], q0); unpack8(qr[mb][1], q1);
        float ss = 0.f;
#pragma unroll
        for (int j = 0; j < 8; ++j) ss += q0[j] * q0[j] + q1[j] * q1[j];
        ss += __shfl_xor(ss, 16); ss += __shfl_xor(ss, 32);
        const float sc = rsqrtf(ss * (1.f / 64.f) + EPS) * 0.125f;
#pragma unroll
        for (int j = 0; j < 4; ++j) { q0[j] *= sc * qn00[j]; q0[4 + j] *= sc * qn01[j]; q1[j] *= sc * qn10[j]; q1[4 + j] *= sc * qn11[j]; }
        qf[mb][0] = as_bf16x8(pack8(q0)); qf[mb][1] = as_bf16x8(pack8(q1));
    }
    f32x4 sacc[12][2];
#pragma unroll
    for (int nb = 0; nb < 12; ++nb) {
#pragma unroll
        for (int mb = 0; mb < 2; ++mb) sacc[nb][mb] = (f32x4){0.f, 0.f, 0.f, 0.f};
        if (nb < 4 * nkc) {
#pragma unroll
            for (int ks = 0; ks < 2; ++ks) { const bf16x8 a = lds_frag16(lds + SL_K + (16 * nb + fr) * 144 + (32 * ks + 8 * fq) * 2);
#pragma unroll
                for (int mb = 0; mb < 2; ++mb) sacc[nb][mb] = MFMA16(a, qf[mb][ks], sacc[nb][mb]); }
        }
    }
    float inv[2];
#pragma unroll
    for (int mb = 0; mb < 2; ++mb) {
        float mx = sink;
#pragma unroll
        for (int nb = 0; nb < 12; ++nb) if (nb < 4 * nkc) {
#pragma unroll
            for (int e = 0; e < 4; ++e) mx = fmaxf(mx, sacc[nb][mb][e]); }
        mx = fmaxf(mx, __shfl_xor(mx, 16)); mx = fmaxf(mx, __shfl_xor(mx, 32));
        float sum = 0.f;
#pragma unroll
        for (int nb = 0; nb < 12; ++nb) {
#pragma unroll
            for (int e = 0; e < 4; ++e) { const float pv = (nb < 4 * nkc) ? __expf(sacc[nb][mb][e] - mx) : 0.f; sacc[nb][mb][e] = pv; sum += pv; } }
        sum += __shfl_xor(sum, 16); sum += __shfl_xor(sum, 32);
        inv[mb] = 1.f / (sum + __expf(sink - mx));
    }
    f32x4 oacc[4][2];
#pragma unroll
    for (int db = 0; db < 4; ++db)
#pragma unroll
        for (int mb = 0; mb < 2; ++mb) oacc[db][mb] = (f32x4){0.f, 0.f, 0.f, 0.f};
#pragma unroll
    for (int ks2 = 0; ks2 < 6; ++ks2) {
        if (ks2 < 2 * nkc) {
            bf16x8 bp[2];
#pragma unroll
            for (int mb = 0; mb < 2; ++mb) bp[mb] = pack_acc2(sacc[2 * ks2][mb], sacc[2 * ks2 + 1][mb]);
#pragma unroll
            for (int db = 0; db < 4; ++db) {
                const LAS unsigned char* vb = lds + SL_V + (16 * db + fr) * 392 + (32 * ks2 + 4 * fq) * 2;
                const bf16x8 a = lds_frag8x2(vb, vb + 32);
#pragma unroll
                for (int mb = 0; mb < 2; ++mb) oacc[db][mb] = MFMA16(a, bp[mb], oacc[db][mb]);
            }
        }
    }
#pragma unroll
    for (int mb = 0; mb < 2; ++mb) {
        bf16* od = PROJ + (size_t)(lr0 + t0 + 16 * mb + fr) * NPROJ + PC_QS + hq * 64 + 4 * fq;
#pragma unroll
        for (int db = 0; db < 4; ++db) { const f32x4 v = oacc[db][mb] * inv[mb]; u32x2 o; o.x = cvt_pk_bf16(v[0], v[1]); o.y = cvt_pk_bf16(v[2], v[3]); *(u32x2*)(od + 16 * db) = o; }
    }
    __syncthreads();
}

constexpr int CL_WN = 0, CL_QD = 17408, CL_UT = 34816, CL_KDT = 52224, CL_QK = 69632, CL_OT = 78336, CL_SSQ = 112128, CL_DL = 114176, CL_PR = 114304;
__device__ __forceinline__ void scan_chain(const Params& p, int g, int s, int h, LAS unsigned char* lds, int tid, int wave, int lane) {
    const bool is_sample = s >= 16; const int nsteps = is_sample ? 1 : 16; const int cu0 = is_sample ? 256 + (s - 16) : 16 * s;
    const int bseq = is_sample ? (s - 16) : s;
    const int fr = lane & 15, fq = lane >> 4;
    bf16* PROJ = (bf16*)(p.ws + WS_BIG);
    const float* DL = (const float*)(p.ws + WS_DL);
    f32x4 sacc[8];
    const int e = 16 * wave + fr;
    if (is_sample || g == 1) { const float* S0 = (is_sample ? p.state_gdn : p.out + O_GDNP) + ((size_t)bseq * 8 + h) * 16384;
#pragma unroll
        for (int db = 0; db < 8; ++db) { const float* pb = S0 + (4 * fq) * 128 + e + db * 2048; asm volatile("" : "+v"(pb));
#pragma unroll
            for (int j = 0; j < 4; ++j) sacc[db][j] = pb[j * 128]; }
    } else {
#pragma unroll
        for (int db = 0; db < 8; ++db) sacc[db] = (f32x4){0.f, 0.f, 0.f, 0.f};
    }
    u32x4 pf[9];
    const unsigned char* exb = p.ws + WS_EX + (size_t)(cu0 * 8 + h) * EX_ITEM;
#define SCAN_LOAD(ptr) do { _Pragma("unroll") for (int k = 0; k < 9; ++k) pf[k] = *(const u32x4*)((ptr) + (size_t)(tid + 512 * k) * 16); } while (0)
#define SCAN_STORE() do { _Pragma("unroll") for (int k = 0; k < 9; ++k) { const int off = (tid + 512 * k) * 16, wi = off & 16383; \
        if (k == 2 || k == 3) *(LAS u32x4*)(lds + CL_WN + (wi >> 8) * 272 + (wi & 255)) = pf[k]; \
        else if (k == 4 || k == 5) *(LAS u32x4*)(lds + CL_QD + (wi >> 8) * 272 + (wi & 255)) = pf[k]; \
        else { const int base = (k < 2) ? CL_UT : (k < 8 ? CL_KDT : CL_QK); LAS unsigned char* d = lds + base + (wi >> 7) * 136 + (wi & 127); \
            u32x2 lo, hi; lo.x = pf[k].x; lo.y = pf[k].y; hi.x = pf[k].z; hi.y = pf[k].w; *(LAS u32x2*)d = lo; *(LAS u32x2*)(d + 8) = hi; } } } while (0)
    SCAN_LOAD(exb); SCAN_STORE();
    if (tid < nsteps) *(LAS float*)(lds + CL_DL + tid * 4) = DL[(cu0 + tid) * 8 + h];
    if (tid < 384) { const int w3 = tid >> 7, cc = tid & 127; *(LAS float*)(lds + CL_PR + tid * 4) = w3 == 0 ? p.gdn_norm[cc] : p.b_merge[(w3 - 1) * 1024 + h * 128 + cc]; }
    __syncthreads();
    u32x4 mg[4][2];
#define SCAN_MG(cu_) do { const bf16* prow = PROJ + (size_t)(64 * (cu_) + (tid >> 3)) * NPROJ + h * 128 + (tid & 7) * 16; _Pragma("unroll") for (int hh = 0; hh < 2; ++hh) { \
        mg[0][hh] = *(const u32x4*)(prow + PC_Z + 8 * hh); mg[1][hh] = *(const u32x4*)(prow + PC_GA + 8 * hh); mg[2][hh] = *(const u32x4*)(prow + PC_GB + 8 * hh); mg[3][hh] = *(const u32x4*)(prow + PC_QS + 8 * hh); } } while (0)
    SCAN_MG(cu0);
    if (nsteps > 1) SCAN_LOAD(exb + (size_t)8 * EX_ITEM);
    for (int st = 0; st < nsteps; ++st) {
        const int cu = cu0 + st, lr0 = 64 * cu;
        const float dl = *(const LAS float*)(lds + CL_DL + st * 4);
        bf16x8 Bs[4];
#pragma unroll
        for (int ks = 0; ks < 4; ++ks) Bs[ks] = pack_acc2(sacc[2 * ks], sacc[2 * ks + 1]);
        f32x4 vacc[4], oacc[4];
        bf16x8 FA[4], FB[4];
#define LD_W(F, mb) do { _Pragma("unroll") for (int ks = 0; ks < 4; ++ks) { const LAS unsigned char* wb = lds + CL_WN + (16 * (mb) + fr) * 272 + (32 * ks + 4 * fq) * 2; F[ks] = lds_frag8x2(wb, wb + 32); } } while (0)
#define LD_Q(F, mb) do { _Pragma("unroll") for (int ks = 0; ks < 4; ++ks) { const LAS unsigned char* qb = lds + CL_QD + (16 * (mb) + fr) * 272 + (32 * ks + 4 * fq) * 2; F[ks] = lds_frag8x2(qb, qb + 32); } } while (0)
#define LD_QK(F, m0) do { _Pragma("unroll") for (int mb = 0; mb < 2; ++mb) _Pragma("unroll") for (int k2 = 0; k2 < 2; ++k2) { \
            const LAS unsigned char* kb = lds + CL_QK + (16 * ((m0) + mb) + fr) * 136 + (32 * k2 + 4 * fq) * 2; F[2 * mb + k2] = lds_frag8x2(kb, kb + 32); } } while (0)
#define LD_KD(F, d0) do { _Pragma("unroll") for (int d = 0; d < 2; ++d) _Pragma("unroll") for (int k2 = 0; k2 < 2; ++k2) { \
            const LAS unsigned char* kb = lds + CL_KDT + (16 * ((d0) + d) + fr) * 136 + (32 * k2 + 4 * fq) * 2; F[2 * d + k2] = lds_frag8x2(kb, kb + 32); } } while (0)
#define MM_W(F, mb) do { _Pragma("unroll") for (int ks = 0; ks < 4; ++ks) vacc[mb] = MFMA16(F[ks], Bs[ks], vacc[mb]); } while (0)
#define MM_Q(F, mb) do { _Pragma("unroll") for (int ks = 0; ks < 4; ++ks) oacc[mb] = MFMA16(F[ks], Bs[ks], oacc[mb]); } while (0)
#define MM_QK(F, m0) do { _Pragma("unroll") for (int mb = 0; mb < 2; ++mb) _Pragma("unroll") for (int k2 = 0; k2 < 2; ++k2) oacc[(m0) + mb] = MFMA16(F[2 * mb + k2], Bv[k2], oacc[(m0) + mb]); } while (0)
#define MM_KD(F, d0) do { _Pragma("unroll") for (int d = 0; d < 2; ++d) { sacc[(d0) + d] = sacc[(d0) + d] * dl; _Pragma("unroll") for (int k2 = 0; k2 < 2; ++k2) sacc[(d0) + d] = MFMA16(F[2 * d + k2], Bv[k2], sacc[(d0) + d]); } } while (0)
#define SB() __builtin_amdgcn_sched_barrier(0)
#pragma unroll
        for (int mb = 0; mb < 4; ++mb) {
            const u32x2 uu = *(const LAS u32x2*)(lds + CL_UT + e * 136 + (16 * mb + 4 * fq) * 2);
            vacc[mb] = (f32x4){bflo(uu.x), bfhi(uu.x), bflo(uu.y), bfhi(uu.y)};
            oacc[mb] = (f32x4){0.f, 0.f, 0.f, 0.f};
        }
        LD_W(FA, 0); SB();
        LD_W(FB, 1); MM_W(FA, 0); SB();
        LD_W(FA, 2); MM_W(FB, 1); SB();
        LD_W(FB, 3); MM_W(FA, 2); SB();
        LD_Q(FA, 0); MM_W(FB, 3); SB();
        LD_Q(FB, 1); MM_Q(FA, 0); SB();
        LD_Q(FA, 2); MM_Q(FB, 1); SB();
        LD_Q(FB, 3); MM_Q(FA, 2); SB();
        LD_QK(FA, 0); MM_Q(FB, 3); SB();
        bf16x8 Bv[2];
#pragma unroll
        for (int k2 = 0; k2 < 2; ++k2) Bv[k2] = pack_acc2(vacc[2 * k2], vacc[2 * k2 + 1]);
        LD_QK(FB, 2); MM_QK(FA, 0); SB();
        LD_KD(FA, 0); MM_QK(FB, 2); SB();
        LD_KD(FB, 2); MM_KD(FA, 0); SB();
        LD_KD(FA, 4); MM_KD(FB, 2); SB();
        LD_KD(FB, 6); MM_KD(FA, 4); SB();
        MM_KD(FB, 6);
#undef LD_W
#undef LD_Q
#undef MM_W
#undef MM_Q
#undef MM_QK
#undef MM_KD
#undef SB
#undef LD_QK
#undef LD_KD
        SEC(16);
#pragma unroll
        for (int mb = 0; mb < 4; ++mb)
#pragma unroll
            for (int j = 0; j < 4; ++j) *(LAS float*)(lds + CL_OT + ((16 * mb + 4 * fq + j) * 132 + e) * 4) = oacc[mb][j];
        __syncthreads();
        SEC(17);
        if (st + 1 < nsteps) { SCAN_STORE(); if (st + 2 < nsteps) SCAN_LOAD(exb + (size_t)(st + 2) * 8 * EX_ITEM); }
        {
            const int i = tid >> 3, c0 = (tid & 7) * 16;
            f32x4 ov[4]; float ssq = 0.f;
#pragma unroll
            for (int q4 = 0; q4 < 4; ++q4) { ov[q4] = *(const LAS f32x4*)(lds + CL_OT + (i * 132 + c0 + 4 * q4) * 4); ssq += (ov[q4][0] * ov[q4][0] + ov[q4][1] * ov[q4][1]) + (ov[q4][2] * ov[q4][2] + ov[q4][3] * ov[q4][3]); }
            ssq += __shfl_xor(ssq, 1); ssq += __shfl_xor(ssq, 2); ssq += __shfl_xor(ssq, 4);
            const float rstd = rsqrtf(ssq * (1.f / 128.f) + EPS);
            const LAS float* PR = (const LAS float*)(lds + CL_PR);
#pragma unroll
            for (int hh = 0; hh < 2; ++hh) {
                float z[8], ga[8], gb[8], os[8], r[8];
                unpack8(mg[0][hh], z); unpack8(mg[1][hh], ga); unpack8(mg[2][hh], gb); unpack8(mg[3][hh], os);
#pragma unroll
                for (int j = 0; j < 8; ++j) { const int cc = c0 + 8 * hh + j;
                    const float o = ov[2 * hh + (j >> 2)][j & 3] * rstd * PR[cc] * siluf_(z[j]);
                    r[j] = sigmoidf_(ga[j] + PR[128 + cc]) * o + sigmoidf_(gb[j] + PR[256 + cc]) * os[j]; }
                *(u32x4*)(PROJ + (size_t)(lr0 + i) * NPROJ + PC_Z + h * 128 + c0 + 8 * hh) = pack8(r);
            }
        }
        if (st + 1 < nsteps) SCAN_MG(cu + 1);
        __syncthreads();
        SEC(18);
    }
    {   float* So = p.out + (is_sample ? O_GDNS : O_GDNP) + ((size_t)bseq * 8 + h) * 16384;
#pragma unroll
        for (int db = 0; db < 8; ++db) { float* pb = So + (4 * fq) * 128 + e + db * 2048; asm volatile("" : "+v"(pb));
#pragma unroll
            for (int j = 0; j < 4; ++j) pb[j * 128] = sacc[db][j]; }
    }
#undef SCAN_LOAD
#undef SCAN_STORE
}
__global__ void __launch_bounds__(512, 2) mega_fwd(Params p) {
    extern __shared__ __attribute__((aligned(16))) unsigned char lds_raw[];
    if (threadIdx.x < 4) ((LAS unsigned*)((LAS unsigned char*)lds_raw + LDS_BARST))[threadIdx.x] = 0u;
    __syncthreads();
    const XcdBarrier xbar = xcd_barrier_post((unsigned*)(p.ws + WS_BAR), (volatile LAS unsigned*)((LAS unsigned char*)lds_raw + LDS_BARST));
    LAS unsigned char* lds = (LAS unsigned char*)lds_raw;
    const int G = gridDim.x;
    unsigned char* ws = p.ws;
    float* MOD = (float*)(ws + WS_MOD);
    bf16* H = (bf16*)(ws + WS_H); bf16* ACT = (bf16*)(ws + WS_BIG); bf16* PROJ = (bf16*)(ws + WS_BIG);
    float* Y = p.out + O_Y;

    enum { K_P0, K_MOD, K_SWIGLU, K_RES, K_PROJ, K_MIX, K_SCAN };
#pragma nounroll
    for (int ph = 0; ph < 17; ++ph) {
        int tid_ = threadIdx.x; asm volatile("" : "+v"(tid_));
        const int tid = tid_, lane = tid & 63, wave = __builtin_amdgcn_readfirstlane(tid >> 6);
        int bx_ = blockIdx.x; asm volatile("" : "+s"(bx_)); const int bx = bx_;
        int kind, g = -1, ffn = 0;
        if (ph == 0) kind = K_P0;
        else if (ph <= 3) { kind = ph == 1 ? K_MOD : (ph == 2 ? K_SWIGLU : K_RES); }
        else if (ph <= 13) { const int q = ph - 4; g = q / 5; const int r = q - 5 * g; kind = r == 0 ? K_MOD : (r == 1 ? K_PROJ : (r == 2 ? K_MIX : (r == 3 ? K_SCAN : K_RES))); }
        else { ffn = 1; kind = ph == 14 ? K_MOD : (ph == 15 ? K_SWIGLU : K_RES); }
        const bool first = (ph <= 3);
        switch (kind) {
        case K_P0: p0_phase(p, lds, tid, wave, lane); break;
        case K_MOD: {
            const float* xp = first ? p.x_prompt : Y; const float* xs = first ? p.x_sample : Y + (size_t)NPROMPT * D;
            const float* gain = g >= 0 ? p.norm_mix : (ffn ? p.norm_ffn2 : p.norm_ffn1);
            mod_phase(p, g >= 0, xp, xs, gain, g >= 0 ? 3072 : (ffn ? 6144 : 0), H, g, g >= 0 ? grows_of(g) : NROWS, lds, tid, wave, lane);
        } break;
        case K_SWIGLU: { pg8::Gemm gm{H, (const bf16*)(ws + (ffn ? WS_W2IN : WS_W1IN)), NROWS, 2 * FF, D, D, D, 128, 512 * D}; pg8::StaticOrder S; S.init(NROWS, 2 * FF, G, bx); EpiSwiglu E{ACT};
            pg8::gemm_phase<EpiSwiglu, pg8::StaticOrder, true, true>(lds, gm, S, E, tid); } break;
        case K_RES: {
            const float* xp = first ? p.x_prompt : Y; const float* xs = first ? p.x_sample : Y + (size_t)NPROMPT * D;
            pg8::Gemm gm; EpiRes E{xp, xs, Y, MOD, 0, 0.5f, g};
            if (g >= 0) { gm = pg8::Gemm{PROJ + PC_Z, (const bf16*)(ws + WS_WOUT), grows_of(g), D, D, NPROJ, D, 128, 512 * NPROJ}; E.goff = 5120; E.gscale = 1.0f; }
            else { gm = pg8::Gemm{ACT, (const bf16*)(ws + (ffn ? WS_W2OUT : WS_W1OUT)), NROWS, D, FF, 64, FF, 32768, 44 * 32768};   E.goff = ffn ? 8192 : 2048; }
            pg8::StaticOrder S; S.init(gm.M, gm.N, G, bx);
            pg8::gemm_phase<EpiRes, pg8::StaticOrder, true, false>(lds, gm, S, E, tid); } break;
        case K_PROJ: { pg8::Gemm gm{H, (const bf16*)(ws + WS_WIN), grows_of(g), NPROJ, D, D, D, 128, 512 * D}; pg8::StaticOrder S; S.init(grows_of(g), NPROJ, G, bx); EpiBf16Plain E{PROJ, NPROJ};
            pg8::gemm_phase<EpiBf16Plain, pg8::StaticOrder, true, true>(lds, gm, S, E, tid); } break;
        case K_MIX:
            gdn_prep_stage_cw(p, bx & 7, lds, tid); __syncthreads();
#pragma nounroll
            for (int it = bx; it < ncu_of(g) * 8; it += G) { int t2 = tid; asm volatile("" : "+v"(t2)); gdn_prep_item(p, g, it >> 3, it & 7, lds, t2, __builtin_amdgcn_readfirstlane(t2 >> 6), t2 & 63); }
#pragma nounroll
            for (int it = (bx + 128) % G; it < ncu_of(g) * 4; it += G) { int t2 = tid; asm volatile("" : "+v"(t2)); swa_item(p, g, it >> 2, it & 3, lds, t2, __builtin_amdgcn_readfirstlane(t2 >> 6), t2 & 63); }
            break;
        default:
#pragma nounroll
            for (int ch = bx; ch < (g == 0 ? 384 : 128); ch += G) { int t2 = tid; asm volatile("" : "+v"(t2)); scan_chain(p, g, ch >> 3, ch & 7, lds, t2, __builtin_amdgcn_readfirstlane(t2 >> 6), t2 & 63); }
            break;
        }
        if (ph != 16) xcd_barrier(xbar);
    }
#ifdef EXTRA_SYNCS
    grid.sync(); grid.sync(); grid.sync(); grid.sync(); grid.sync(); grid.sync(); grid.sync(); grid.sync(); grid.sync(); grid.sync();
#endif
}

extern "C" void kernel_launch(void* const* d_in, const int* in_sizes, int n_in, void* d_out, int out_size, void* d_ws, size_t ws_size, hipStream_t stream) {
    static int grid_blocks = 0;
    if (grid_blocks == 0) {
        if (n_in != 27 || ws_size < WS_END) { fprintf(stderr, "kernel_launch: unexpected n_in %d / ws_size %zu (need %zu)\n", n_in, ws_size, (size_t)WS_END); grid_blocks = -1; return; }
        int dev = 0, cus = 0, per_cu = 0;
        (void)hipGetDevice(&dev); (void)hipDeviceGetAttribute(&cus, hipDeviceAttributeMultiprocessorCount, dev);
        (void)hipFuncSetAttribute((const void*)mega_fwd, hipFuncAttributeMaxDynamicSharedMemorySize, LDS_BYTES);
        (void)hipOccupancyMaxActiveBlocksPerMultiprocessor(&per_cu, (const void*)mega_fwd, 512, LDS_BYTES);
        if (per_cu < 1) { fprintf(stderr, "kernel_launch: occupancy query says %d blocks per CU; the in-kernel barriers need every workgroup resident: nothing launched\n", per_cu); grid_blocks = -1; return; }
        grid_blocks = cus;
    }
    if (grid_blocks < 0) return;
    if (hipMemsetAsync((char*)d_ws + WS_BAR, 0, 16384, stream) != hipSuccess) { fprintf(stderr, "kernel_launch: memset of the barrier words failed\n"); return; }
    Params p{};
    const float** pp = (const float**)&p;
    for (int i = 0; i < 27; ++i) pp[i] = (const float*)d_in[i];
    p.out = (float*)d_out; p.ws = (unsigned char*)d_ws;
    void* args[] = {&p};
    hipError_t e = hipLaunchCooperativeKernel((const void*)mega_fwd, dim3(grid_blocks), dim3(512), args, LDS_BYTES, stream);
    if (e != hipSuccess) fprintf(stderr, "cooperative launch failed: %s (grid %d)\n", hipGetErrorString(e), grid_blocks);
}
```

```cpp
#include <hip/hip_runtime.h>
#include <hip/hip_cooperative_groups.h>
#include <cstdio>
#include <cstdint>
namespace cg = cooperative_groups;
namespace pg8 {
#define PG8_LAS __attribute__((address_space(3)))
typedef unsigned short bf16_t;
typedef short bf16x8 __attribute__((ext_vector_type(8)));
typedef float f32x4 __attribute__((ext_vector_type(4)));
typedef unsigned u32x4 __attribute__((ext_vector_type(4)));
constexpr int BM = 256, BK = 64, HALF = 128, HTB = HALF * BK * 2  , STAGE_BYTES = 8 * HTB, NXCD = 8, WGM = 4;

__host__ __device__ __forceinline__ int lds_byte(int r, int c) { const int st = (r >> 4) * 2 + (c >> 5), rr = r & 15, cc = c & 31, ob = rr * 64 + cc * 2; return st * 1024 + (ob ^ (((ob >> 9) & 1) << 5)); }
__host__ __device__ __forceinline__ void stage_rc(int b, int& R, int& C) { const int st = b / 1024, sb = b % 1024, swz = sb ^ (((sb >> 9) & 1) << 5); R = (st >> 1) * 16 + swz / 64; C = (st & 1) * 32 + (swz % 64) / 2; }
__host__ __device__ __forceinline__ int perm32(int rho) { const int n = rho >> 4, i = rho & 15; return 8 * (i >> 2) + 4 * n + (i & 3); }

struct Unit { int pm, pn; };
struct Gemm { const bf16_t* A; const bf16_t* Bt; int M, N, K, lda, ldb, a_kstep, a_tstep; };

struct StaticOrder {
    int nM, nN, nwg, G, c;
    __host__ __device__ void init(int M, int N, int G_, int c_) { nM = M / BM; nN = N / BM; nwg = nM * nN; G = G_; c = c_; }
    __host__ __device__ bool next(int i, Unit& u) const {
        const long L = (long)i * G + c; if (L >= nwg) return false;
        int wgid = (int)L; { const int q = nwg / NXCD, r = nwg % NXCD, xcd = wgid % NXCD, off = wgid / NXCD; wgid = (xcd < r ? xcd * (q + 1) : r * (q + 1) + (xcd - r) * q) + off; }
        const int nig = WGM * nN, gid = wgid / nig, fm = gid * WGM, gsz = (nM - fm) < WGM ? (nM - fm) : WGM;
        u.pm = fm + ((wgid % nig) % gsz); u.pn = (wgid % nig) / gsz; return true;
    }
    __device__ __forceinline__ void a_ready(const Unit&) const {}
    __device__ __forceinline__ void done(const Unit&) const {}
};

__device__ __forceinline__ unsigned cvt_pk_bf16(float lo, float hi) { unsigned r; asm volatile("v_cvt_pk_bf16_f32 %0, %1, %2" : "=v"(r) : "v"(lo), "v"(hi)); return r; }
typedef float f32x2 __attribute__((ext_vector_type(2)));
template <class Epi, class Sched, bool ALIGN_EPI = false, bool SP2 = false>
__device__ __forceinline__ void gemm_phase(PG8_LAS unsigned char* lds, const Gemm g, const Sched& S, const Epi& E, const int tid_in) {
    const int tid = tid_in, wid = __builtin_amdgcn_readfirstlane(tid >> 6), lane = tid & 63, wr = wid >> 2, wc = wid & 3, fr = lane & 15, fq = lane >> 4;
    const int K = g.K, nt = K / BK;
    unsigned voffA[2], voffB[2];
#pragma unroll
    for (int i = 0; i < 2; ++i) { int R, C; stage_rc(tid * 16 + i * 8192, R, C); const int Rb = Epi::PERM ? ((R & ~31) + perm32(R & 31)) : R;
        voffA[i] = (unsigned)(R * g.lda + C) * 2u; voffB[i] = (unsigned)(Rb * g.ldb + C) * 2u; }
    const size_t kstep = (size_t)(BK * 2);
    const size_t hstep = (size_t)HALF * g.ldb * 2;
    const size_t tstep = 2 * hstep;
    const size_t hstepA = (size_t)HALF * g.lda * 2, tstepA = (size_t)g.a_tstep, kstepA = (size_t)g.a_kstep;
    const unsigned ldsw = (unsigned)wid * 1024u;
    const int aoff = lds_byte(wr * 64 + fr, fq * 8), boff = lds_byte(wc * 32 + fr, fq * 8);
#define PG8_SA(b, h) (((b) * 2 + (h)) * HTB)
#define PG8_SB(b, h) ((4 + (b) * 2 + (h)) * HTB)
#define PG8_STAGE(bufoff, gbase, voff) do { _Pragma("unroll") for (int _i = 0; _i < 2; ++_i) \
        __builtin_amdgcn_global_load_lds((const unsigned*)((const char*)(gbase) + (voff)[_i]), (PG8_LAS unsigned*)(lds + (bufoff) + ldsw + _i * 8192), 16, 0, 0); } while (0)
#define PG8_LDA(dst, b, h) do { _Pragma("unroll") for (int m = 0; m < 4; ++m) _Pragma("unroll") for (int k = 0; k < 2; ++k) dst[m][k] = *(const PG8_LAS bf16x8*)(lds + PG8_SA(b, h) + aoff + m * 2048 + k * 1024); } while (0)
#define PG8_LDB(dst, b, h) do { _Pragma("unroll") for (int n = 0; n < 2; ++n) _Pragma("unroll") for (int k = 0; k < 2; ++k) dst[n][k] = *(const PG8_LAS bf16x8*)(lds + PG8_SB(b, h) + boff + n * 2048 + k * 1024); } while (0)
#define PG8_MMA(ai, bj, At, Bt) do { __builtin_amdgcn_s_setprio(1); _Pragma("unroll") for (int m = 0; m < 4; ++m) _Pragma("unroll") for (int n = 0; n < 2; ++n) _Pragma("unroll") for (int k = 0; k < 2; ++k) \
        acc[ai][bj][m][n] = __builtin_amdgcn_mfma_f32_16x16x32_bf16(Bt[n][k], At[m][k], acc[ai][bj][m][n], 0, 0, 0); __builtin_amdgcn_s_setprio(0); } while (0)
#define PG8_WAIT_V(n) asm volatile("s_waitcnt vmcnt(" #n ")" ::: "memory")
#define PG8_WAIT_L(n) asm volatile("s_waitcnt lgkmcnt(" #n ")" ::: "memory")
#define PG8_BAR __builtin_amdgcn_s_barrier()
#define PG8_SCHED __builtin_amdgcn_sched_barrier(0)
    Unit cur, nxt; int ui = 0;
    if (!S.next(0, cur)) return;
    f32x4 acc[2][2][4][2];
#pragma unroll
    for (int a = 0; a < 2; ++a)
#pragma unroll
        for (int b = 0; b < 2; ++b)
#pragma unroll
            for (int m = 0; m < 4; ++m)
#pragma unroll
                for (int n = 0; n < 2; ++n) acc[a][b][m][n] = (f32x4){0.f, 0.f, 0.f, 0.f};
    bf16x8 At[4][2], B0[2][2], B1[2][2];
    const char* cA = (const char*)g.A + (size_t)cur.pm * tstepA; const char* cB = (const char*)g.Bt + (size_t)cur.pn * tstep;
    S.a_ready(cur);
    if constexpr (SP2) {
        PG8_STAGE(PG8_SB(0, 0), cB, voffB); PG8_STAGE(PG8_SB(0, 1), cB + hstep, voffB); PG8_STAGE(PG8_SA(0, 0), cA, voffA); PG8_STAGE(PG8_SA(0, 1), cA + hstepA, voffA);
        if (wr == 1) PG8_BAR;
        PG8_WAIT_V(2); PG8_BAR;
        PG8_STAGE(PG8_SB(1, 0), cB + kstep, voffB); PG8_STAGE(PG8_SA(1, 0), cA + kstepA, voffA); PG8_STAGE(PG8_SB(1, 1), cB + hstep + kstep, voffB);
        PG8_WAIT_V(6); PG8_BAR;
    } else {
        PG8_STAGE(PG8_SB(0, 0), cB, voffB); PG8_STAGE(PG8_SA(0, 0), cA, voffA); PG8_STAGE(PG8_SB(0, 1), cB + hstep, voffB); PG8_STAGE(PG8_SA(0, 1), cA + hstepA, voffA);
        if (wr == 1) PG8_BAR;
        PG8_WAIT_V(4); PG8_BAR;
        PG8_STAGE(PG8_SB(1, 0), cB + kstep, voffB); PG8_STAGE(PG8_SA(1, 0), cA + kstepA, voffA); PG8_STAGE(PG8_SB(1, 1), cB + hstep + kstep, voffB);
        PG8_WAIT_V(6); PG8_BAR;
    }
    for (;;) {
        const bool has_next = S.next(ui + 1, nxt);
        const char* nA = has_next ? (const char*)g.A + (size_t)nxt.pm * tstepA : cA; const char* nB = has_next ? (const char*)g.Bt + (size_t)nxt.pn * tstep : cB;
        for (int t = 0; t < nt; t += 2) {
            const bool last = (t == nt - 2);
            const char* a1 = cA + (size_t)(t + 1) * kstepA;
            const char* a2 = last ? nA : cA + (size_t)(t + 2) * kstepA; const char* b2 = last ? nB : cB + (size_t)(t + 2) * kstep;
            const char* a3 = a2 + kstepA; const char* b3 = b2 + kstep;
            if (last && has_next) S.a_ready(nxt);
            if constexpr (SP2) {
            PG8_LDB(B0, 0, 0); PG8_LDB(B1, 0, 1); PG8_SCHED; PG8_LDA(At, 0, 0); PG8_STAGE(PG8_SA(1, 1), a1 + hstepA, voffA);
            PG8_WAIT_V(8); PG8_WAIT_L(0); PG8_BAR; PG8_MMA(0, 0, At, B0); PG8_MMA(0, 1, At, B1); PG8_BAR; PG8_SCHED;
            PG8_LDA(At, 0, 1); PG8_STAGE(PG8_SB(0, 0), b2, voffB); PG8_STAGE(PG8_SB(0, 1), b2 + hstep, voffB); PG8_STAGE(PG8_SA(0, 0), a2, voffA);
            PG8_WAIT_V(8); PG8_WAIT_L(0); PG8_BAR; PG8_MMA(1, 0, At, B0); PG8_MMA(1, 1, At, B1); PG8_BAR; PG8_SCHED;
            PG8_LDB(B0, 1, 0); PG8_LDB(B1, 1, 1); PG8_SCHED; PG8_LDA(At, 1, 0); PG8_STAGE(PG8_SA(0, 1), a2 + hstepA, voffA);
            PG8_WAIT_V(8); PG8_WAIT_L(0); PG8_BAR; PG8_MMA(0, 0, At, B0); PG8_MMA(0, 1, At, B1); PG8_BAR; PG8_SCHED;
            PG8_LDA(At, 1, 1); PG8_STAGE(PG8_SB(1, 0), b3, voffB); PG8_STAGE(PG8_SB(1, 1), b3 + hstep, voffB); PG8_STAGE(PG8_SA(1, 0), a3, voffA);
            PG8_WAIT_V(8); PG8_WAIT_L(0); PG8_BAR; PG8_MMA(1, 0, At, B0); PG8_MMA(1, 1, At, B1); PG8_BAR; PG8_SCHED;
            } else {
            PG8_LDB(B0, 0, 0); PG8_SCHED; PG8_LDA(At, 0, 0); PG8_STAGE(PG8_SA(1, 1), a1 + hstepA, voffA);
            PG8_WAIT_L(8); PG8_BAR; PG8_WAIT_L(0); PG8_MMA(0, 0, At, B0); PG8_BAR; PG8_SCHED;
            PG8_LDB(B1, 0, 1); PG8_STAGE(PG8_SB(0, 0), b2, voffB);
            PG8_BAR; PG8_WAIT_L(0); PG8_MMA(0, 1, At, B1); PG8_BAR;
            PG8_LDA(At, 0, 1); PG8_STAGE(PG8_SA(0, 0), a2, voffA);
            PG8_BAR; PG8_WAIT_L(0); PG8_MMA(1, 0, At, B0); PG8_BAR; PG8_SCHED;
            PG8_STAGE(PG8_SB(0, 1), b2 + hstep, voffB);
            PG8_WAIT_V(6); PG8_BAR; PG8_MMA(1, 1, At, B1); PG8_BAR;
            PG8_LDB(B0, 1, 0); PG8_SCHED; PG8_LDA(At, 1, 0); PG8_STAGE(PG8_SA(0, 1), a2 + hstepA, voffA);
            PG8_WAIT_L(8); PG8_BAR; PG8_WAIT_L(0); PG8_MMA(0, 0, At, B0); PG8_BAR; PG8_SCHED;
            PG8_LDB(B1, 1, 1); PG8_STAGE(PG8_SB(1, 0), b3, voffB);
            PG8_BAR; PG8_WAIT_L(0); PG8_MMA(0, 1, At, B1); PG8_BAR;
            PG8_LDA(At, 1, 1); PG8_STAGE(PG8_SA(1, 0), a3, voffA);
            PG8_BAR; PG8_WAIT_L(0); PG8_MMA(1, 0, At, B0); PG8_BAR; PG8_SCHED;
            PG8_STAGE(PG8_SB(1, 1), b3 + hstep, voffB);
            PG8_WAIT_V(6); PG8_BAR; PG8_MMA(1, 1, At, B1); PG8_BAR;
            }
        }
        if constexpr (ALIGN_EPI) { if (wr == 0) PG8_BAR; }
        if constexpr (!Epi::AFTER_DRAIN) { E(acc, cur, wr, wc, fr, fq); S.done(cur); }
        if (!has_next) break;
#pragma unroll
        for (int a = 0; a < 2; ++a)
#pragma unroll
            for (int b = 0; b < 2; ++b)
#pragma unroll
                for (int m = 0; m < 4; ++m)
#pragma unroll
                    for (int n = 0; n < 2; ++n) acc[a][b][m][n] = (f32x4){0.f, 0.f, 0.f, 0.f};
        cur = nxt; cA = nA; cB = nB; ++ui;
        if constexpr (ALIGN_EPI) { if (wr == 1) PG8_BAR; }
    }
    PG8_WAIT_V(0);
    if constexpr (!ALIGN_EPI) { if (wr == 0) PG8_BAR; }
    PG8_BAR;
    if constexpr (Epi::AFTER_DRAIN) { E.fused(acc, cur, wr, wc, fr, fq, lds, wid, lane); S.done(cur); }
#undef PG8_SA
#undef PG8_SB
#undef PG8_STAGE
#undef PG8_LDA
#undef PG8_LDB
#undef PG8_MMA
#undef PG8_WAIT_V
#undef PG8_WAIT_L
#undef PG8_BAR
#undef PG8_SCHED
}
}
#define LAS __attribute__((address_space(3)))
typedef unsigned short bf16;
typedef short bf16x8 __attribute__((ext_vector_type(8)));
typedef float f32x4 __attribute__((ext_vector_type(4)));
typedef unsigned u32x4 __attribute__((ext_vector_type(4)));
typedef unsigned u32x2 __attribute__((ext_vector_type(2)));
typedef float f32x2_t __attribute__((ext_vector_type(2)));
typedef __bf16 bf16x2_t __attribute__((ext_vector_type(2)));
__device__ __forceinline__ unsigned cvt_pk_bf16(float lo, float hi) { const f32x2_t v = {lo, hi}; const bf16x2_t b = __builtin_convertvector(v, bf16x2_t); return __builtin_bit_cast(unsigned, b); }

constexpr int D = 1024, NROWS = 34816, NPROMPT = 32768, FF = 2816, NPROJ = 7680, WIN_N = 7696, NMOD = 9216;
constexpr int GROWS_MAX = 18432;
__host__ __device__ constexpr int grows_of(int g) { return g == 0 ? 18432 : 16384; }
__host__ __device__ constexpr int ncu_of(int g) { return g == 0 ? 288 : 256; }
constexpr float EPS = 1e-6f;
constexpr int PC_Z = 3072, PC_QS = 4096, PC_KS = 5120, PC_VS = 5376, PC_GA = 5632, PC_GB = 6656;
constexpr size_t O_Y = 0, O_CONVP = 35651584, O_GDNP = 35799040, O_KP = 37896192, O_VP = 38420480, O_CONVS = 38944768, O_GDNS = 39239680, O_KS = 43433984, O_VS = 44482560;
constexpr size_t MiB = 1u << 20;
constexpr size_t WS_MOD = 0, WS_GB = 2 * MiB, WS_HALO = 3 * MiB + 512 * 1024  , WS_DL = 4 * MiB, WS_KVT = 5 * MiB  ,
    WS_W1IN = 7 * MiB, WS_W1OUT = 18 * MiB, WS_WIN = 24 * MiB, WS_WOUT = 39 * MiB, WS_W2IN = 41 * MiB, WS_W2OUT = 52 * MiB;
constexpr size_t WS_H = 58 * MiB;
constexpr size_t WS_EX = 58 * MiB, WS_BIG = 220 * MiB;
constexpr size_t WS_END = 490 * MiB;
constexpr int EX_ITEM = 73728, EX_UT = 0, EX_WN = 16384, EX_QD = 32768, EX_KDT = 49152, EX_QK = 65536;
constexpr int LDS_BYTES = 151552;
constexpr size_t WS_BAR = 4 * MiB + 256 * 1024;
constexpr int LDS_BARST = LDS_BYTES - 16;

struct Params {
    const float *x_prompt, *x_sample, *state_conv, *state_gdn, *cache_k, *cache_v, *c_prompt, *c_sample, *w_ada, *b_ada, *norm_ffn1, *ffn1_w_in, *ffn1_w_out,
        *norm_mix, *w_in, *conv_w, *a_log, *dt_bias, *gdn_norm, *q_norm, *k_norm, *sinks, *b_merge, *w_out, *norm_ffn2, *ffn2_w_in, *ffn2_w_out;
    float* out; unsigned char* ws;
};

__device__ __forceinline__ float bflo(unsigned w) { return __uint_as_float(w << 16); }
__device__ __forceinline__ float bfhi(unsigned w) { return __uint_as_float(w & 0xffff0000u); }
__device__ __forceinline__ unsigned short f2bf(float f) { return (unsigned short)(cvt_pk_bf16(f, 0.f) & 0xffffu); }
__device__ __forceinline__ float sigmoidf_(float x) { return __builtin_amdgcn_rcpf(1.f + __expf(-x)); }
__device__ __forceinline__ float siluf_(float x) { return x * sigmoidf_(x); }
__device__ __forceinline__ void unpack8(const u32x4 w, float (&f)[8]) { f[0] = bflo(w.x); f[1] = bfhi(w.x); f[2] = bflo(w.y); f[3] = bfhi(w.y); f[4] = bflo(w.z); f[5] = bfhi(w.z); f[6] = bflo(w.w); f[7] = bfhi(w.w); }
__device__ __forceinline__ u32x4 pack8(const float (&f)[8]) { u32x4 w; w.x = cvt_pk_bf16(f[0], f[1]); w.y = cvt_pk_bf16(f[2], f[3]); w.z = cvt_pk_bf16(f[4], f[5]); w.w = cvt_pk_bf16(f[6], f[7]); return w; }
__device__ __forceinline__ bf16x8 as_bf16x8(u32x4 w) { return __builtin_bit_cast(bf16x8, w); }
__device__ __forceinline__ float wave_sum(float v) {
#pragma unroll
    for (int o = 1; o < 64; o <<= 1) v += __shfl_xor(v, o);
    return v;
}
__device__ __forceinline__ int grow_of(int g, int lr) { return lr < 16384 ? (lr >> 10) * 2048 + 1024 * g + (lr & 1023) : NPROMPT + (lr - 16384); }
__device__ __forceinline__ int modrow_of(int m) { return m < NPROMPT ? (m >> 11) : 16 + ((m - NPROMPT) >> 6); }

struct EpiSwiglu {
    static constexpr bool PERM = true, AFTER_DRAIN = false;
    bf16* O;
    __device__ __forceinline__ void operator()(const pg8::f32x4 (&acc)[2][2][4][2], const pg8::Unit& u, int wr, int wc, int fr, int fq) const {
        const int row0 = u.pm * 256 + wr * 64 + fr, col0 = u.pn * 128 + wc * 32 + 8 * fq; const int kt = col0 >> 6, cin = col0 & 63;
#pragma unroll
        for (int ai = 0; ai < 2; ++ai)
#pragma unroll
            for (int m = 0; m < 4; ++m) {
                float v[8];
#pragma unroll
                for (int n = 0; n < 2; ++n)
#pragma unroll
                    for (int i = 0; i < 4; ++i) { const float gt = acc[ai][0][m][n][i], up = acc[ai][1][m][n][i]; v[n * 4 + i] = siluf_(gt) * up; }
                *(u32x4*)(O + ((size_t)(u.pm * 44 + kt) * 256 + (row0 - u.pm * 256) + ai * 128 + m * 16) * 64 + cin) = pack8(v);
            }
    }
};
struct EpiBf16Plain {
    static constexpr bool PERM = true, AFTER_DRAIN = false;
    bf16* O; int ldc;
    __device__ __forceinline__ void operator()(const pg8::f32x4 (&acc)[2][2][4][2], const pg8::Unit& u, int wr, int wc, int fr, int fq) const {
        const int row0 = u.pm * 256 + wr * 64 + fr, col0 = u.pn * 256 + wc * 32 + 8 * fq;
#pragma unroll
        for (int ai = 0; ai < 2; ++ai)
#pragma unroll
            for (int m = 0; m < 4; ++m)
#pragma unroll
                for (int bj = 0; bj < 2; ++bj) {
                    float v[8];
#pragma unroll
                    for (int n = 0; n < 2; ++n)
#pragma unroll
                        for (int i = 0; i < 4; ++i) v[n * 4 + i] = acc[ai][bj][m][n][i];
                    *(u32x4*)(O + (size_t)(row0 + ai * 128 + m * 16) * ldc + col0 + bj * 128) = pack8(v);
                }
    }
};
struct EpiRes {
    static constexpr bool PERM = false, AFTER_DRAIN = false;
    const float* xin_p; const float* xin_s; float* out; const float* mod; int goff; float gscale; int grp;
    __device__ __forceinline__ void operator()(const pg8::f32x4 (&acc)[2][2][4][2], const pg8::Unit& u, int wr, int wc, int fr, int fq) const {
        const int col0 = u.pn * 256 + wc * 32 + 4 * fq;
        f32x4 xv[2][4], gv[2][4]; float* orow[2];
#define EPIRES_LOAD(buf, it) do { const int R_ = u.pm * 256 + ((it) >> 2) * 128 + wr * 64 + ((it) & 3) * 16 + fr; const int gm_ = grp < 0 ? R_ : grow_of(grp, R_); \
            const float* xr_ = gm_ < NPROMPT ? xin_p + (size_t)gm_ * D : xin_s + (size_t)(gm_ - NPROMPT) * D; const float* mr_ = mod + (size_t)modrow_of(gm_) * NMOD + goff; orow[buf] = out + (size_t)gm_ * D; \
            _Pragma("unroll") for (int q_ = 0; q_ < 4; ++q_) { const int c_ = col0 + (q_ >> 1) * 128 + (q_ & 1) * 16; xv[buf][q_] = *(const f32x4*)(xr_ + c_); gv[buf][q_] = *(const f32x4*)(mr_ + c_); } } while (0)
        EPIRES_LOAD(0, 0);
#pragma unroll
        for (int it = 0; it < 8; ++it) {
            if (it < 7) EPIRES_LOAD((it + 1) & 1, it + 1);
#pragma unroll
            for (int q = 0; q < 4; ++q) { const int c = col0 + (q >> 1) * 128 + (q & 1) * 16;
                *(f32x4*)(orow[it & 1] + c) = xv[it & 1][q] + gscale * gv[it & 1][q] * acc[it >> 2][q >> 1][it & 3][q & 1]; }
        }
#undef EPIRES_LOAD
    }
};

__device__ __forceinline__ void transpose_tile(const float* W, int ldw, int K, bf16* WT, int dst_row0, int src_col0, int k0, LAS float* scr, int lane) {
    const int voff = (lane >> 5) * ldw + (lane & 31);
#pragma unroll
    for (int i = 0; i < 32; ++i) { const float* wr = W + (size_t)(k0 + 2 * i) * ldw + src_col0; scr[(2 * i + (lane >> 5)) * 33 + (lane & 31)] = wr[voff]; }
    asm volatile("s_waitcnt lgkmcnt(0)" ::: "memory");
    const int c = lane & 7;
#pragma unroll
    for (int j = 0; j < 4; ++j) { const int n = (lane >> 3) + 8 * j; const LAS float* s = scr + (8 * c) * 33 + n;
        u32x4 o; o.x = cvt_pk_bf16(s[0 * 33], s[1 * 33]); o.y = cvt_pk_bf16(s[2 * 33], s[3 * 33]); o.z = cvt_pk_bf16(s[4 * 33], s[5 * 33]); o.w = cvt_pk_bf16(s[6 * 33], s[7 * 33]);
        *(u32x4*)(WT + (size_t)(dst_row0 + n) * K + k0 + 8 * c) = o; }
    asm volatile("s_waitcnt lgkmcnt(0)" ::: "memory");
}
__device__ __forceinline__ int swiglu_src(int n) { const int pn = n >> 8, r = n & 255; return r < 128 ? 128 * pn + r : FF + 128 * pn + (r - 128); }
__device__ __forceinline__ void p0_phase(const Params& p, LAS unsigned char* lds, int tid, int wave, int lane) {
    unsigned char* ws = p.ws;
    if (blockIdx.x < 144) {
        const int n0 = blockIdx.x * 64, fr = lane & 15, fq = lane >> 4;
        float* MOD = (float*)(ws + WS_MOD);
#pragma unroll 4
        for (int i = 0; i < 12; ++i) { const int idx = tid + 512 * i, r = idx >> 7, k8 = (idx & 127) * 8;
            const float* cp = r < 16 ? p.c_prompt + r * D + k8 : p.c_sample + (r - 16) * D + k8;
            const f32x4 a = *(const f32x4*)cp, b2 = *(const f32x4*)(cp + 4); float v[8];
#pragma unroll
            for (int j = 0; j < 4; ++j) { v[j] = a[j] / (1.f + __expf(-a[j])); v[4 + j] = b2[j] / (1.f + __expf(-b2[j])); }
            *(LAS u32x4*)(lds + r * 2064 + k8 * 2) = pack8(v); }
        __syncthreads();
        f32x4 acc[3][4];
#pragma unroll
        for (int mb = 0; mb < 3; ++mb)
#pragma unroll
            for (int nb = 0; nb < 4; ++nb) acc[mb][nb] = (f32x4){0.f, 0.f, 0.f, 0.f};
        const int kb = wave * 128;
        const int voff = (8 * fq) * NMOD + fr;
#pragma unroll
        for (int ks = 0; ks < 4; ++ks) {
            bf16x8 bfr[4];
#pragma unroll
            for (int nb = 0; nb < 4; ++nb) { float w[8];
#pragma unroll
                for (int j = 0; j < 8; ++j) { const float* wr = p.w_ada + (size_t)(kb + 32 * ks + j) * NMOD + n0 + 16 * nb; w[j] = wr[voff]; }
                bfr[nb] = as_bf16x8(pack8(w)); }
#pragma unroll
            for (int mb = 0; mb < 3; ++mb) { const bf16x8 af = *(const LAS bf16x8*)(lds + (16 * mb + fr) * 2064 + (kb + 32 * ks + 8 * fq) * 2);
#pragma unroll
                for (int nb = 0; nb < 4; ++nb) acc[mb][nb] = __builtin_amdgcn_mfma_f32_16x16x32_bf16(af, bfr[nb], acc[mb][nb], 0, 0, 0); }
        }
        __syncthreads();
        LAS float* part = (LAS float*)lds;
#pragma unroll
        for (int mb = 0; mb < 3; ++mb)
#pragma unroll
            for (int nb = 0; nb < 4; ++nb)
#pragma unroll
                for (int j = 0; j < 4; ++j) part[(wave * 48 + 16 * mb + 4 * fq + j) * 64 + 16 * nb + fr] = acc[mb][nb][j];
        __syncthreads();
#pragma unroll
        for (int i = 0; i < 6; ++i) { const int idx = tid + 512 * i, r = idx >> 6, col = idx & 63; float sm = p.b_ada[n0 + col];
#pragma unroll
            for (int w = 0; w < 8; ++w) sm += part[(w * 48 + r) * 64 + col];
            MOD[(size_t)r * NMOD + n0 + col] = sm; }
        __syncthreads();
    }
    LAS float* scr = (LAS float*)(lds + wave * 16384);
    const int gw = blockIdx.x * 8 + wave, NGW = gridDim.x * 8;
    constexpr int I0 = 16 * 176, I1 = 44 * 32, I2 = 16 * 240, I3 = 16 * 32;
    constexpr int NIT = 2 * I0 + 2 * I1 + I2 + I3;
#pragma unroll 1
    for (int it = gw; it < NIT; it += NGW) {
        int r = it; const float* W; int ldw, K, nb, kb, srcc; size_t wso;
        if (r < I0) { nb = r % 176; kb = r / 176; W = p.ffn1_w_in; ldw = 2 * FF; K = D; wso = WS_W1IN; srcc = swiglu_src(32 * nb); }
        else if ((r -= I0) < I0) { nb = r % 176; kb = r / 176; W = p.ffn2_w_in; ldw = 2 * FF; K = D; wso = WS_W2IN; srcc = swiglu_src(32 * nb); }
        else if ((r -= I0) < I1) { nb = r % 32; kb = r / 32; W = p.ffn1_w_out; ldw = D; K = FF; wso = WS_W1OUT; srcc = 32 * nb; }
        else if ((r -= I1) < I1) { nb = r % 32; kb = r / 32; W = p.ffn2_w_out; ldw = D; K = FF; wso = WS_W2OUT; srcc = 32 * nb; }
        else if ((r -= I1) < I2) { nb = r % 240; kb = r / 240; W = p.w_in; ldw = WIN_N; K = D; wso = WS_WIN; srcc = 32 * nb < 4096 ? 32 * nb : 32 * nb + 16; }
        else { r -= I2; nb = r % 32; kb = r / 32; W = p.w_out; ldw = D; K = D; wso = WS_WOUT; srcc = 32 * nb; }
        transpose_tile(W, ldw, K, (bf16*)(ws + wso), 32 * nb, srcc, 64 * kb, scr, lane);
    }
}

__device__ __forceinline__ void mod_phase(const Params& p, const bool AB, const float* xin_p, const float* xin_s, const float* gain, int moff, bf16* H, int grp, int nrows, LAS unsigned char* lds, int tid, int wave, int lane) {
    const float* MOD = (const float*)(p.ws + WS_MOD);
    LAS float* wabt = (LAS float*)lds;
    if (AB) {
        for (int i = 0; i < 8; ++i) { const int idx = tid + 512 * i, k = idx >> 2, j4 = idx & 3; const f32x4 w = *(const f32x4*)(p.w_in + (size_t)k * WIN_N + 4096 + 4 * j4);
#pragma unroll
            for (int e = 0; e < 4; ++e) wabt[(4 * j4 + e) * 1024 + k] = w[e]; }
        __syncthreads();
    }
    const int gw = blockIdx.x * 8 + wave, NGW = gridDim.x * 8;
    const int rpw = (nrows + NGW - 1) / NGW, rbeg = gw * rpw, rend = (rbeg + rpw < nrows) ? rbeg + rpw : nrows;
    f32x4 gn[4], sh[4], sc[4];
#pragma unroll
    for (int j = 0; j < 4; ++j) gn[j] = *(const f32x4*)(gain + 4 * lane + 256 * j);
    int cur_mod = -1;
    f32x4 xa[4], xb[4];
#define MOD_XPTR(r) ({ const int gm_ = grp < 0 ? (r) : grow_of(grp, (r)); (gm_ < NPROMPT ? xin_p + (size_t)gm_ * D : xin_s + (size_t)(gm_ - NPROMPT) * D); })
#define MOD_LOADX(dst, r) do { const int rc_ = (r) < rend ? (r) : (rend - 1); const float* xr_ = MOD_XPTR(rc_); _Pragma("unroll") for (int j = 0; j < 4; ++j) dst[j] = *(const f32x4*)(xr_ + 4 * lane + 256 * j); } while (0)
    if (rbeg < rend) { MOD_LOADX(xa, rbeg); MOD_LOADX(xb, rbeg + 1); }
#pragma unroll 1
    for (int r = rbeg; r < rend; ++r) {
        f32x4 v[4];
#pragma unroll
        for (int j = 0; j < 4; ++j) { v[j] = xa[j]; xa[j] = xb[j]; }
        MOD_LOADX(xb, r + 2);
        const int gm = grp < 0 ? r : grow_of(grp, r); const int mrow = modrow_of(gm);
        if (mrow != cur_mod) { cur_mod = mrow; const float* mr = MOD + (size_t)mrow * NMOD + moff;
#pragma unroll
            for (int j = 0; j < 4; ++j) { sh[j] = *(const f32x4*)(mr + 4 * lane + 256 * j); sc[j] = *(const f32x4*)(mr + 1024 + 4 * lane + 256 * j); } }
        float ss = 0.f;
#pragma unroll
        for (int j = 0; j < 4; ++j) ss += (v[j][0] * v[j][0] + v[j][1] * v[j][1]) + (v[j][2] * v[j][2] + v[j][3] * v[j][3]);
        const float rstd = rsqrtf(wave_sum(ss) * (1.f / D) + EPS);
#pragma unroll
        for (int j = 0; j < 4; ++j) { v[j] = v[j] * rstd * gn[j] * (1.f + sc[j]) + sh[j];
            u32x2 o; o.x = cvt_pk_bf16(v[j][0], v[j][1]); o.y = cvt_pk_bf16(v[j][2], v[j][3]);
            *(u32x2*)(H + (size_t)r * D + 4 * lane + 256 * j) = o; }
        if (AB) {
            float s16[16];
#pragma unroll
            for (int o = 0; o < 16; ++o) { float s = 0.f;
#pragma unroll
                for (int j = 0; j < 4; ++j) { const f32x4 w = *(const LAS f32x4*)(wabt + o * 1024 + 4 * lane + 256 * j); s += (v[j][0] * w[0] + v[j][1] * w[1]) + (v[j][2] * w[2] + v[j][3] * w[3]); }
                s16[o] = s; }
            const bool b5 = lane & 32, b4 = lane & 16, b3 = lane & 8, b2 = lane & 4;
            float t8[8], t4[4], t2[2], t1;
#pragma unroll
            for (int j = 0; j < 8; ++j) { const float snd = b5 ? s16[j] : s16[8 + j], mine = b5 ? s16[8 + j] : s16[j]; t8[j] = mine + __shfl_xor(snd, 32); }
#pragma unroll
            for (int j = 0; j < 4; ++j) { const float snd = b4 ? t8[j] : t8[4 + j], mine = b4 ? t8[4 + j] : t8[j]; t4[j] = mine + __shfl_xor(snd, 16); }
#pragma unroll
            for (int j = 0; j < 2; ++j) { const float snd = b3 ? t4[j] : t4[2 + j], mine = b3 ? t4[2 + j] : t4[j]; t2[j] = mine + __shfl_xor(snd, 8); }
            { const float snd = b2 ? t2[0] : t2[1], mine = b2 ? t2[1] : t2[0]; t1 = mine + __shfl_xor(snd, 4); }
            t1 += __shfl_xor(t1, 2); t1 += __shfl_xor(t1, 1);
            if ((lane & 3) == 0) { const int o = lane >> 2; float res;
                if (o < 8) { const float A = __expf(p.a_log[o]); const float xx = t1 + p.dt_bias[o]; const float sp = xx > 20.f ? xx : log1pf(__expf(xx)); res = -A * sp; }
                else res = 1.f / (1.f + __expf(-t1));
                ((float*)(p.ws + WS_GB))[(size_t)r * 16 + o] = res; }
        }
    }
#undef MOD_XPTR
#undef MOD_LOADX
}
#define XB_TMO      128
#define XB_XCNT(j)  (256  + 64 * (j))
#define XB_XSUB(j)  (1280 + 64 * (j))
#define XB_XGEN(j)  (2304 + 64 * (j))
#define XB_TOP      3328
#define XB_TOPGEN   3392
#define XCD_BAR_WORDS 3456
#define XB_SPIN_CAP (1u << 18)

__device__ __forceinline__ unsigned xb_ld(unsigned* p)              { return __hip_atomic_load(p, __ATOMIC_RELAXED, __HIP_MEMORY_SCOPE_AGENT); }
__device__ __forceinline__ unsigned xb_add(unsigned* p, unsigned v) { return __hip_atomic_fetch_add(p, v, __ATOMIC_RELAXED, __HIP_MEMORY_SCOPE_AGENT); }
__device__ __forceinline__ unsigned xb_xcc_id() { return (unsigned)__builtin_amdgcn_s_getreg((3 << 11) | 20) & 0xFu; }
#define XB_SPIN(cond, bar) do { unsigned _sp = 0; while (cond) { __builtin_amdgcn_s_sleep(1); \
    if ((++_sp & 255u) == 0u) { if (xb_ld(&(bar)[XB_TMO])) break; if (_sp > XB_SPIN_CAP) { atomicAdd(&(bar)[XB_TMO], 1u); break; } } } } while (0)

struct XcdBarrier {
    unsigned* bar; unsigned x;
    volatile LAS unsigned* st;
};

__device__ __forceinline__ XcdBarrier xcd_barrier_post(unsigned* bar, volatile LAS unsigned* st) {
    XcdBarrier b; b.bar = bar; b.x = xb_xcc_id(); b.st = st;
    if (threadIdx.x == 0) (void)xb_add(&bar[XB_XCNT(b.x)], 1u);
    return b;
}
__device__ __forceinline__ void xcd_barrier_complete(unsigned* bar, unsigned x, unsigned& nloc, unsigned& nx) {
    const unsigned G = gridDim.x * gridDim.y * gridDim.z;
    unsigned sum, cnt, mine, sp = 0u;
    for (;;) {
        sum = 0u; cnt = 0u; mine = 0u;
#pragma unroll
        for (unsigned j = 0; j < 16; ++j) { const unsigned c = xb_ld(&bar[XB_XCNT(j)]); sum += c; cnt += (c > 0u) ? 1u : 0u; mine = (j == x) ? c : mine; }
        if (sum == G) break;
        __builtin_amdgcn_s_sleep(1);
        if ((++sp & 255u) == 0u) { if (xb_ld(&bar[XB_TMO])) break; if (sp > XB_SPIN_CAP) { atomicAdd(&bar[XB_TMO], 1u); break; } }
    }
    nloc = mine > 0u ? mine : 1u; nx = cnt > 0u ? cnt : 1u;
}

__device__ __forceinline__ void xcd_barrier(const XcdBarrier& b) {
    asm volatile("s_waitcnt vmcnt(0)" ::: "memory");
    __syncthreads();
    if (threadIdx.x == 0) {
        unsigned* bar = b.bar;
        __builtin_amdgcn_s_waitcnt(0);
        unsigned nloc = b.st[0], nx = b.st[1];
        if (nloc == 0u) { xcd_barrier_complete(bar, b.x, nloc, nx); b.st[0] = nloc; b.st[1] = nx; }
        const unsigned old = xb_add(&bar[XB_XSUB(b.x)], 1u);
        const unsigned gen = old / nloc;
        if (old + 1u == (gen + 1u) * nloc) {
            __builtin_amdgcn_fence(__ATOMIC_RELEASE, "agent");
            asm volatile("s_waitcnt vmcnt(0)" ::: "memory");
            const unsigned og = xb_add(&bar[XB_TOP], 1u);
            const unsigned tg = og / nx;
            if (og + 1u == (tg + 1u) * nx) xb_add(&bar[XB_TOPGEN], 1u);
            else XB_SPIN(xb_ld(&bar[XB_TOPGEN]) == tg, bar);
            __builtin_amdgcn_fence(__ATOMIC_ACQUIRE, "agent");
            xb_add(&bar[XB_XGEN(b.x)], 1u);
            asm volatile("s_waitcnt vmcnt(0)" ::: "memory");
        } else {
            XB_SPIN(xb_ld(&bar[XB_XGEN(b.x)]) == gen, bar);
            __builtin_amdgcn_fence(__ATOMIC_ACQUIRE, "agent");
            asm volatile("s_waitcnt vmcnt(0)" ::: "memory");
        }
    }
    __syncthreads();
}

#ifdef PROBE_TS
#define SEC(slot) do { if (blockIdx.x == 0 && threadIdx.x == 0) { unsigned long long* TS_ = (unsigned long long*)(p.ws + WS_DL + 512 * 1024); const unsigned long long t_ = __builtin_amdgcn_s_memrealtime(); TS_[(slot)] += t_ - TS_[31]; TS_[31] = t_; } } while (0)
#define SEC0() do { if (blockIdx.x == 0 && threadIdx.x == 0) { unsigned long long* TS_ = (unsigned long long*)(p.ws + WS_DL + 512 * 1024); TS_[31] = __builtin_amdgcn_s_memrealtime(); } } while (0)
#else
#define SEC(slot) do { } while (0)
#define SEC0() do { } while (0)
#endif
#define MFMA16(a, b, c) __builtin_amdgcn_mfma_f32_16x16x32_bf16((a), (b), (c), 0, 0, 0)
__device__ __forceinline__ bf16x8 lds_frag16(const LAS unsigned char* base) { return *(const LAS bf16x8*)base; }
__device__ __forceinline__ bf16x8 lds_frag8x2(const LAS unsigned char* lo, const LAS unsigned char* hi) {
    const u32x2 a = *(const LAS u32x2*)lo, b = *(const LAS u32x2*)hi; u32x4 w; w.x = a.x; w.y = a.y; w.z = b.x; w.w = b.y; return as_bf16x8(w); }
__device__ __forceinline__ bf16x8 pack_acc2(const f32x4 a, const f32x4 b) { u32x4 w; w.x = cvt_pk_bf16(a[0], a[1]); w.y = cvt_pk_bf16(a[2], a[3]); w.z = cvt_pk_bf16(b[0], b[1]); w.w = cvt_pk_bf16(b[2], b[3]); return as_bf16x8(w); }

constexpr int PL_QL = 0, PL_KL = 17408, PL_RT = 34816, PL_KDT = 71680, PL_AM = 90112  , PL_TB = 106752, PL_GS = 115968, PL_CW = 116992, PL_TM = 123136  ,
    PL_UTS = 0  , PL_WNS = 123136  , PL_QKS = 140544  ;
__device__ __forceinline__ void gdn_prep_stage_cw(const Params& p, int h, LAS unsigned char* lds, int tid) {
    for (int idx = tid; idx < 1536; idx += 512) { const int i = idx / 384, rem = idx - 384 * i, arr = rem >> 7, ch = rem & 127; ((LAS float*)(lds + PL_CW))[idx] = p.conv_w[i * 3072 + arr * 1024 + h * 128 + ch]; }
}
__device__ __forceinline__ void gdn_prep_item(const Params& p, int g, int cu, int h, LAS unsigned char* lds, int tid, int wave, int lane) {
    const bool is_sample = cu >= 256; const int cl = is_sample ? 0 : (cu & 15), c = is_sample ? 0 : 16 * g + cl; const int lr0 = 64 * cu;
    const int bseq = is_sample ? (cu - 256) : (cu >> 4);
    const bf16* PROJ = (const bf16*)(p.ws + WS_BIG); bf16* HALO = (bf16*)(p.ws + WS_HALO);
    unsigned char* ex = p.ws + WS_EX + (size_t)(cu * 8 + h) * EX_ITEM;
    LAS float* GS = (LAS float*)(lds + PL_GS);
    const int fr = lane & 15, fq = lane >> 4;
    const int r = tid >> 3, ch0 = (tid & 7) * 16;
    u32x4 raw[3][4][2];
#pragma unroll
    for (int arr = 0; arr < 3; ++arr)
#pragma unroll
        for (int i = 0; i < 4; ++i) {
            const int rr = r - 3 + i, col = arr * 1024 + h * 128 + ch0;
            if (rr >= 0 || cl > 0) { const bf16* src = PROJ + (size_t)(lr0 + rr) * NPROJ + col; raw[arr][i][0] = *(const u32x4*)src; raw[arr][i][1] = *(const u32x4*)(src + 8); }
            else if (!is_sample && g == 1) { const bf16* src = HALO + ((size_t)bseq * 3 + (3 + rr)) * 3072 + col; raw[arr][i][0] = *(const u32x4*)src; raw[arr][i][1] = *(const u32x4*)(src + 8); }
            else if (is_sample) { const float* src = p.state_conv + ((size_t)bseq * 3 + (3 + rr)) * 3072 + col; float t[8];
#pragma unroll
                for (int hh = 0; hh < 2; ++hh) { const f32x4 t0 = *(const f32x4*)(src + 8 * hh), t1 = *(const f32x4*)(src + 8 * hh + 4);
#pragma unroll
                    for (int j = 0; j < 4; ++j) { t[j] = t0[j]; t[4 + j] = t1[j]; }
                    raw[arr][i][hh] = pack8(t); }
            } else { raw[arr][i][0] = (u32x4){0u, 0u, 0u, 0u}; raw[arr][i][1] = (u32x4){0u, 0u, 0u, 0u}; }
        }
    {
        const float* GB = (const float*)(p.ws + WS_GB) + (size_t)(lr0 + lane) * 16;
        float gv = GB[h]; const float bt = GB[8 + h];
#pragma unroll
        for (int o = 1; o < 64; o <<= 1) { const float t = __shfl_up(gv, o); if (lane >= o) gv += t; }
        GS[lane] = gv; GS[64 + lane] = bt;
    }
    {
        const float Gr = GS[r], Gl = GS[63], br = GS[64 + r];
        const float eg = __expf(Gr), egl = __expf(Gl - Gr);
        const bool lastc = is_sample || c == 31;
#pragma unroll
        for (int arr = 0; arr < 3; ++arr) {
            const int col = arr * 1024 + h * 128 + ch0;
            float acc[16];
#pragma unroll
            for (int j = 0; j < 16; ++j) acc[j] = 0.f;
#pragma unroll
            for (int i = 0; i < 4; ++i) {
                float x[16]; { float t[8]; unpack8(raw[arr][i][0], t);
#pragma unroll
                    for (int j = 0; j < 8; ++j) x[j] = t[j];
                    unpack8(raw[arr][i][1], t);
#pragma unroll
                    for (int j = 0; j < 8; ++j) x[8 + j] = t[j]; }
                const LAS float* wsrc = (const LAS float*)(lds + PL_CW) + (i * 3 + arr) * 128 + ch0;
#pragma unroll
                for (int j4 = 0; j4 < 4; ++j4) { const f32x4 w = *(const LAS f32x4*)(wsrc + 4 * j4);
#pragma unroll
                    for (int e = 0; e < 4; ++e) acc[4 * j4 + e] += x[4 * j4 + e] * w[e]; }
                if (i == 3 && g == 0 && !is_sample && cl == 15 && r >= 61) {
                    bf16* hd = HALO + ((size_t)bseq * 3 + (r - 61)) * 3072 + col; *(u32x4*)hd = raw[arr][3][0]; *(u32x4*)(hd + 8) = raw[arr][3][1]; }
                if (i == 3 && lastc && r >= 61) {
                    float* o = p.out + (is_sample ? O_CONVS : O_CONVP) + ((size_t)bseq * 3 + (r - 61)) * 3072 + col;
#pragma unroll
                    for (int j4 = 0; j4 < 4; ++j4) *(f32x4*)(o + 4 * j4) = (f32x4){x[4 * j4], x[4 * j4 + 1], x[4 * j4 + 2], x[4 * j4 + 3]};
                }
            }
            float ss = 0.f;
#pragma unroll
            for (int j = 0; j < 16; ++j) { acc[j] = siluf_(acc[j]); ss += acc[j] * acc[j]; }
            if (arr < 2) { ss += __shfl_xor(ss, 1); ss += __shfl_xor(ss, 2); ss += __shfl_xor(ss, 4);
                const float sc = rsqrtf(ss + EPS) * (arr == 0 ? 0.08838834764831845f : 1.f);
#pragma unroll
                for (int j = 0; j < 16; ++j) acc[j] *= sc; }
            if (arr == 0) {
                float t[8];
#pragma unroll
                for (int hh = 0; hh < 2; ++hh) {
#pragma unroll
                    for (int j = 0; j < 8; ++j) t[j] = acc[8 * hh + j];
                    *(LAS u32x4*)(lds + PL_QL + r * 272 + (ch0 + 8 * hh) * 2) = pack8(t);
#pragma unroll
                    for (int j = 0; j < 8; ++j) t[j] = acc[8 * hh + j] * eg;
                    *(u32x4*)(ex + EX_QD + r * 256 + (ch0 + 8 * hh) * 2) = pack8(t);
                }
            } else if (arr == 1) {
                float t[8];
#pragma unroll
                for (int hh = 0; hh < 2; ++hh) {
#pragma unroll
                    for (int j = 0; j < 8; ++j) t[j] = acc[8 * hh + j];
                    *(LAS u32x4*)(lds + PL_KL + r * 272 + (ch0 + 8 * hh) * 2) = pack8(t);
                }
                const float wsc = br * eg;
#pragma unroll
                for (int j = 0; j < 16; ++j) {
                    *(LAS unsigned short*)(lds + PL_KDT + (ch0 + j) * 144 + r * 2) = f2bf(acc[j] * egl);
                    *(LAS unsigned short*)(lds + PL_RT + (128 + ch0 + j) * 144 + r * 2) = f2bf(acc[j] * wsc);
                }
            } else {
#pragma unroll
                for (int j = 0; j < 16; ++j) *(LAS unsigned short*)(lds + PL_RT + (ch0 + j) * 144 + r * 2) = f2bf(acc[j] * br);
            }
            __builtin_amdgcn_sched_barrier(0);
        }
    }
    __syncthreads();
    {
#pragma unroll
        for (int n = 0; n < 4; ++n) {
            const int job = wave * 4 + n, typ = job >> 4, t = job & 15, ib = t >> 2, jb = t & 3;
            if (jb > ib) continue;
            f32x4 acc = (f32x4){0.f, 0.f, 0.f, 0.f};
            if (typ == 0) {
#pragma unroll
                for (int ks = 0; ks < 4; ++ks) { const bf16x8 a = lds_frag16(lds + PL_KL + (16 * ib + fr) * 272 + (32 * ks + 8 * fq) * 2), b = lds_frag16(lds + PL_KL + (16 * jb + fr) * 272 + (32 * ks + 8 * fq) * 2);
                    acc = MFMA16(a, b, acc); }
                const int j = 16 * jb + fr; const float Gj = GS[j];
#pragma unroll
                for (int e = 0; e < 4; ++e) { const int i = 16 * ib + 4 * fq + e; const float v = (j < i) ? GS[64 + i] * acc[e] * __expf(GS[i] - Gj) : 0.f; *(LAS float*)(lds + PL_AM + (i * 65 + j) * 4) = v; }
            } else {
#pragma unroll
                for (int ks = 0; ks < 4; ++ks) { const bf16x8 a = lds_frag16(lds + PL_KL + (16 * jb + fr) * 272 + (32 * ks + 8 * fq) * 2), b = lds_frag16(lds + PL_QL + (16 * ib + fr) * 272 + (32 * ks + 8 * fq) * 2);
                    acc = MFMA16(a, b, acc); }
                const int i = 16 * ib + fr; const float Gi = GS[i]; float v[4];
#pragma unroll
                for (int e = 0; e < 4; ++e) { const int j = 16 * jb + 4 * fq + e; v[e] = (j <= i) ? acc[e] * __expf(Gi - GS[j]) : 0.f; }
                u32x2 o; o.x = cvt_pk_bf16(v[0], v[1]); o.y = cvt_pk_bf16(v[2], v[3]);
                *(LAS u32x2*)(lds + PL_QKS + i * 144 + (16 * jb + 4 * fq) * 2) = o;
            }
        }
#pragma unroll
        for (int n = 0; n < 4; ++n) {
            const int job = wave * 4 + n, typ = job >> 4, t = job & 15, ib = t >> 2, jb = t & 3;
            if (jb <= ib) continue;
            if (typ == 0) { } else { u32x2 o; o.x = 0u; o.y = 0u; *(LAS u32x2*)(lds + PL_QKS + (16 * ib + fr) * 144 + (16 * jb + 4 * fq) * 2) = o; }
        }
    }
    __syncthreads();
    {
        const LAS float* AMf = (const LAS float*)(lds + PL_AM); LAS float* TMf = (LAS float*)(lds + PL_TM);
        if (wave < 4) {
            const int b0 = 16 * wave; float t[16];
            const LAS float* arow = AMf + b0 * 65 + b0;
#pragma unroll
            for (int i = 0; i < 16; ++i) {
                float sacc_ = fmaxf(1.f - fabsf((float)fr - (float)i), 0.f);
#pragma unroll
                for (int j = 0; j < i; ++j) sacc_ -= arow[i * 65 + j] * t[j];
                t[i] = sacc_;
                if (fq == 0) TMf[(b0 + i) * 65 + b0 + fr] = sacc_;
            }
        } else {
            if (wave == 7 && lane == 0) ((float*)(p.ws + WS_DL))[cu * 8 + h] = __expf(GS[63]);
            const int t2 = tid - 256;
#pragma unroll
            for (int k = 0; k < 4; ++k) { const int idx = t2 + 256 * k, d = idx >> 3, c8 = idx & 7;
                *(u32x4*)(ex + EX_KDT + d * 128 + c8 * 16) = *(const LAS u32x4*)(lds + PL_KDT + d * 144 + c8 * 16); }
#pragma unroll
            for (int k = 0; k < 2; ++k) { const int idx = t2 + 256 * k;
                *(u32x4*)(ex + EX_QK + (idx >> 3) * 128 + (idx & 7) * 16) = *(const LAS u32x4*)(lds + PL_QKS + (idx >> 3) * 144 + (idx & 7) * 16); }
        }
        __syncthreads();
#pragma unroll
        for (int dd = 1; dd < 4; ++dd) {
            if (wave < 4 - dd) {
                const int J = wave, I = wave + dd;
                f32x4 c4 = (f32x4){0.f, 0.f, 0.f, 0.f};
#pragma unroll
                for (int kk = 0; kk < dd; ++kk) { const int K = J + kk;
#pragma unroll
                    for (int k0 = 0; k0 < 16; k0 += 4) { const float a = AMf[(16 * I + fr) * 65 + 16 * K + k0 + fq], b = TMf[(16 * K + k0 + fq) * 65 + 16 * J + fr];
                        c4 = __builtin_amdgcn_mfma_f32_16x16x4f32(a, b, c4, 0, 0, 0); } }
                f32x4 r4 = (f32x4){0.f, 0.f, 0.f, 0.f};
#pragma unroll
                for (int s4 = 0; s4 < 4; ++s4) { const float a = TMf[(16 * I + fr) * 65 + 16 * I + 4 * fq + s4]; r4 = __builtin_amdgcn_mfma_f32_16x16x4f32(a, c4[s4], r4, 0, 0, 0); }
#pragma unroll
                for (int j = 0; j < 4; ++j) TMf[(16 * I + 4 * fq + j) * 65 + 16 * J + fr] = -r4[j];
            }
            __syncthreads();
        }
        {   const int i = tid >> 3, j0 = (tid & 7) * 8; float v[8];
#pragma unroll
            for (int jj = 0; jj < 8; ++jj) v[jj] = ((j0 >> 4) > (i >> 4)) ? 0.f : TMf[i * 65 + j0 + jj];
            *(LAS u32x4*)(lds + PL_TB + i * 144 + j0 * 2) = pack8(v); }
    }
    __syncthreads();
    {
#pragma unroll
        for (int mb = 0; mb < 4; ++mb) {
            f32x4 au = (f32x4){0.f, 0.f, 0.f, 0.f}, aw = (f32x4){0.f, 0.f, 0.f, 0.f};
#pragma unroll
            for (int ks = 0; ks < 2; ++ks) {
                const bf16x8 tf = lds_frag16(lds + PL_TB + (16 * mb + fr) * 144 + (32 * ks + 8 * fq) * 2);
                const bf16x8 rv = lds_frag16(lds + PL_RT + (16 * wave + fr) * 144 + (32 * ks + 8 * fq) * 2);
                const bf16x8 rk = lds_frag16(lds + PL_RT + (128 + 16 * wave + fr) * 144 + (32 * ks + 8 * fq) * 2);
                au = MFMA16(tf, rv, au);
                aw = MFMA16(rk, tf, aw);
            }
            u32x2 o; o.x = cvt_pk_bf16(au[0], au[1]); o.y = cvt_pk_bf16(au[2], au[3]);
            *(LAS u32x2*)(lds + PL_UTS + (16 * wave + fr) * 144 + (16 * mb + 4 * fq) * 2) = o;
            o.x = cvt_pk_bf16(-aw[0], -aw[1]); o.y = cvt_pk_bf16(-aw[2], -aw[3]);
            *(LAS u32x2*)(lds + PL_WNS + (16 * mb + fr) * 272 + (16 * wave + 4 * fq) * 2) = o;
        }
    }
    __syncthreads();
    {
#pragma unroll
        for (int k = 0; k < 2; ++k) { const int idx = tid + 512 * k;
            *(u32x4*)(ex + EX_UT + (idx >> 3) * 128 + (idx & 7) * 16) = *(const LAS u32x4*)(lds + PL_UTS + (idx >> 3) * 144 + (idx & 7) * 16);
            *(u32x4*)(ex + EX_WN + (idx >> 4) * 256 + (idx & 15) * 16) = *(const LAS u32x4*)(lds + PL_WNS + (idx >> 4) * 272 + (idx & 15) * 16); }
    }
    __syncthreads();
}

constexpr int SL_K = 0, SL_V = 27648;
__device__ __forceinline__ void swa_item(const Params& p, int g, int cu, int kvh, LAS unsigned char* lds, int tid, int wave, int lane) {
    const bool is_sample = cu >= 256; const int cl = is_sample ? 0 : (cu & 15), c = is_sample ? 0 : 16 * g + cl; const int lr0 = 64 * cu;
    const int bseq = is_sample ? (cu - 256) : (cu >> 4);
    const int nkc = is_sample ? 3 : (c < 2 ? c + 1 : 3);
    bf16* PROJ = (bf16*)(p.ws + WS_BIG); bf16* KVT = (bf16*)(p.ws + WS_KVT);
    const int fr = lane & 15, fq = lane >> 4;
    const int hq = kvh * 4 + (wave >> 1), t0 = 32 * (wave & 1);
    u32x4 qr[2][2];
#pragma unroll
    for (int mb = 0; mb < 2; ++mb) { const bf16* qsrc = PROJ + (size_t)(lr0 + t0 + 16 * mb + fr) * NPROJ + PC_QS + hq * 64 + 8 * fq; qr[mb][0] = *(const u32x4*)qsrc; qr[mb][1] = *(const u32x4*)(qsrc + 32); }
    const f32x4 qn00 = *(const f32x4*)(p.q_norm + 8 * fq), qn01 = *(const f32x4*)(p.q_norm + 8 * fq + 4), qn10 = *(const f32x4*)(p.q_norm + 32 + 8 * fq), qn11 = *(const f32x4*)(p.q_norm + 32 + 8 * fq + 4);
    const float sink = p.sinks[hq];
    {
        const int row = tid >> 3, d8 = tid & 7;
        const f32x4 kn0 = *(const f32x4*)(p.k_norm + d8 * 8), kn1 = *(const f32x4*)(p.k_norm + d8 * 8 + 4);
        u32x4 kr[3], vr[3]; f32x4 ck[2][2], cv[2][2];
#pragma unroll
        for (int s = 0; s < 3; ++s) {
            if (s >= nkc) continue;
            if (is_sample && s < 2) {
                const size_t off = (((size_t)bseq * 128 + 64 * s + row) * 4 + kvh) * 64 + d8 * 8;
                ck[s][0] = *(const f32x4*)(p.cache_k + off); ck[s][1] = *(const f32x4*)(p.cache_k + off + 4); cv[s][0] = *(const f32x4*)(p.cache_v + off); cv[s][1] = *(const f32x4*)(p.cache_v + off + 4);
            } else if (!is_sample && cl - (nkc - 1 - s) < 0) {
                const bf16* src = KVT + ((size_t)bseq * 128 + 64 * (cl - (nkc - 1 - s) + 2) + row) * 512 + kvh * 64 + d8 * 8; kr[s] = *(const u32x4*)src; vr[s] = *(const u32x4*)(src + 256);
            } else {
                const int lrk = lr0 - 64 * (nkc - 1 - s) + row;
                kr[s] = *(const u32x4*)(PROJ + (size_t)lrk * NPROJ + PC_KS + kvh * 64 + d8 * 8); vr[s] = *(const u32x4*)(PROJ + (size_t)lrk * NPROJ + PC_VS + kvh * 64 + d8 * 8);
            }
        }
#pragma unroll
        for (int s = 0; s < 3; ++s) {
            if (s >= nkc) continue;
            float kv[8], vv[8];
            if (is_sample && s < 2) {
                if (s < 2) {
#pragma unroll
                    for (int j = 0; j < 4; ++j) { kv[j] = ck[s < 2 ? s : 0][0][j]; kv[4 + j] = ck[s < 2 ? s : 0][1][j]; vv[j] = cv[s < 2 ? s : 0][0][j]; vv[4 + j] = cv[s < 2 ? s : 0][1][j]; }
                }
                if (s == 1) { const size_t oo = (((size_t)bseq * 128 + row) * 4 + kvh) * 64 + d8 * 8;
                    *(f32x4*)(p.out + O_KS + oo) = ck[1][0]; *(f32x4*)(p.out + O_KS + oo + 4) = ck[1][1]; *(f32x4*)(p.out + O_VS + oo) = cv[1][0]; *(f32x4*)(p.out + O_VS + oo + 4) = cv[1][1]; }
            } else if (!is_sample && cl - (nkc - 1 - s) < 0) {
                unpack8(kr[s], kv); unpack8(vr[s], vv);
            } else {
                unpack8(kr[s], kv); unpack8(vr[s], vv);
                float ss = 0.f;
#pragma unroll
                for (int j = 0; j < 8; ++j) ss += kv[j] * kv[j];
                ss += __shfl_xor(ss, 1); ss += __shfl_xor(ss, 2); ss += __shfl_xor(ss, 4);
                const float sc = rsqrtf(ss * (1.f / 64.f) + EPS);
#pragma unroll
                for (int j = 0; j < 4; ++j) { kv[j] *= sc * kn0[j]; kv[4 + j] *= sc * kn1[j]; }
                if (s == nkc - 1 && !is_sample && g == 0 && cl >= 14) {
                    bf16* dst = KVT + ((size_t)bseq * 128 + 64 * (cl - 14) + row) * 512 + kvh * 64 + d8 * 8; *(u32x4*)dst = pack8(kv); *(u32x4*)(dst + 256) = pack8(vv); }
                if (s == nkc - 1 && (is_sample || c >= 30)) {
                    const int orow = is_sample ? 64 + row : 64 * (c - 30) + row;
                    const size_t oo = (((size_t)bseq * 128 + orow) * 4 + kvh) * 64 + d8 * 8;
                    float* ok = p.out + (is_sample ? O_KS : O_KP) + oo; float* ov = p.out + (is_sample ? O_VS : O_VP) + oo;
                    *(f32x4*)ok = (f32x4){kv[0], kv[1], kv[2], kv[3]}; *(f32x4*)(ok + 4) = (f32x4){kv[4], kv[5], kv[6], kv[7]};
                    *(f32x4*)ov = (f32x4){vv[0], vv[1], vv[2], vv[3]}; *(f32x4*)(ov + 4) = (f32x4){vv[4], vv[5], vv[6], vv[7]};
                }
            }
            const int key = 64 * s + row;
            *(LAS u32x4*)(lds + SL_K + key * 144 + d8 * 16) = pack8(kv);
#pragma unroll
            for (int j = 0; j < 8; ++j) *(LAS unsigned short*)(lds + SL_V + (d8 * 8 + j) * 392 + key * 2) = f2bf(vv[j]);
        }
    }
    __syncthreads();
    bf16x8 qf[2][2];
#pragma unroll
    for (int mb = 0; mb < 2; ++mb) {
        float q0[8], q1[8]; unpack8(qr[mb][0], q0); unpack8(qr[mb][1], q1);
        float ss = 0.f;
#pragma unroll
        for (int j = 0; j < 8; ++j) ss += q0[j] * q0[j] + q1[j] * q1[j];
        ss += __shfl_xor(ss, 16); ss += __shfl_xor(ss, 32);
        const float sc = rsqrtf(ss * (1.f / 64.f) + EPS) * 0.125f;
#pragma unroll
        for (int j = 0; j < 4; ++j) { q0[j] *= sc * qn00[j]; q0[4 + j] *= sc * qn01[j]; q1[j] *= sc * qn10[j]; q1[4 + j] *= sc * qn11[j]; }
        qf[mb][0] = as_bf16x8(pack8(q0)); qf[mb][1] = as_bf16x8(pack8(q1));
    }
    f32x4 sacc[12][2];
#pragma unroll
    for (int nb = 0; nb < 12; ++nb) {
#pragma unroll
        for (int mb = 0; mb < 2; ++mb) sacc[nb][mb] = (f32x4){0.f, 0.f, 0.f, 0.f};
        if (nb < 4 * nkc) {
#pragma unroll
            for (int ks = 0; ks < 2; ++ks) { const bf16x8 a = lds_frag16(lds + SL_K + (16 * nb + fr) * 144 + (32 * ks + 8 * fq) * 2);
#pragma unroll
                for (int mb = 0; mb < 2; ++mb) sacc[nb][mb] = MFMA16(a, qf[mb][ks], sacc[nb][mb]); }
        }
    }
    float inv[2];
#pragma unroll
    for (int mb = 0; mb < 2; ++mb) {
        float mx = sink;
#pragma unroll
        for (int nb = 0; nb < 12; ++nb) if (nb < 4 * nkc) {
#pragma unroll
            for (int e = 0; e < 4; ++e) mx = fmaxf(mx, sacc[nb][mb][e]); }
        mx = fmaxf(mx, __shfl_xor(mx, 16)); mx = fmaxf(mx, __shfl_xor(mx, 32));
        float sum = 0.f;
#pragma unroll
        for (int nb = 0; nb < 12; ++nb) {
#pragma unroll
            for (int e = 0; e < 4; ++e) { const float pv = (nb < 4 * nkc) ? __expf(sacc[nb][mb][e] - mx) : 0.f; sacc[nb][mb][e] = pv; sum += pv; } }
        sum += __shfl_xor(sum, 16); sum += __shfl_xor(sum, 32);
        inv[mb] = 1.f / (sum + __expf(sink - mx));
    }
    f32x4 oacc[4][2];
#pragma unroll
    for (int db = 0; db < 4; ++db)
#pragma unroll
        for (int mb = 0; mb < 2; ++mb) oacc[db][mb] = (f32x4){0.f, 0.f, 0.f, 0.f};
#pragma unroll
    for (int ks2 = 0; ks2 < 6; ++ks2) {
        if (ks2 < 2 * nkc) {
            bf16x8 bp[2];
#pragma unroll
            for (int mb = 0; mb < 2; ++mb) bp[mb] = pack_acc2(sacc[2 * ks2][mb], sacc[2 * ks2 + 1][mb]);
#pragma unroll
            for (int db = 0; db < 4; ++db) {
                const LAS unsigned char* vb = lds + SL_V + (16 * db + fr) * 392 + (32 * ks2 + 4 * fq) * 2;
                const bf16x8 a = lds_frag8x2(vb, vb + 32);
#pragma unroll
                for (int mb = 0; mb < 2; ++mb) oacc[db][mb] = MFMA16(a, bp[mb], oacc[db][mb]);
            }
        }
    }
#pragma unroll
    for (int mb = 0; mb < 2; ++mb) {
        bf16* od = PROJ + (size_t)(lr0 + t0 + 16 * mb + fr) * NPROJ + PC_QS + hq * 64 + 4 * fq;
#pragma unroll
        for (int db = 0; db < 4; ++db) { const f32x4 v = oacc[db][mb] * inv[mb]; u32x2 o; o.x = cvt_pk_bf16(v[0], v[1]); o.y = cvt_pk_bf16(v[2], v[3]); *(u32x2*)(od + 16 * db) = o; }
    }
    __syncthreads();
}

constexpr int CL_WN = 0, CL_QD = 17408, CL_UT = 34816, CL_KDT = 52224, CL_QK = 69632, CL_OT = 78336, CL_SSQ = 112128, CL_DL = 114176, CL_PR = 114304;
__device__ __forceinline__ void scan_chain(const Params& p, int g, int s, int h, LAS unsigned char* lds, int tid, int wave, int lane) {
    const bool is_sample = s >= 16; const int nsteps = is_sample ? 1 : 16; const int cu0 = is_sample ? 256 + (s - 16) : 16 * s;
    const int bseq = is_sample ? (s - 16) : s;
    const int fr = lane & 15, fq = lane >> 4;
    bf16* PROJ = (bf16*)(p.ws + WS_BIG);
    const float* DL = (const float*)(p.ws + WS_DL);
    f32x4 sacc[8];
    const int e = 16 * wave + fr;
    if (is_sample || g == 1) { const float* S0 = (is_sample ? p.state_gdn : p.out + O_GDNP) + ((size_t)bseq * 8 + h) * 16384;
#pragma unroll
        for (int db = 0; db < 8; ++db) { const float* pb = S0 + (4 * fq) * 128 + e + db * 2048; asm volatile("" : "+v"(pb));
#pragma unroll
            for (int j = 0; j < 4; ++j) sacc[db][j] = pb[j * 128]; }
    } else {
#pragma unroll
        for (int db = 0; db < 8; ++db) sacc[db] = (f32x4){0.f, 0.f, 0.f, 0.f};
    }
    u32x4 pf[9];
    const unsigned char* exb = p.ws + WS_EX + (size_t)(cu0 * 8 + h) * EX_ITEM;
#define SCAN_LOAD(ptr) do { _Pragma("unroll") for (int k = 0; k < 9; ++k) pf[k] = *(const u32x4*)((ptr) + (size_t)(tid + 512 * k) * 16); } while (0)
#define SCAN_STORE() do { _Pragma("unroll") for (int k = 0; k < 9; ++k) { const int off = (tid + 512 * k) * 16, wi = off & 16383; \
        if (k == 2 || k == 3) *(LAS u32x4*)(lds + CL_WN + (wi >> 8) * 272 + (wi & 255)) = pf[k]; \
        else if (k == 4 || k == 5) *(LAS u32x4*)(lds + CL_QD + (wi >> 8) * 272 + (wi & 255)) = pf[k]; \
        else { const int base = (k < 2) ? CL_UT : (k < 8 ? CL_KDT : CL_QK); LAS unsigned char* d = lds + base + (wi >> 7) * 136 + (wi & 127); \
            u32x2 lo, hi; lo.x = pf[k].x; lo.y = pf[k].y; hi.x = pf[k].z; hi.y = pf[k].w; *(LAS u32x2*)d = lo; *(LAS u32x2*)(d + 8) = hi; } } } while (0)
    SCAN_LOAD(exb); SCAN_STORE();
    if (tid < nsteps) *(LAS float*)(lds + CL_DL + tid * 4) = DL[(cu0 + tid) * 8 + h];
    if (tid < 384) { const int w3 = tid >> 7, cc = tid & 127; *(LAS float*)(lds + CL_PR + tid * 4) = w3 == 0 ? p.gdn_norm[cc] : p.b_merge[(w3 - 1) * 1024 + h * 128 + cc]; }
    __syncthreads();
    u32x4 mg[4][2];
#define SCAN_MG(cu_) do { const bf16* prow = PROJ + (size_t)(64 * (cu_) + (tid >> 3)) * NPROJ + h * 128 + (tid & 7) * 16; _Pragma("unroll") for (int hh = 0; hh < 2; ++hh) { \
        mg[0][hh] = *(const u32x4*)(prow + PC_Z + 8 * hh); mg[1][hh] = *(const u32x4*)(prow + PC_GA + 8 * hh); mg[2][hh] = *(const u32x4*)(prow + PC_GB + 8 * hh); mg[3][hh] = *(const u32x4*)(prow + PC_QS + 8 * hh); } } while (0)
    SCAN_MG(cu0);
    if (nsteps > 1) SCAN_LOAD(exb + (size_t)8 * EX_ITEM);
    for (int st = 0; st < nsteps; ++st) {
        const int cu = cu0 + st, lr0 = 64 * cu;
        const float dl = *(const LAS float*)(lds + CL_DL + st * 4);
        bf16x8 Bs[4];
#pragma unroll
        for (int ks = 0; ks < 4; ++ks) Bs[ks] = pack_acc2(sacc[2 * ks], sacc[2 * ks + 1]);
        f32x4 vacc[4], oacc[4];
        bf16x8 FA[4], FB[4];
#define LD_W(F, mb) do { _Pragma("unroll") for (int ks = 0; ks < 4; ++ks) { const LAS unsigned char* wb = lds + CL_WN + (16 * (mb) + fr) * 272 + (32 * ks + 4 * fq) * 2; F[ks] = lds_frag8x2(wb, wb + 32); } } while (0)
#define LD_Q(F, mb) do { _Pragma("unroll") for (int ks = 0; ks < 4; ++ks) { const LAS unsigned char* qb = lds + CL_QD + (16 * (mb) + fr) * 272 + (32 * ks + 4 * fq) * 2; F[ks] = lds_frag8x2(qb, qb + 32); } } while (0)
#define LD_QK(F, m0) do { _Pragma("unroll") for (int mb = 0; mb < 2; ++mb) _Pragma("unroll") for (int k2 = 0; k2 < 2; ++k2) { \
            const LAS unsigned char* kb = lds + CL_QK + (16 * ((m0) + mb) + fr) * 136 + (32 * k2 + 4 * fq) * 2; F[2 * mb + k2] = lds_frag8x2(kb, kb + 32); } } while (0)
#define LD_KD(F, d0) do { _Pragma("unroll") for (int d = 0; d < 2; ++d) _Pragma("unroll") for (int k2 = 0; k2 < 2; ++k2) { \
            const LAS unsigned char* kb = lds + CL_KDT + (16 * ((d0) + d) + fr) * 136 + (32 * k2 + 4 * fq) * 2; F[2 * d + k2] = lds_frag8x2(kb, kb + 32); } } while (0)
#define MM_W(F, mb) do { _Pragma("unroll") for (int ks = 0; ks < 4; ++ks) vacc[mb] = MFMA16(F[ks], Bs[ks], vacc[mb]); } while (0)
#define MM_Q(F, mb) do { _Pragma("unroll") for (int ks = 0; ks < 4; ++ks) oacc[mb] = MFMA16(F[ks], Bs[ks], oacc[mb]); } while (0)
#define MM_QK(F, m0) do { _Pragma("unroll") for (int mb = 0; mb < 2; ++mb) _Pragma("unroll") for (int k2 = 0; k2 < 2; ++k2) oacc[(m0) + mb] = MFMA16(F[2 * mb + k2], Bv[k2], oacc[(m0) + mb]); } while (0)
#define MM_KD(F, d0) do { _Pragma("unroll") for (int d = 0; d < 2; ++d) { sacc[(d0) + d] = sacc[(d0) + d] * dl; _Pragma("unroll") for (int k2 = 0; k2 < 2; ++k2) sacc[(d0) + d] = MFMA16(F[2 * d + k2], Bv[k2], sacc[(d0) + d]); } } while (0)
#define SB() __builtin_amdgcn_sched_barrier(0)
#pragma unroll
        for (int mb = 0; mb < 4; ++mb) {
            const u32x2 uu = *(const LAS u32x2*)(lds + CL_UT + e * 136 + (16 * mb + 4 * fq) * 2);
            vacc[mb] = (f32x4){bflo(uu.x), bfhi(uu.x), bflo(uu.y), bfhi(uu.y)};
            oacc[mb] = (f32x4){0.f, 0.f, 0.f, 0.f};
        }
        LD_W(FA, 0); SB();
        LD_W(FB, 1); MM_W(FA, 0); SB();
        LD_W(FA, 2); MM_W(FB, 1); SB();
        LD_W(FB, 3); MM_W(FA, 2); SB();
        LD_Q(FA, 0); MM_W(FB, 3); SB();
        LD_Q(FB, 1); MM_Q(FA, 0); SB();
        LD_Q(FA, 2); MM_Q(FB, 1); SB();
        LD_Q(FB, 3); MM_Q(FA, 2); SB();
        LD_QK(FA, 0); MM_Q(FB, 3); SB();
        bf16x8 Bv[2];
#pragma unroll
        for (int k2 = 0; k2 < 2; ++k2) Bv[k2] = pack_acc2(vacc[2 * k2], vacc[2 * k2 + 1]);
        LD_QK(FB, 2); MM_QK(FA, 0); SB();
        LD_KD(FA, 0); MM_QK(FB, 2); SB();
        LD_KD(FB, 2); MM_KD(FA, 0); SB();
        LD_KD(FA, 4); MM_KD(FB, 2); SB();
        LD_KD(FB, 6); MM_KD(FA, 4); SB();
        MM_KD(FB, 6);
#undef LD_W
#undef LD_Q
#undef MM_W
#undef MM_Q
#undef MM_QK
#undef MM_KD
#undef SB
#undef LD_QK
#undef LD_KD
        SEC(16);
#pragma unroll
        for (int mb = 0; mb < 4; ++mb)
#pragma unroll
            for (int j = 0; j < 4; ++j) *(LAS float*)(lds + CL_OT + ((16 * mb + 4 * fq + j) * 132 + e) * 4) = oacc[mb][j];
        __syncthreads();
        SEC(17);
        if (st + 1 < nsteps) { SCAN_STORE(); if (st + 2 < nsteps) SCAN_LOAD(exb + (size_t)(st + 2) * 8 * EX_ITEM); }
        {
            const int i = tid >> 3, c0 = (tid & 7) * 16;
            f32x4 ov[4]; float ssq = 0.f;
#pragma unroll
            for (int q4 = 0; q4 < 4; ++q4) { ov[q4] = *(const LAS f32x4*)(lds + CL_OT + (i * 132 + c0 + 4 * q4) * 4); ssq += (ov[q4][0] * ov[q4][0] + ov[q4][1] * ov[q4][1]) + (ov[q4][2] * ov[q4][2] + ov[q4][3] * ov[q4][3]); }
            ssq += __shfl_xor(ssq, 1); ssq += __shfl_xor(ssq, 2); ssq += __shfl_xor(ssq, 4);
            const float rstd = rsqrtf(ssq * (1.f / 128.f) + EPS);
            const LAS float* PR = (const LAS float*)(lds + CL_PR);
#pragma unroll
            for (int hh = 0; hh < 2; ++hh) {
                float z[8], ga[8], gb[8], os[8], r[8];
                unpack8(mg[0][hh], z); unpack8(mg[1][hh], ga); unpack8(mg[2][hh], gb); unpack8(mg[3][hh], os);
#pragma unroll
                for (int j = 0; j < 8; ++j) { const int cc = c0 + 8 * hh + j;
                    const float o = ov[2 * hh + (j >> 2)][j & 3] * rstd * PR[cc] * siluf_(z[j]);
                    r[j] = sigmoidf_(ga[j] + PR[128 + cc]) * o + sigmoidf_(gb[j] + PR[256 + cc]) * os[j]; }
                *(u32x4*)(PROJ + (size_t)(lr0 + i) * NPROJ + PC_Z + h * 128 + c0 + 8 * hh) = pack8(r);
            }
        }
        if (st + 1 < nsteps) SCAN_MG(cu + 1);
        __syncthreads();
        SEC(18);
    }
    {   float* So = p.out + (is_sample ? O_GDNS : O_GDNP) + ((size_t)bseq * 8 + h) * 16384;
#pragma unroll
        for (int db = 0; db < 8; ++db) { float* pb = So + (4 * fq) * 128 + e + db * 2048; asm volatile("" : "+v"(pb));
#pragma unroll
            for (int j = 0; j < 4; ++j) pb[j * 128] = sacc[db][j]; }
    }
#undef SCAN_LOAD
#undef SCAN_STORE
}
__global__ void __launch_bounds__(512, 2) mega_fwd(Params p) {
    extern __shared__ __attribute__((aligned(16))) unsigned char lds_raw[];
    if (threadIdx.x < 4) ((LAS unsigned*)((LAS unsigned char*)lds_raw + LDS_BARST))[threadIdx.x] = 0u;
    __syncthreads();
    const XcdBarrier xbar = xcd_barrier_post((unsigned*)(p.ws + WS_BAR), (volatile LAS unsigned*)((LAS unsigned char*)lds_raw + LDS_BARST));
    LAS unsigned char* lds = (LAS unsigned char*)lds_raw;
    const int G = gridDim.x;
    unsigned char* ws = p.ws;
    float* MOD = (float*)(ws + WS_MOD);
    bf16* H = (bf16*)(ws + WS_H); bf16* ACT = (bf16*)(ws + WS_BIG); bf16* PROJ = (bf16*)(ws + WS_BIG);
    float* Y = p.out + O_Y;

    enum { K_P0, K_MOD, K_SWIGLU, K_RES, K_PROJ, K_MIX, K_SCAN };
#pragma nounroll
    for (int ph = 0; ph < 17; ++ph) {
        int tid_ = threadIdx.x; asm volatile("" : "+v"(tid_));
        const int tid = tid_, lane = tid & 63, wave = __builtin_amdgcn_readfirstlane(tid >> 6);
        int bx_ = blockIdx.x; asm volatile("" : "+s"(bx_)); const int bx = bx_;
        int kind, g = -1, ffn = 0;
        if (ph == 0) kind = K_P0;
        else if (ph <= 3) { kind = ph == 1 ? K_MOD : (ph == 2 ? K_SWIGLU : K_RES); }
        else if (ph <= 13) { const int q = ph - 4; g = q / 5; const int r = q - 5 * g; kind = r == 0 ? K_MOD : (r == 1 ? K_PROJ : (r == 2 ? K_MIX : (r == 3 ? K_SCAN : K_RES))); }
        else { ffn = 1; kind = ph == 14 ? K_MOD : (ph == 15 ? K_SWIGLU : K_RES); }
        const bool first = (ph <= 3);
        switch (kind) {
        case K_P0: p0_phase(p, lds, tid, wave, lane); break;
        case K_MOD: {
            const float* xp = first ? p.x_prompt : Y; const float* xs = first ? p.x_sample : Y + (size_t)NPROMPT * D;
            const float* gain = g >= 0 ? p.norm_mix : (ffn ? p.norm_ffn2 : p.norm_ffn1);
            mod_phase(p, g >= 0, xp, xs, gain, g >= 0 ? 3072 : (ffn ? 6144 : 0), H, g, g >= 0 ? grows_of(g) : NROWS, lds, tid, wave, lane);
        } break;
        case K_SWIGLU: { pg8::Gemm gm{H, (const bf16*)(ws + (ffn ? WS_W2IN : WS_W1IN)), NROWS, 2 * FF, D, D, D, 128, 512 * D}; pg8::StaticOrder S; S.init(NROWS, 2 * FF, G, bx); EpiSwiglu E{ACT};
            pg8::gemm_phase<EpiSwiglu, pg8::StaticOrder, true, true>(lds, gm, S, E, tid); } break;
        case K_RES: {
            const float* xp = first ? p.x_prompt : Y; const float* xs = first ? p.x_sample : Y + (size_t)NPROMPT * D;
            pg8::Gemm gm; EpiRes E{xp, xs, Y, MOD, 0, 0.5f, g};
            if (g >= 0) { gm = pg8::Gemm{PROJ + PC_Z, (const bf16*)(ws + WS_WOUT), grows_of(g), D, D, NPROJ, D, 128, 512 * NPROJ}; E.goff = 5120; E.gscale = 1.0f; }
            else { gm = pg8::Gemm{ACT, (const bf16*)(ws + (ffn ? WS_W2OUT : WS_W1OUT)), NROWS, D, FF, 64, FF, 32768, 44 * 32768};   E.goff = ffn ? 8192 : 2048; }
            pg8::StaticOrder S; S.init(gm.M, gm.N, G, bx);
            pg8::gemm_phase<EpiRes, pg8::StaticOrder, true, true>(lds, gm, S, E, tid); } break;
        case K_PROJ: { pg8::Gemm gm{H, (const bf16*)(ws + WS_WIN), grows_of(g), NPROJ, D, D, D, 128, 512 * D}; pg8::StaticOrder S; S.init(grows_of(g), NPROJ, G, bx); EpiBf16Plain E{PROJ, NPROJ};
            pg8::gemm_phase<EpiBf16Plain, pg8::StaticOrder, true, true>(lds, gm, S, E, tid); } break;
        case K_MIX:
            gdn_prep_stage_cw(p, bx & 7, lds, tid); __syncthreads();
#pragma nounroll
            for (int it = bx; it < ncu_of(g) * 8; it += G) { int t2 = tid; asm volatile("" : "+v"(t2)); gdn_prep_item(p, g, it >> 3, it & 7, lds, t2, __builtin_amdgcn_readfirstlane(t2 >> 6), t2 & 63); }
#pragma nounroll
            for (int it = (bx + 128) % G; it < ncu_of(g) * 4; it += G) { int t2 = tid; asm volatile("" : "+v"(t2)); swa_item(p, g, it >> 2, it & 3, lds, t2, __builtin_amdgcn_readfirstlane(t2 >> 6), t2 & 63); }
            break;
        default:
#pragma nounroll
            for (int ch = bx; ch < (g == 0 ? 384 : 128); ch += G) { int t2 = tid; asm volatile("" : "+v"(t2)); scan_chain(p, g, ch >> 3, ch & 7, lds, t2, __builtin_amdgcn_readfirstlane(t2 >> 6), t2 & 63); }
            break;
        }
        if (ph != 16) xcd_barrier(xbar);
    }
#ifdef EXTRA_SYNCS
    grid.sync(); grid.sync(); grid.sync(); grid.sync(); grid.sync(); grid.sync(); grid.sync(); grid.sync(); grid.sync(); grid.sync();
#endif
}

extern "C" void kernel_launch(void* const* d_in, const int* in_sizes, int n_in, void* d_out, int out_size, void* d_ws, size_t ws_size, hipStream_t stream) {
    static int grid_blocks = 0;
    if (grid_blocks == 0) {
        if (n_in != 27 || ws_size < WS_END) { fprintf(stderr, "kernel_launch: unexpected n_in %d / ws_size %zu (need %zu)\n", n_in, ws_size, (size_t)WS_END); grid_blocks = -1; return; }
        int dev = 0, cus = 0, per_cu = 0;
        (void)hipGetDevice(&dev); (void)hipDeviceGetAttribute(&cus, hipDeviceAttributeMultiprocessorCount, dev);
        (void)hipFuncSetAttribute((const void*)mega_fwd, hipFuncAttributeMaxDynamicSharedMemorySize, LDS_BYTES);
        (void)hipOccupancyMaxActiveBlocksPerMultiprocessor(&per_cu, (const void*)mega_fwd, 512, LDS_BYTES);
        if (per_cu < 1) { fprintf(stderr, "kernel_launch: occupancy query says %d blocks per CU; the in-kernel barriers need every workgroup resident: nothing launched\n", per_cu); grid_blocks = -1; return; }
        grid_blocks = cus;
    }
    if (grid_blocks < 0) return;
    if (hipMemsetAsync((char*)d_ws + WS_BAR, 0, 16384, stream) != hipSuccess) { fprintf(stderr, "kernel_launch: memset of the barrier words failed\n"); return; }
    Params p{};
    const float** pp = (const float**)&p;
    for (int i = 0; i < 27; ++i) pp[i] = (const float*)d_in[i];
    p.out = (float*)d_out; p.ws = (unsigned char*)d_ws;
    void* args[] = {&p};
    hipError_t e = hipLaunchCooperativeKernel((const void*)mega_fwd, dim3(grid_blocks), dim3(512), args, LDS_BYTES, stream);
    if (e != hipSuccess) fprintf(stderr, "cooperative launch failed: %s (grid %d)\n", hipGetErrorString(e), grid_blocks);
}
```

```cpp
#include <hip/hip_runtime.h>
#include <hip/hip_cooperative_groups.h>
#include <cstdio>
#include <cstdint>
namespace cg = cooperative_groups;
namespace pg8 {
#define PG8_LAS __attribute__((address_space(3)))
typedef unsigned short bf16_t;
typedef short bf16x8 __attribute__((ext_vector_type(8)));
typedef float f32x4 __attribute__((ext_vector_type(4)));
typedef unsigned u32x4 __attribute__((ext_vector_type(4)));
constexpr int BM = 256, BK = 64, HALF = 128, HTB = HALF * BK * 2  , STAGE_BYTES = 8 * HTB, NXCD = 8, WGM = 4;

__host__ __device__ __forceinline__ int lds_byte(int r, int c) { const int st = (r >> 4) * 2 + (c >> 5), rr = r & 15, cc = c & 31, ob = rr * 64 + cc * 2; return st * 1024 + (ob ^ (((ob >> 9) & 1) << 5)); }
__host__ __device__ __forceinline__ void stage_rc(int b, int& R, int& C) { const int st = b / 1024, sb = b % 1024, swz = sb ^ (((sb >> 9) & 1) << 5); R = (st >> 1) * 16 + swz / 64; C = (st & 1) * 32 + (swz % 64) / 2; }
__host__ __device__ __forceinline__ int perm32(int rho) { const int n = rho >> 4, i = rho & 15; return 8 * (i >> 2) + 4 * n + (i & 3); }

struct Unit { int pm, pn; };
struct Gemm { const bf16_t* A; const bf16_t* Bt; int M, N, K, lda, ldb, a_kstep, a_tstep; };

struct StaticOrder {
    int nM, nN, nwg, G, c;
    __host__ __device__ void init(int M, int N, int G_, int c_) { nM = M / BM; nN = N / BM; nwg = nM * nN; G = G_; c = c_; }
    __host__ __device__ bool next(int i, Unit& u) const {
        const long L = (long)i * G + c; if (L >= nwg) return false;
        int wgid = (int)L; { const int q = nwg / NXCD, r = nwg % NXCD, xcd = wgid % NXCD, off = wgid / NXCD; wgid = (xcd < r ? xcd * (q + 1) : r * (q + 1) + (xcd - r) * q) + off; }
        const int nig = WGM * nN, gid = wgid / nig, fm = gid * WGM, gsz = (nM - fm) < WGM ? (nM - fm) : WGM;
        u.pm = fm + ((wgid % nig) % gsz); u.pn = (wgid % nig) / gsz; return true;
    }
    __device__ __forceinline__ void a_ready(const Unit&) const {}
    __device__ __forceinline__ void done(const Unit&) const {}
};

__device__ __forceinline__ unsigned cvt_pk_bf16(float lo, float hi) { unsigned r; asm volatile("v_cvt_pk_bf16_f32 %0, %1, %2" : "=v"(r) : "v"(lo), "v"(hi)); return r; }
typedef float f32x2 __attribute__((ext_vector_type(2)));
template <class Epi, class Sched, bool ALIGN_EPI = false, bool SP2 = false>
__device__ __forceinline__ void gemm_phase(PG8_LAS unsigned char* lds, const Gemm g, const Sched& S, const Epi& E, const int tid_in) {
    const int tid = tid_in, wid = __builtin_amdgcn_readfirstlane(tid >> 6), lane = tid & 63, wr = wid >> 2, wc = wid & 3, fr = lane & 15, fq = lane >> 4;
    const int K = g.K, nt = K / BK;
    unsigned voffA[2], voffB[2];
#pragma unroll
    for (int i = 0; i < 2; ++i) { int R, C; stage_rc(tid * 16 + i * 8192, R, C); const int Rb = Epi::PERM ? ((R & ~31) + perm32(R & 31)) : R;
        voffA[i] = (unsigned)(R * g.lda + C) * 2u; voffB[i] = (unsigned)(Rb * g.ldb + C) * 2u; }
    const size_t kstep = (size_t)(BK * 2);
    const size_t hstep = (size_t)HALF * g.ldb * 2;
    const size_t tstep = 2 * hstep;
    const size_t hstepA = (size_t)HALF * g.lda * 2, tstepA = (size_t)g.a_tstep, kstepA = (size_t)g.a_kstep;
    const unsigned ldsw = (unsigned)wid * 1024u;
    const int aoff = lds_byte(wr * 64 + fr, fq * 8), boff = lds_byte(wc * 32 + fr, fq * 8);
#define PG8_SA(b, h) (((b) * 2 + (h)) * HTB)
#define PG8_SB(b, h) ((4 + (b) * 2 + (h)) * HTB)
#define PG8_STAGE(bufoff, gbase, voff) do { _Pragma("unroll") for (int _i = 0; _i < 2; ++_i) \
        __builtin_amdgcn_global_load_lds((const unsigned*)((const char*)(gbase) + (voff)[_i]), (PG8_LAS unsigned*)(lds + (bufoff) + ldsw + _i * 8192), 16, 0, 0); } while (0)
#define PG8_LDA(dst, b, h) do { _Pragma("unroll") for (int m = 0; m < 4; ++m) _Pragma("unroll") for (int k = 0; k < 2; ++k) dst[m][k] = *(const PG8_LAS bf16x8*)(lds + PG8_SA(b, h) + aoff + m * 2048 + k * 1024); } while (0)
#define PG8_LDB(dst, b, h) do { _Pragma("unroll") for (int n = 0; n < 2; ++n) _Pragma("unroll") for (int k = 0; k < 2; ++k) dst[n][k] = *(const PG8_LAS bf16x8*)(lds + PG8_SB(b, h) + boff + n * 2048 + k * 1024); } while (0)
#define PG8_MMA(ai, bj, At, Bt) do { __builtin_amdgcn_s_setprio(1); _Pragma("unroll") for (int m = 0; m < 4; ++m) _Pragma("unroll") for (int n = 0; n < 2; ++n) _Pragma("unroll") for (int k = 0; k < 2; ++k) \
        acc[ai][bj][m][n] = __builtin_amdgcn_mfma_f32_16x16x32_bf16(Bt[n][k], At[m][k], acc[ai][bj][m][n], 0, 0, 0); __builtin_amdgcn_s_setprio(0); } while (0)
#define PG8_WAIT_V(n) asm volatile("s_waitcnt vmcnt(" #n ")" ::: "memory")
#define PG8_WAIT_L(n) asm volatile("s_waitcnt lgkmcnt(" #n ")" ::: "memory")
#define PG8_BAR __builtin_amdgcn_s_barrier()
#define PG8_SCHED __builtin_amdgcn_sched_barrier(0)
    Unit cur, nxt; int ui = 0;
    if (!S.next(0, cur)) return;
    f32x4 acc[2][2][4][2];
#pragma unroll
    for (int a = 0; a < 2; ++a)
#pragma unroll
        for (int b = 0; b < 2; ++b)
#pragma unroll
            for (int m = 0; m < 4; ++m)
#pragma unroll
                for (int n = 0; n < 2; ++n) acc[a][b][m][n] = (f32x4){0.f, 0.f, 0.f, 0.f};
    bf16x8 At[4][2], B0[2][2], B1[2][2];
    const char* cA = (const char*)g.A + (size_t)cur.pm * tstepA; const char* cB = (const char*)g.Bt + (size_t)cur.pn * tstep;
    S.a_ready(cur);
    if constexpr (SP2) {
        PG8_STAGE(PG8_SB(0, 0), cB, voffB); PG8_STAGE(PG8_SB(0, 1), cB + hstep, voffB); PG8_STAGE(PG8_SA(0, 0), cA, voffA); PG8_STAGE(PG8_SA(0, 1), cA + hstepA, voffA);
        if (wr == 1) PG8_BAR;
        PG8_WAIT_V(2); PG8_BAR;
        PG8_STAGE(PG8_SB(1, 0), cB + kstep, voffB); PG8_STAGE(PG8_SA(1, 0), cA + kstepA, voffA); PG8_STAGE(PG8_SB(1, 1), cB + hstep + kstep, voffB);
        PG8_WAIT_V(6); PG8_BAR;
    } else {
        PG8_STAGE(PG8_SB(0, 0), cB, voffB); PG8_STAGE(PG8_SA(0, 0), cA, voffA); PG8_STAGE(PG8_SB(0, 1), cB + hstep, voffB); PG8_STAGE(PG8_SA(0, 1), cA + hstepA, voffA);
        if (wr == 1) PG8_BAR;
        PG8_WAIT_V(4); PG8_BAR;
        PG8_STAGE(PG8_SB(1, 0), cB + kstep, voffB); PG8_STAGE(PG8_SA(1, 0), cA + kstepA, voffA); PG8_STAGE(PG8_SB(1, 1), cB + hstep + kstep, voffB);
        PG8_WAIT_V(6); PG8_BAR;
    }
    for (;;) {
        const bool has_next = S.next(ui + 1, nxt);
        const char* nA = has_next ? (const char*)g.A + (size_t)nxt.pm * tstepA : cA; const char* nB = has_next ? (const char*)g.Bt + (size_t)nxt.pn * tstep : cB;
        for (int t = 0; t < nt; t += 2) {
            const bool last = (t == nt - 2);
            const char* a1 = cA + (size_t)(t + 1) * kstepA;
            const char* a2 = last ? nA : cA + (size_t)(t + 2) * kstepA; const char* b2 = last ? nB : cB + (size_t)(t + 2) * kstep;
            const char* a3 = a2 + kstepA; const char* b3 = b2 + kstep;
            if (last && has_next) S.a_ready(nxt);
            if constexpr (SP2) {
            PG8_LDB(B0, 0, 0); PG8_LDB(B1, 0, 1); PG8_SCHED; PG8_LDA(At, 0, 0); PG8_STAGE(PG8_SA(1, 1), a1 + hstepA, voffA);
            PG8_WAIT_V(8); PG8_WAIT_L(0); PG8_BAR; PG8_MMA(0, 0, At, B0); PG8_MMA(0, 1, At, B1); PG8_BAR; PG8_SCHED;
            PG8_LDA(At, 0, 1); PG8_STAGE(PG8_SB(0, 0), b2, voffB); PG8_STAGE(PG8_SB(0, 1), b2 + hstep, voffB); PG8_STAGE(PG8_SA(0, 0), a2, voffA);
            PG8_WAIT_V(8); PG8_WAIT_L(0); PG8_BAR; PG8_MMA(1, 0, At, B0); PG8_MMA(1, 1, At, B1); PG8_BAR; PG8_SCHED;
            PG8_LDB(B0, 1, 0); PG8_LDB(B1, 1, 1); PG8_SCHED; PG8_LDA(At, 1, 0); PG8_STAGE(PG8_SA(0, 1), a2 + hstepA, voffA);
            PG8_WAIT_V(8); PG8_WAIT_L(0); PG8_BAR; PG8_MMA(0, 0, At, B0); PG8_MMA(0, 1, At, B1); PG8_BAR; PG8_SCHED;
            PG8_LDA(At, 1, 1); PG8_STAGE(PG8_SB(1, 0), b3, voffB); PG8_STAGE(PG8_SB(1, 1), b3 + hstep, voffB); PG8_STAGE(PG8_SA(1, 0), a3, voffA);
            PG8_WAIT_V(8); PG8_WAIT_L(0); PG8_BAR; PG8_MMA(1, 0, At, B0); PG8_MMA(1, 1, At, B1); PG8_BAR; PG8_SCHED;
            } else {
            PG8_LDB(B0, 0, 0); PG8_SCHED; PG8_LDA(At, 0, 0); PG8_STAGE(PG8_SA(1, 1), a1 + hstepA, voffA);
            PG8_WAIT_L(8); PG8_BAR; PG8_WAIT_L(0); PG8_MMA(0, 0, At, B0); PG8_BAR; PG8_SCHED;
            PG8_LDB(B1, 0, 1); PG8_STAGE(PG8_SB(0, 0), b2, voffB);
            PG8_BAR; PG8_WAIT_L(0); PG8_MMA(0, 1, At, B1); PG8_BAR;
            PG8_LDA(At, 0, 1); PG8_STAGE(PG8_SA(0, 0), a2, voffA);
            PG8_BAR; PG8_WAIT_L(0); PG8_MMA(1, 0, At, B0); PG8_BAR; PG8_SCHED;
            PG8_STAGE(PG8_SB(0, 1), b2 + hstep, voffB);
            PG8_WAIT_V(6); PG8_BAR; PG8_MMA(1, 1, At, B1); PG8_BAR;
            PG8_LDB(B0, 1, 0); PG8_SCHED; PG8_LDA(At, 1, 0); PG8_STAGE(PG8_SA(0, 1), a2 + hstepA, voffA);
            PG8_WAIT_L(8); PG8_BAR; PG8_WAIT_L(0); PG8_MMA(0, 0, At, B0); PG8_BAR; PG8_SCHED;
            PG8_LDB(B1, 1, 1); PG8_STAGE(PG8_SB(1, 0), b3, voffB);
            PG8_BAR; PG8_WAIT_L(0); PG8_MMA(0, 1, At, B1); PG8_BAR;
            PG8_LDA(At, 1, 1); PG8_STAGE(PG8_SA(1, 0), a3, voffA);
            PG8_BAR; PG8_WAIT_L(0); PG8_MMA(1, 0, At, B0); PG8_BAR; PG8_SCHED;
            PG8_STAGE(PG8_SB(1, 1), b3 + hstep, voffB);
            PG8_WAIT_V(6); PG8_BAR; PG8_MMA(1, 1, At, B1); PG8_BAR;
            }
        }
        if constexpr (ALIGN_EPI) { if (wr == 0) PG8_BAR; }
        if constexpr (!Epi::AFTER_DRAIN) { E(acc, cur, wr, wc, fr, fq); S.done(cur); }
        if (!has_next) break;
#pragma unroll
        for (int a = 0; a < 2; ++a)
#pragma unroll
            for (int b = 0; b < 2; ++b)
#pragma unroll
                for (int m = 0; m < 4; ++m)
#pragma unroll
                    for (int n = 0; n < 2; ++n) acc[a][b][m][n] = (f32x4){0.f, 0.f, 0.f, 0.f};
        cur = nxt; cA = nA; cB = nB; ++ui;
        if constexpr (ALIGN_EPI) { if (wr == 1) PG8_BAR; }
    }
    PG8_WAIT_V(0);
    if constexpr (!ALIGN_EPI) { if (wr == 0) PG8_BAR; }
    PG8_BAR;
    if constexpr (Epi::AFTER_DRAIN) { E.fused(acc, cur, wr, wc, fr, fq, lds, wid, lane); S.done(cur); }
#undef PG8_SA
#undef PG8_SB
#undef PG8_STAGE
#undef PG8_LDA
#undef PG8_LDB
#undef PG8_MMA
#undef PG8_WAIT_V
#undef PG8_WAIT_L
#undef PG8_BAR
#undef PG8_SCHED
}
}
#define LAS __attribute__((address_space(3)))
typedef unsigned short bf16;
typedef short bf16x8 __attribute__((ext_vector_type(8)));
typedef float f32x4 __attribute__((ext_vector_type(4)));
typedef unsigned u32x4 __attribute__((ext_vector_type(4)));
typedef unsigned u32x2 __attribute__((ext_vector_type(2)));
typedef float f32x2_t __attribute__((ext_vector_type(2)));
typedef __bf16 bf16x2_t __attribute__((ext_vector_type(2)));
__device__ __forceinline__ unsigned cvt_pk_bf16(float lo, float hi) { const f32x2_t v = {lo, hi}; const bf16x2_t b = __builtin_convertvector(v, bf16x2_t); return __builtin_bit_cast(unsigned, b); }

constexpr int D = 1024, NROWS = 34816, NPROMPT = 32768, FF = 2816, NPROJ = 7680, WIN_N = 7696, NMOD = 9216;
constexpr int GROWS_MAX = 18432;
__host__ __device__ constexpr int grows_of(int g) { return g == 0 ? 18432 : 16384; }
__host__ __device__ constexpr int ncu_of(int g) { return g == 0 ? 288 : 256; }
constexpr float EPS = 1e-6f;
constexpr int PC_Z = 3072, PC_QS = 4096, PC_KS = 5120, PC_VS = 5376, PC_GA = 5632, PC_GB = 6656;
constexpr size_t O_Y = 0, O_CONVP = 35651584, O_GDNP = 35799040, O_KP = 37896192, O_VP = 38420480, O_CONVS = 38944768, O_GDNS = 39239680, O_KS = 43433984, O_VS = 44482560;
constexpr size_t MiB = 1u << 20;
constexpr size_t WS_MOD = 0, WS_GB = 2 * MiB, WS_HALO = 3 * MiB + 512 * 1024  , WS_DL = 4 * MiB, WS_KVT = 5 * MiB  ,
    WS_W1IN = 7 * MiB, WS_W1OUT = 18 * MiB, WS_WIN = 24 * MiB, WS_WOUT = 39 * MiB, WS_W2IN = 41 * MiB, WS_W2OUT = 52 * MiB;
constexpr size_t WS_H = 58 * MiB;
constexpr size_t WS_EX = 58 * MiB, WS_BIG = 220 * MiB;
constexpr size_t WS_END = 490 * MiB;
constexpr int EX_ITEM = 73728, EX_UT = 0, EX_WN = 16384, EX_QD = 32768, EX_KDT = 49152, EX_QK = 65536;
constexpr int LDS_BYTES = 151552;
constexpr size_t WS_BAR = 4 * MiB + 256 * 1024;
constexpr int LDS_BARST = LDS_BYTES - 16;

struct Params {
    const float *x_prompt, *x_sample, *state_conv, *state_gdn, *cache_k, *cache_v, *c_prompt, *c_sample, *w_ada, *b_ada, *norm_ffn1, *ffn1_w_in, *ffn1_w_out,
        *norm_mix, *w_in, *conv_w, *a_log, *dt_bias, *gdn_norm, *q_norm, *k_norm, *sinks, *b_merge, *w_out, *norm_ffn2, *ffn2_w_in, *ffn2_w_out;
    float* out; unsigned char* ws;
};

__device__ __forceinline__ float bflo(unsigned w) { return __uint_as_float(w << 16); }
__device__ __forceinline__ float bfhi(unsigned w) { return __uint_as_float(w & 0xffff0000u); }
__device__ __forceinline__ unsigned short f2bf(float f) { return (unsigned short)(cvt_pk_bf16(f, 0.f) & 0xffffu); }
__device__ __forceinline__ float sigmoidf_(float x) { return __builtin_amdgcn_rcpf(1.f + __expf(-x)); }
__device__ __forceinline__ float siluf_(float x) { return x * sigmoidf_(x); }
__device__ __forceinline__ void unpack8(const u32x4 w, float (&f)[8]) { f[0] = bflo(w.x); f[1] = bfhi(w.x); f[2] = bflo(w.y); f[3] = bfhi(w.y); f[4] = bflo(w.z); f[5] = bfhi(w.z); f[6] = bflo(w.w); f[7] = bfhi(w.w); }
__device__ __forceinline__ u32x4 pack8(const float (&f)[8]) { u32x4 w; w.x = cvt_pk_bf16(f[0], f[1]); w.y = cvt_pk_bf16(f[2], f[3]); w.z = cvt_pk_bf16(f[4], f[5]); w.w = cvt_pk_bf16(f[6], f[7]); return w; }
__device__ __forceinline__ bf16x8 as_bf16x8(u32x4 w) { return __builtin_bit_cast(bf16x8, w); }
__device__ __forceinline__ float wave_sum(float v) {
#pragma unroll
    for (int o = 1; o < 64; o <<= 1) v += __shfl_xor(v, o);
    return v;
}
__device__ __forceinline__ int grow_of(int g, int lr) { return lr < 16384 ? (lr >> 10) * 2048 + 1024 * g + (lr & 1023) : NPROMPT + (lr - 16384); }
__device__ __forceinline__ int modrow_of(int m) { return m < NPROMPT ? (m >> 11) : 16 + ((m - NPROMPT) >> 6); }

struct EpiSwiglu {
    static constexpr bool PERM = true, AFTER_DRAIN = false;
    bf16* O;
    __device__ __forceinline__ void operator()(const pg8::f32x4 (&acc)[2][2][4][2], const pg8::Unit& u, int wr, int wc, int fr, int fq) const {
        const int row0 = u.pm * 256 + wr * 64 + fr, col0 = u.pn * 128 + wc * 32 + 8 * fq; const int kt = col0 >> 6, cin = col0 & 63;
#pragma unroll
        for (int ai = 0; ai < 2; ++ai)
#pragma unroll
            for (int m = 0; m < 4; ++m) {
                float v[8];
#pragma unroll
                for (int n = 0; n < 2; ++n)
#pragma unroll
                    for (int i = 0; i < 4; ++i) { const float gt = acc[ai][0][m][n][i], up = acc[ai][1][m][n][i]; v[n * 4 + i] = siluf_(gt) * up; }
                *(u32x4*)(O + ((size_t)(u.pm * 44 + kt) * 256 + (row0 - u.pm * 256) + ai * 128 + m * 16) * 64 + cin) = pack8(v);
            }
    }
};
struct EpiBf16Plain {
    static constexpr bool PERM = true, AFTER_DRAIN = false;
    bf16* O; int ldc;
    __device__ __forceinline__ void operator()(const pg8::f32x4 (&acc)[2][2][4][2], const pg8::Unit& u, int wr, int wc, int fr, int fq) const {
        const int row0 = u.pm * 256 + wr * 64 + fr, col0 = u.pn * 256 + wc * 32 + 8 * fq;
#pragma unroll
        for (int ai = 0; ai < 2; ++ai)
#pragma unroll
            for (int m = 0; m < 4; ++m)
#pragma unroll
                for (int bj = 0; bj < 2; ++bj) {
                    float v[8];
#pragma unroll
                    for (int n = 0; n < 2; ++n)
#pragma unroll
                        for (int i = 0; i < 4; ++i) v[n * 4 + i] = acc[ai][bj][m][n][i];
                    *(u32x4*)(O + (size_t)(row0 + ai * 128 + m * 16) * ldc + col0 + bj * 128) = pack8(v);
                }
    }
};
struct EpiRes {
    static constexpr bool PERM = false, AFTER_DRAIN = false;
    const float* xin_p; const float* xin_s; float* out; const float* mod; int goff; float gscale; int grp;
    __device__ __forceinline__ void operator()(const pg8::f32x4 (&acc)[2][2][4][2], const pg8::Unit& u, int wr, int wc, int fr, int fq) const {
        const int col0 = u.pn * 256 + wc * 32 + 4 * fq;
#pragma unroll
        for (int ai = 0; ai < 2; ++ai)
#pragma unroll
            for (int m = 0; m < 4; ++m) {
                const int R = u.pm * 256 + ai * 128 + wr * 64 + m * 16 + fr;
                const int gm = grp < 0 ? R : grow_of(grp, R);
                const float* xr = gm < NPROMPT ? xin_p + (size_t)gm * D : xin_s + (size_t)(gm - NPROMPT) * D;
                const float* mr = mod + (size_t)modrow_of(gm) * NMOD + goff;
                float* orow = out + (size_t)gm * D;
#pragma unroll
                for (int bj = 0; bj < 2; ++bj)
#pragma unroll
                    for (int n = 0; n < 2; ++n) {
                        const int c = col0 + bj * 128 + n * 16;
                        const f32x4 xv = *(const f32x4*)(xr + c), gv = *(const f32x4*)(mr + c);
                        *(f32x4*)(orow + c) = xv + gscale * gv * acc[ai][bj][m][n];
                    }
            }
    }
};

__device__ __forceinline__ void transpose_tile(const float* W, int ldw, int K, bf16* WT, int dst_row0, int src_col0, int k0, LAS float* scr, int lane) {
    const int voff = (lane >> 5) * ldw + (lane & 31);
#pragma unroll
    for (int i = 0; i < 32; ++i) { const float* wr = W + (size_t)(k0 + 2 * i) * ldw + src_col0; scr[(2 * i + (lane >> 5)) * 33 + (lane & 31)] = wr[voff]; }
    asm volatile("s_waitcnt lgkmcnt(0)" ::: "memory");
    const int c = lane & 7;
#pragma unroll
    for (int j = 0; j < 4; ++j) { const int n = (lane >> 3) + 8 * j; const LAS float* s = scr + (8 * c) * 33 + n;
        u32x4 o; o.x = cvt_pk_bf16(s[0 * 33], s[1 * 33]); o.y = cvt_pk_bf16(s[2 * 33], s[3 * 33]); o.z = cvt_pk_bf16(s[4 * 33], s[5 * 33]); o.w = cvt_pk_bf16(s[6 * 33], s[7 * 33]);
        *(u32x4*)(WT + (size_t)(dst_row0 + n) * K + k0 + 8 * c) = o; }
    asm volatile("s_waitcnt lgkmcnt(0)" ::: "memory");
}
__device__ __forceinline__ int swiglu_src(int n) { const int pn = n >> 8, r = n & 255; return r < 128 ? 128 * pn + r : FF + 128 * pn + (r - 128); }
__device__ __forceinline__ void p0_phase(const Params& p, LAS unsigned char* lds, int tid, int wave, int lane) {
    unsigned char* ws = p.ws;
    if (blockIdx.x < 144) {
        const int n0 = blockIdx.x * 64, fr = lane & 15, fq = lane >> 4;
        float* MOD = (float*)(ws + WS_MOD);
#pragma unroll 4
        for (int i = 0; i < 12; ++i) { const int idx = tid + 512 * i, r = idx >> 7, k8 = (idx & 127) * 8;
            const float* cp = r < 16 ? p.c_prompt + r * D + k8 : p.c_sample + (r - 16) * D + k8;
            const f32x4 a = *(const f32x4*)cp, b2 = *(const f32x4*)(cp + 4); float v[8];
#pragma unroll
            for (int j = 0; j < 4; ++j) { v[j] = a[j] / (1.f + __expf(-a[j])); v[4 + j] = b2[j] / (1.f + __expf(-b2[j])); }
            *(LAS u32x4*)(lds + r * 2064 + k8 * 2) = pack8(v); }
        __syncthreads();
        f32x4 acc[3][4];
#pragma unroll
        for (int mb = 0; mb < 3; ++mb)
#pragma unroll
            for (int nb = 0; nb < 4; ++nb) acc[mb][nb] = (f32x4){0.f, 0.f, 0.f, 0.f};
        const int kb = wave * 128;
        const int voff = (8 * fq) * NMOD + fr;
#pragma unroll
        for (int ks = 0; ks < 4; ++ks) {
            bf16x8 bfr[4];
#pragma unroll
            for (int nb = 0; nb < 4; ++nb) { float w[8];
#pragma unroll
                for (int j = 0; j < 8; ++j) { const float* wr = p.w_ada + (size_t)(kb + 32 * ks + j) * NMOD + n0 + 16 * nb; w[j] = wr[voff]; }
                bfr[nb] = as_bf16x8(pack8(w)); }
#pragma unroll
            for (int mb = 0; mb < 3; ++mb) { const bf16x8 af = *(const LAS bf16x8*)(lds + (16 * mb + fr) * 2064 + (kb + 32 * ks + 8 * fq) * 2);
#pragma unroll
                for (int nb = 0; nb < 4; ++nb) acc[mb][nb] = __builtin_amdgcn_mfma_f32_16x16x32_bf16(af, bfr[nb], acc[mb][nb], 0, 0, 0); }
        }
        __syncthreads();
        LAS float* part = (LAS float*)lds;
#pragma unroll
        for (int mb = 0; mb < 3; ++mb)
#pragma unroll
            for (int nb = 0; nb < 4; ++nb)
#pragma unroll
                for (int j = 0; j < 4; ++j) part[(wave * 48 + 16 * mb + 4 * fq + j) * 64 + 16 * nb + fr] = acc[mb][nb][j];
        __syncthreads();
#pragma unroll
        for (int i = 0; i < 6; ++i) { const int idx = tid + 512 * i, r = idx >> 6, col = idx & 63; float sm = p.b_ada[n0 + col];
#pragma unroll
            for (int w = 0; w < 8; ++w) sm += part[(w * 48 + r) * 64 + col];
            MOD[(size_t)r * NMOD + n0 + col] = sm; }
        __syncthreads();
    }
    LAS float* scr = (LAS float*)(lds + wave * 16384);
    const int gw = blockIdx.x * 8 + wave, NGW = gridDim.x * 8;
    constexpr int I0 = 16 * 176, I1 = 44 * 32, I2 = 16 * 240, I3 = 16 * 32;
    constexpr int NIT = 2 * I0 + 2 * I1 + I2 + I3;
#pragma unroll 1
    for (int it = gw; it < NIT; it += NGW) {
        int r = it; const float* W; int ldw, K, nb, kb, srcc; size_t wso;
        if (r < I0) { nb = r % 176; kb = r / 176; W = p.ffn1_w_in; ldw = 2 * FF; K = D; wso = WS_W1IN; srcc = swiglu_src(32 * nb); }
        else if ((r -= I0) < I0) { nb = r % 176; kb = r / 176; W = p.ffn2_w_in; ldw = 2 * FF; K = D; wso = WS_W2IN; srcc = swiglu_src(32 * nb); }
        else if ((r -= I0) < I1) { nb = r % 32; kb = r / 32; W = p.ffn1_w_out; ldw = D; K = FF; wso = WS_W1OUT; srcc = 32 * nb; }
        else if ((r -= I1) < I1) { nb = r % 32; kb = r / 32; W = p.ffn2_w_out; ldw = D; K = FF; wso = WS_W2OUT; srcc = 32 * nb; }
        else if ((r -= I1) < I2) { nb = r % 240; kb = r / 240; W = p.w_in; ldw = WIN_N; K = D; wso = WS_WIN; srcc = 32 * nb < 4096 ? 32 * nb : 32 * nb + 16; }
        else { r -= I2; nb = r % 32; kb = r / 32; W = p.w_out; ldw = D; K = D; wso = WS_WOUT; srcc = 32 * nb; }
        transpose_tile(W, ldw, K, (bf16*)(ws + wso), 32 * nb, srcc, 64 * kb, scr, lane);
    }
}

__device__ __forceinline__ void mod_phase(const Params& p, const bool AB, const float* xin_p, const float* xin_s, const float* gain, int moff, bf16* H, int grp, int nrows, LAS unsigned char* lds, int tid, int wave, int lane) {
    const float* MOD = (const float*)(p.ws + WS_MOD);
    LAS float* wabt = (LAS float*)lds;
    if (AB) {
        for (int i = 0; i < 8; ++i) { const int idx = tid + 512 * i, k = idx >> 2, j4 = idx & 3; const f32x4 w = *(const f32x4*)(p.w_in + (size_t)k * WIN_N + 4096 + 4 * j4);
#pragma unroll
            for (int e = 0; e < 4; ++e) wabt[(4 * j4 + e) * 1024 + k] = w[e]; }
        __syncthreads();
    }
    const int gw = blockIdx.x * 8 + wave, NGW = gridDim.x * 8;
    const int rpw = (nrows + NGW - 1) / NGW, rbeg = gw * rpw, rend = (rbeg + rpw < nrows) ? rbeg + rpw : nrows;
    f32x4 gn[4], sh[4], sc[4];
#pragma unroll
    for (int j = 0; j < 4; ++j) gn[j] = *(const f32x4*)(gain + 4 * lane + 256 * j);
    int cur_mod = -1;
    f32x4 xa[4], xb[4];
#define MOD_XPTR(r) ({ const int gm_ = grp < 0 ? (r) : grow_of(grp, (r)); (gm_ < NPROMPT ? xin_p + (size_t)gm_ * D : xin_s + (size_t)(gm_ - NPROMPT) * D); })
#define MOD_LOADX(dst, r) do { const int rc_ = (r) < rend ? (r) : (rend - 1); const float* xr_ = MOD_XPTR(rc_); _Pragma("unroll") for (int j = 0; j < 4; ++j) dst[j] = *(const f32x4*)(xr_ + 4 * lane + 256 * j); } while (0)
    if (rbeg < rend) { MOD_LOADX(xa, rbeg); MOD_LOADX(xb, rbeg + 1); }
#pragma unroll 1
    for (int r = rbeg; r < rend; ++r) {
        f32x4 v[4];
#pragma unroll
        for (int j = 0; j < 4; ++j) { v[j] = xa[j]; xa[j] = xb[j]; }
        MOD_LOADX(xb, r + 2);
        const int gm = grp < 0 ? r : grow_of(grp, r); const int mrow = modrow_of(gm);
        if (mrow != cur_mod) { cur_mod = mrow; const float* mr = MOD + (size_t)mrow * NMOD + moff;
#pragma unroll
            for (int j = 0; j < 4; ++j) { sh[j] = *(const f32x4*)(mr + 4 * lane + 256 * j); sc[j] = *(const f32x4*)(mr + 1024 + 4 * lane + 256 * j); } }
        float ss = 0.f;
#pragma unroll
        for (int j = 0; j < 4; ++j) ss += (v[j][0] * v[j][0] + v[j][1] * v[j][1]) + (v[j][2] * v[j][2] + v[j][3] * v[j][3]);
        const float rstd = rsqrtf(wave_sum(ss) * (1.f / D) + EPS);
#pragma unroll
        for (int j = 0; j < 4; ++j) { v[j] = v[j] * rstd * gn[j] * (1.f + sc[j]) + sh[j];
            u32x2 o; o.x = cvt_pk_bf16(v[j][0], v[j][1]); o.y = cvt_pk_bf16(v[j][2], v[j][3]);
            *(u32x2*)(H + (size_t)r * D + 4 * lane + 256 * j) = o; }
        if (AB) {
            float s16[16];
#pragma unroll
            for (int o = 0; o < 16; ++o) { float s = 0.f;
#pragma unroll
                for (int j = 0; j < 4; ++j) { const f32x4 w = *(const LAS f32x4*)(wabt + o * 1024 + 4 * lane + 256 * j); s += (v[j][0] * w[0] + v[j][1] * w[1]) + (v[j][2] * w[2] + v[j][3] * w[3]); }
                s16[o] = s; }
            const bool b5 = lane & 32, b4 = lane & 16, b3 = lane & 8, b2 = lane & 4;
            float t8[8], t4[4], t2[2], t1;
#pragma unroll
            for (int j = 0; j < 8; ++j) { const float snd = b5 ? s16[j] : s16[8 + j], mine = b5 ? s16[8 + j] : s16[j]; t8[j] = mine + __shfl_xor(snd, 32); }
#pragma unroll
            for (int j = 0; j < 4; ++j) { const float snd = b4 ? t8[j] : t8[4 + j], mine = b4 ? t8[4 + j] : t8[j]; t4[j] = mine + __shfl_xor(snd, 16); }
#pragma unroll
            for (int j = 0; j < 2; ++j) { const float snd = b3 ? t4[j] : t4[2 + j], mine = b3 ? t4[2 + j] : t4[j]; t2[j] = mine + __shfl_xor(snd, 8); }
            { const float snd = b2 ? t2[0] : t2[1], mine = b2 ? t2[1] : t2[0]; t1 = mine + __shfl_xor(snd, 4); }
            t1 += __shfl_xor(t1, 2); t1 += __shfl_xor(t1, 1);
            if ((lane & 3) == 0) { const int o = lane >> 2; float res;
                if (o < 8) { const float A = __expf(p.a_log[o]); const float xx = t1 + p.dt_bias[o]; const float sp = xx > 20.f ? xx : log1pf(__expf(xx)); res = -A * sp; }
                else res = 1.f / (1.f + __expf(-t1));
                ((float*)(p.ws + WS_GB))[(size_t)r * 16 + o] = res; }
        }
    }
#undef MOD_XPTR
#undef MOD_LOADX
}
#define XB_TMO      128
#define XB_XCNT(j)  (256  + 64 * (j))
#define XB_XSUB(j)  (1280 + 64 * (j))
#define XB_XGEN(j)  (2304 + 64 * (j))
#define XB_TOP      3328
#define XB_TOPGEN   3392
#define XCD_BAR_WORDS 3456
#define XB_SPIN_CAP (1u << 18)

__device__ __forceinline__ unsigned xb_ld(unsigned* p)              { return __hip_atomic_load(p, __ATOMIC_RELAXED, __HIP_MEMORY_SCOPE_AGENT); }
__device__ __forceinline__ unsigned xb_add(unsigned* p, unsigned v) { return __hip_atomic_fetch_add(p, v, __ATOMIC_RELAXED, __HIP_MEMORY_SCOPE_AGENT); }
__device__ __forceinline__ unsigned xb_xcc_id() { return (unsigned)__builtin_amdgcn_s_getreg((3 << 11) | 20) & 0xFu; }
#define XB_SPIN(cond, bar) do { unsigned _sp = 0; while (cond) { __builtin_amdgcn_s_sleep(1); \
    if ((++_sp & 255u) == 0u) { if (xb_ld(&(bar)[XB_TMO])) break; if (_sp > XB_SPIN_CAP) { atomicAdd(&(bar)[XB_TMO], 1u); break; } } } } while (0)

struct XcdBarrier {
    unsigned* bar; unsigned x;
    volatile LAS unsigned* st;
};

__device__ __forceinline__ XcdBarrier xcd_barrier_post(unsigned* bar, volatile LAS unsigned* st) {
    XcdBarrier b; b.bar = bar; b.x = xb_xcc_id(); b.st = st;
    if (threadIdx.x == 0) (void)xb_add(&bar[XB_XCNT(b.x)], 1u);
    return b;
}
__device__ __forceinline__ void xcd_barrier_complete(unsigned* bar, unsigned x, unsigned& nloc, unsigned& nx) {
    const unsigned G = gridDim.x * gridDim.y * gridDim.z;
    unsigned sum, cnt, mine, sp = 0u;
    for (;;) {
        sum = 0u; cnt = 0u; mine = 0u;
#pragma unroll
        for (unsigned j = 0; j < 16; ++j) { const unsigned c = xb_ld(&bar[XB_XCNT(j)]); sum += c; cnt += (c > 0u) ? 1u : 0u; mine = (j == x) ? c : mine; }
        if (sum == G) break;
        __builtin_amdgcn_s_sleep(1);
        if ((++sp & 255u) == 0u) { if (xb_ld(&bar[XB_TMO])) break; if (sp > XB_SPIN_CAP) { atomicAdd(&bar[XB_TMO], 1u); break; } }
    }
    nloc = mine > 0u ? mine : 1u; nx = cnt > 0u ? cnt : 1u;
}

__device__ __forceinline__ void xcd_barrier(const XcdBarrier& b) {
    asm volatile("s_waitcnt vmcnt(0)" ::: "memory");
    __syncthreads();
    if (threadIdx.x == 0) {
        unsigned* bar = b.bar;
        __builtin_amdgcn_s_waitcnt(0);
        unsigned nloc = b.st[0], nx = b.st[1];
        if (nloc == 0u) { xcd_barrier_complete(bar, b.x, nloc, nx); b.st[0] = nloc; b.st[1] = nx; }
        const unsigned old = xb_add(&bar[XB_XSUB(b.x)], 1u);
        const unsigned gen = old / nloc;
        if (old + 1u == (gen + 1u) * nloc) {
            __builtin_amdgcn_fence(__ATOMIC_RELEASE, "agent");
            asm volatile("s_waitcnt vmcnt(0)" ::: "memory");
            const unsigned og = xb_add(&bar[XB_TOP], 1u);
            const unsigned tg = og / nx;
            if (og + 1u == (tg + 1u) * nx) xb_add(&bar[XB_TOPGEN], 1u);
            else XB_SPIN(xb_ld(&bar[XB_TOPGEN]) == tg, bar);
            __builtin_amdgcn_fence(__ATOMIC_ACQUIRE, "agent");
            xb_add(&bar[XB_XGEN(b.x)], 1u);
            asm volatile("s_waitcnt vmcnt(0)" ::: "memory");
        } else {
            XB_SPIN(xb_ld(&bar[XB_XGEN(b.x)]) == gen, bar);
            __builtin_amdgcn_fence(__ATOMIC_ACQUIRE, "agent");
            asm volatile("s_waitcnt vmcnt(0)" ::: "memory");
        }
    }
    __syncthreads();
}

#ifdef PROBE_TS
#define SEC(slot) do { if (blockIdx.x == 0 && threadIdx.x == 0) { unsigned long long* TS_ = (unsigned long long*)(p.ws + WS_DL + 512 * 1024); const unsigned long long t_ = __builtin_amdgcn_s_memrealtime(); TS_[(slot)] += t_ - TS_[31]; TS_[31] = t_; } } while (0)
#define SEC0() do { if (blockIdx.x == 0 && threadIdx.x == 0) { unsigned long long* TS_ = (unsigned long long*)(p.ws + WS_DL + 512 * 1024); TS_[31] = __builtin_amdgcn_s_memrealtime(); } } while (0)
#else
#define SEC(slot) do { } while (0)
#define SEC0() do { } while (0)
#endif
#define MFMA16(a, b, c) __builtin_amdgcn_mfma_f32_16x16x32_bf16((a), (b), (c), 0, 0, 0)
__device__ __forceinline__ bf16x8 lds_frag16(const LAS unsigned char* base) { return *(const LAS bf16x8*)base; }
__device__ __forceinline__ bf16x8 lds_frag8x2(const LAS unsigned char* lo, const LAS unsigned char* hi) {
    const u32x2 a = *(const LAS u32x2*)lo, b = *(const LAS u32x2*)hi; u32x4 w; w.x = a.x; w.y = a.y; w.z = b.x; w.w = b.y; return as_bf16x8(w); }
__device__ __forceinline__ bf16x8 pack_acc2(const f32x4 a, const f32x4 b) { u32x4 w; w.x = cvt_pk_bf16(a[0], a[1]); w.y = cvt_pk_bf16(a[2], a[3]); w.z = cvt_pk_bf16(b[0], b[1]); w.w = cvt_pk_bf16(b[2], b[3]); return as_bf16x8(w); }

constexpr int PL_QL = 0, PL_KL = 17408, PL_RT = 34816, PL_KDT = 71680, PL_AM = 90112  , PL_TB = 106752, PL_GS = 115968, PL_CW = 116992, PL_TM = 123136  ,
    PL_UTS = 0  , PL_WNS = 123136  , PL_QKS = 140544  ;
__device__ __forceinline__ void gdn_prep_stage_cw(const Params& p, int h, LAS unsigned char* lds, int tid) {
    for (int idx = tid; idx < 1536; idx += 512) { const int i = idx / 384, rem = idx - 384 * i, arr = rem >> 7, ch = rem & 127; ((LAS float*)(lds + PL_CW))[idx] = p.conv_w[i * 3072 + arr * 1024 + h * 128 + ch]; }
}
__device__ __forceinline__ void gdn_prep_item(const Params& p, int g, int cu, int h, LAS unsigned char* lds, int tid, int wave, int lane) {
    const bool is_sample = cu >= 256; const int cl = is_sample ? 0 : (cu & 15), c = is_sample ? 0 : 16 * g + cl; const int lr0 = 64 * cu;
    const int bseq = is_sample ? (cu - 256) : (cu >> 4);
    const bf16* PROJ = (const bf16*)(p.ws + WS_BIG); bf16* HALO = (bf16*)(p.ws + WS_HALO);
    unsigned char* ex = p.ws + WS_EX + (size_t)(cu * 8 + h) * EX_ITEM;
    LAS float* GS = (LAS float*)(lds + PL_GS);
    const int fr = lane & 15, fq = lane >> 4;
    const int r = tid >> 3, ch0 = (tid & 7) * 16;
    u32x4 raw[3][4][2];
#pragma unroll
    for (int arr = 0; arr < 3; ++arr)
#pragma unroll
        for (int i = 0; i < 4; ++i) {
            const int rr = r - 3 + i, col = arr * 1024 + h * 128 + ch0;
            if (rr >= 0 || cl > 0) { const bf16* src = PROJ + (size_t)(lr0 + rr) * NPROJ + col; raw[arr][i][0] = *(const u32x4*)src; raw[arr][i][1] = *(const u32x4*)(src + 8); }
            else if (!is_sample && g == 1) { const bf16* src = HALO + ((size_t)bseq * 3 + (3 + rr)) * 3072 + col; raw[arr][i][0] = *(const u32x4*)src; raw[arr][i][1] = *(const u32x4*)(src + 8); }
            else if (is_sample) { const float* src = p.state_conv + ((size_t)bseq * 3 + (3 + rr)) * 3072 + col; float t[8];
#pragma unroll
                for (int hh = 0; hh < 2; ++hh) { const f32x4 t0 = *(const f32x4*)(src + 8 * hh), t1 = *(const f32x4*)(src + 8 * hh + 4);
#pragma unroll
                    for (int j = 0; j < 4; ++j) { t[j] = t0[j]; t[4 + j] = t1[j]; }
                    raw[arr][i][hh] = pack8(t); }
            } else { raw[arr][i][0] = (u32x4){0u, 0u, 0u, 0u}; raw[arr][i][1] = (u32x4){0u, 0u, 0u, 0u}; }
        }
    {
        const float* GB = (const float*)(p.ws + WS_GB) + (size_t)(lr0 + lane) * 16;
        float gv = GB[h]; const float bt = GB[8 + h];
#pragma unroll
        for (int o = 1; o < 64; o <<= 1) { const float t = __shfl_up(gv, o); if (lane >= o) gv += t; }
        GS[lane] = gv; GS[64 + lane] = bt;
    }
    {
        const float Gr = GS[r], Gl = GS[63], br = GS[64 + r];
        const int tsw = (((r >> 3) ^ (tid & 7)) << 4) + (r & 7) * 2;
        const float eg = __expf(Gr), egl = __expf(Gl - Gr);
        const bool lastc = is_sample || c == 31;
#pragma unroll
        for (int arr = 0; arr < 3; ++arr) {
            const int col = arr * 1024 + h * 128 + ch0;
            float acc[16];
#pragma unroll
            for (int j = 0; j < 16; ++j) acc[j] = 0.f;
#pragma unroll
            for (int i = 0; i < 4; ++i) {
                float x[16]; { float t[8]; unpack8(raw[arr][i][0], t);
#pragma unroll
                    for (int j = 0; j < 8; ++j) x[j] = t[j];
                    unpack8(raw[arr][i][1], t);
#pragma unroll
                    for (int j = 0; j < 8; ++j) x[8 + j] = t[j]; }
                const LAS float* wsrc = (const LAS float*)(lds + PL_CW) + (i * 3 + arr) * 128 + ch0;
#pragma unroll
                for (int j4 = 0; j4 < 4; ++j4) { const f32x4 w = *(const LAS f32x4*)(wsrc + 4 * j4);
#pragma unroll
                    for (int e = 0; e < 4; ++e) acc[4 * j4 + e] += x[4 * j4 + e] * w[e]; }
                if (i == 3 && g == 0 && !is_sample && cl == 15 && r >= 61) {
                    bf16* hd = HALO + ((size_t)bseq * 3 + (r - 61)) * 3072 + col; *(u32x4*)hd = raw[arr][3][0]; *(u32x4*)(hd + 8) = raw[arr][3][1]; }
                if (i == 3 && lastc && r >= 61) {
                    float* o = p.out + (is_sample ? O_CONVS : O_CONVP) + ((size_t)bseq * 3 + (r - 61)) * 3072 + col;
#pragma unroll
                    for (int j4 = 0; j4 < 4; ++j4) *(f32x4*)(o + 4 * j4) = (f32x4){x[4 * j4], x[4 * j4 + 1], x[4 * j4 + 2], x[4 * j4 + 3]};
                }
            }
            float ss = 0.f;
#pragma unroll
            for (int j = 0; j < 16; ++j) { acc[j] = siluf_(acc[j]); ss += acc[j] * acc[j]; }
            if (arr < 2) { ss += __shfl_xor(ss, 1); ss += __shfl_xor(ss, 2); ss += __shfl_xor(ss, 4);
                const float sc = rsqrtf(ss + EPS) * (arr == 0 ? 0.08838834764831845f : 1.f);
#pragma unroll
                for (int j = 0; j < 16; ++j) acc[j] *= sc; }
            if (arr == 0) {
                float t[8];
#pragma unroll
                for (int hh = 0; hh < 2; ++hh) {
#pragma unroll
                    for (int j = 0; j < 8; ++j) t[j] = acc[8 * hh + j];
                    *(LAS u32x4*)(lds + PL_QL + r * 272 + (ch0 + 8 * hh) * 2) = pack8(t);
#pragma unroll
                    for (int j = 0; j < 8; ++j) t[j] = acc[8 * hh + j] * eg;
                    *(u32x4*)(ex + EX_QD + r * 256 + (ch0 + 8 * hh) * 2) = pack8(t);
                }
            } else if (arr == 1) {
                float t[8];
#pragma unroll
                for (int hh = 0; hh < 2; ++hh) {
#pragma unroll
                    for (int j = 0; j < 8; ++j) t[j] = acc[8 * hh + j];
                    *(LAS u32x4*)(lds + PL_KL + r * 272 + (ch0 + 8 * hh) * 2) = pack8(t);
                }
                const float wsc = br * eg;
#pragma unroll
                for (int j = 0; j < 16; ++j) {
                    *(LAS unsigned short*)(lds + PL_KDT + (ch0 + j) * 144 + tsw) = f2bf(acc[j] * egl);
                    *(LAS unsigned short*)(lds + PL_RT + (128 + ch0 + j) * 144 + tsw) = f2bf(acc[j] * wsc);
                }
            } else {
#pragma unroll
                for (int j = 0; j < 16; ++j) *(LAS unsigned short*)(lds + PL_RT + (ch0 + j) * 144 + tsw) = f2bf(acc[j] * br);
            }
            __builtin_amdgcn_sched_barrier(0);
        }
    }
    __syncthreads();
    {
#pragma unroll
        for (int n = 0; n < 4; ++n) {
            const int job = wave * 4 + n, typ = job >> 4, t = job & 15, ib = t >> 2, jb = t & 3;
            if (jb > ib) continue;
            f32x4 acc = (f32x4){0.f, 0.f, 0.f, 0.f};
            if (typ == 0) {
#pragma unroll
                for (int ks = 0; ks < 4; ++ks) { const bf16x8 a = lds_frag16(lds + PL_KL + (16 * ib + fr) * 272 + (32 * ks + 8 * fq) * 2), b = lds_frag16(lds + PL_KL + (16 * jb + fr) * 272 + (32 * ks + 8 * fq) * 2);
                    acc = MFMA16(a, b, acc); }
                const int j = 16 * jb + fr; const float Gj = GS[j];
#pragma unroll
                for (int e = 0; e < 4; ++e) { const int i = 16 * ib + 4 * fq + e; const float v = (j < i) ? GS[64 + i] * acc[e] * __expf(GS[i] - Gj) : 0.f; *(LAS float*)(lds + PL_AM + (i * 65 + j) * 4) = v; }
            } else {
#pragma unroll
                for (int ks = 0; ks < 4; ++ks) { const bf16x8 a = lds_frag16(lds + PL_KL + (16 * jb + fr) * 272 + (32 * ks + 8 * fq) * 2), b = lds_frag16(lds + PL_QL + (16 * ib + fr) * 272 + (32 * ks + 8 * fq) * 2);
                    acc = MFMA16(a, b, acc); }
                const int i = 16 * ib + fr; const float Gi = GS[i]; float v[4];
#pragma unroll
                for (int e = 0; e < 4; ++e) { const int j = 16 * jb + 4 * fq + e; v[e] = (j <= i) ? acc[e] * __expf(Gi - GS[j]) : 0.f; }
                u32x2 o; o.x = cvt_pk_bf16(v[0], v[1]); o.y = cvt_pk_bf16(v[2], v[3]);
                *(LAS u32x2*)(lds + PL_QKS + i * 144 + (16 * jb + 4 * fq) * 2) = o;
            }
        }
#pragma unroll
        for (int n = 0; n < 4; ++n) {
            const int job = wave * 4 + n, typ = job >> 4, t = job & 15, ib = t >> 2, jb = t & 3;
            if (jb <= ib) continue;
            if (typ == 0) { } else { u32x2 o; o.x = 0u; o.y = 0u; *(LAS u32x2*)(lds + PL_QKS + (16 * ib + fr) * 144 + (16 * jb + 4 * fq) * 2) = o; }
        }
    }
    __syncthreads();
    {
        const LAS float* AMf = (const LAS float*)(lds + PL_AM); LAS float* TMf = (LAS float*)(lds + PL_TM);
        if (wave < 4) {
            const int b0 = 16 * wave; float t[16];
            const LAS float* arow = AMf + b0 * 65 + b0;
#pragma unroll
            for (int i = 0; i < 16; ++i) {
                float sacc_ = fmaxf(1.f - fabsf((float)fr - (float)i), 0.f);
#pragma unroll
                for (int j = 0; j < i; ++j) sacc_ -= arow[i * 65 + j] * t[j];
                t[i] = sacc_;
                if (fq == 0) TMf[(b0 + i) * 65 + b0 + fr] = sacc_;
            }
        } else {
            if (wave == 7 && lane == 0) ((float*)(p.ws + WS_DL))[cu * 8 + h] = __expf(GS[63]);
            const int t2 = tid - 256;
#pragma unroll
            for (int k = 0; k < 4; ++k) { const int idx = t2 + 256 * k, d = idx >> 3, c8 = idx & 7;
                *(u32x4*)(ex + EX_KDT + d * 128 + c8 * 16) = *(const LAS u32x4*)(lds + PL_KDT + d * 144 + ((c8 ^ ((d >> 4) & 7)) << 4)); }
#pragma unroll
            for (int k = 0; k < 2; ++k) { const int idx = t2 + 256 * k;
                *(u32x4*)(ex + EX_QK + (idx >> 3) * 128 + (idx & 7) * 16) = *(const LAS u32x4*)(lds + PL_QKS + (idx >> 3) * 144 + (idx & 7) * 16); }
        }
        __syncthreads();
#pragma unroll
        for (int dd = 1; dd < 4; ++dd) {
            if (wave < 4 - dd) {
                const int J = wave, I = wave + dd;
                f32x4 c4 = (f32x4){0.f, 0.f, 0.f, 0.f};
#pragma unroll
                for (int kk = 0; kk < dd; ++kk) { const int K = J + kk;
#pragma unroll
                    for (int k0 = 0; k0 < 16; k0 += 4) { const float a = AMf[(16 * I + fr) * 65 + 16 * K + k0 + fq], b = TMf[(16 * K + k0 + fq) * 65 + 16 * J + fr];
                        c4 = __builtin_amdgcn_mfma_f32_16x16x4f32(a, b, c4, 0, 0, 0); } }
                f32x4 r4 = (f32x4){0.f, 0.f, 0.f, 0.f};
#pragma unroll
                for (int s4 = 0; s4 < 4; ++s4) { const float a = TMf[(16 * I + fr) * 65 + 16 * I + 4 * fq + s4]; r4 = __builtin_amdgcn_mfma_f32_16x16x4f32(a, c4[s4], r4, 0, 0, 0); }
#pragma unroll
                for (int j = 0; j < 4; ++j) TMf[(16 * I + 4 * fq + j) * 65 + 16 * J + fr] = -r4[j];
            }
            __syncthreads();
        }
        {   const int i = tid >> 3, j0 = (tid & 7) * 8; float v[8];
#pragma unroll
            for (int jj = 0; jj < 8; ++jj) v[jj] = ((j0 >> 4) > (i >> 4)) ? 0.f : TMf[i * 65 + j0 + jj];
            *(LAS u32x4*)(lds + PL_TB + i * 144 + j0 * 2) = pack8(v); }
    }
    __syncthreads();
    {
#pragma unroll
        for (int mb = 0; mb < 4; ++mb) {
            f32x4 au = (f32x4){0.f, 0.f, 0.f, 0.f}, aw = (f32x4){0.f, 0.f, 0.f, 0.f};
#pragma unroll
            for (int ks = 0; ks < 2; ++ks) {
                const bf16x8 tf = lds_frag16(lds + PL_TB + (16 * mb + fr) * 144 + (32 * ks + 8 * fq) * 2);
                const bf16x8 rv = lds_frag16(lds + PL_RT + (16 * wave + fr) * 144 + (((4 * ks + fq) ^ wave) << 4));
                const bf16x8 rk = lds_frag16(lds + PL_RT + (128 + 16 * wave + fr) * 144 + (((4 * ks + fq) ^ wave) << 4));
                au = MFMA16(tf, rv, au);
                aw = MFMA16(rk, tf, aw);
            }
            u32x2 o; o.x = cvt_pk_bf16(au[0], au[1]); o.y = cvt_pk_bf16(au[2], au[3]);
            *(LAS u32x2*)(lds + PL_UTS + (16 * wave + fr) * 144 + (16 * mb + 4 * fq) * 2) = o;
            o.x = cvt_pk_bf16(-aw[0], -aw[1]); o.y = cvt_pk_bf16(-aw[2], -aw[3]);
            *(LAS u32x2*)(lds + PL_WNS + (16 * mb + fr) * 272 + (16 * wave + 4 * fq) * 2) = o;
        }
    }
    __syncthreads();
    {
#pragma unroll
        for (int k = 0; k < 2; ++k) { const int idx = tid + 512 * k;
            *(u32x4*)(ex + EX_UT + (idx >> 3) * 128 + (idx & 7) * 16) = *(const LAS u32x4*)(lds + PL_UTS + (idx >> 3) * 144 + (idx & 7) * 16);
            *(u32x4*)(ex + EX_WN + (idx >> 4) * 256 + (idx & 15) * 16) = *(const LAS u32x4*)(lds + PL_WNS + (idx >> 4) * 272 + (idx & 15) * 16); }
    }
    __syncthreads();
}

constexpr int SL_K = 0, SL_V = 27648;
__device__ __forceinline__ void swa_item(const Params& p, int g, int cu, int kvh, LAS unsigned char* lds, int tid, int wave, int lane) {
    const bool is_sample = cu >= 256; const int cl = is_sample ? 0 : (cu & 15), c = is_sample ? 0 : 16 * g + cl; const int lr0 = 64 * cu;
    const int bseq = is_sample ? (cu - 256) : (cu >> 4);
    const int nkc = is_sample ? 3 : (c < 2 ? c + 1 : 3);
    bf16* PROJ = (bf16*)(p.ws + WS_BIG); bf16* KVT = (bf16*)(p.ws + WS_KVT);
    const int fr = lane & 15, fq = lane >> 4;
    const int hq = kvh * 4 + (wave >> 1), t0 = 32 * (wave & 1);
    u32x4 qr[2][2];
#pragma unroll
    for (int mb = 0; mb < 2; ++mb) { const bf16* qsrc = PROJ + (size_t)(lr0 + t0 + 16 * mb + fr) * NPROJ + PC_QS + hq * 64 + 8 * fq; qr[mb][0] = *(const u32x4*)qsrc; qr[mb][1] = *(const u32x4*)(qsrc + 32); }
    const f32x4 qn00 = *(const f32x4*)(p.q_norm + 8 * fq), qn01 = *(const f32x4*)(p.q_norm + 8 * fq + 4), qn10 = *(const f32x4*)(p.q_norm + 32 + 8 * fq), qn11 = *(const f32x4*)(p.q_norm + 32 + 8 * fq + 4);
    const float sink = p.sinks[hq];
    {
        const int row = tid >> 3, d8 = tid & 7;
        const f32x4 kn0 = *(const f32x4*)(p.k_norm + d8 * 8), kn1 = *(const f32x4*)(p.k_norm + d8 * 8 + 4);
        u32x4 kr[3], vr[3]; f32x4 ck[2][2], cv[2][2];
#pragma unroll
        for (int s = 0; s < 3; ++s) {
            if (s >= nkc) continue;
            if (is_sample && s < 2) {
                const size_t off = (((size_t)bseq * 128 + 64 * s + row) * 4 + kvh) * 64 + d8 * 8;
                ck[s][0] = *(const f32x4*)(p.cache_k + off); ck[s][1] = *(const f32x4*)(p.cache_k + off + 4); cv[s][0] = *(const f32x4*)(p.cache_v + off); cv[s][1] = *(const f32x4*)(p.cache_v + off + 4);
            } else if (!is_sample && cl - (nkc - 1 - s) < 0) {
                const bf16* src = KVT + ((size_t)bseq * 128 + 64 * (cl - (nkc - 1 - s) + 2) + row) * 512 + kvh * 64 + d8 * 8; kr[s] = *(const u32x4*)src; vr[s] = *(const u32x4*)(src + 256);
            } else {
                const int lrk = lr0 - 64 * (nkc - 1 - s) + row;
                kr[s] = *(const u32x4*)(PROJ + (size_t)lrk * NPROJ + PC_KS + kvh * 64 + d8 * 8); vr[s] = *(const u32x4*)(PROJ + (size_t)lrk * NPROJ + PC_VS + kvh * 64 + d8 * 8);
            }
        }
#pragma unroll
        for (int s = 0; s < 3; ++s) {
            if (s >= nkc) continue;
            float kv[8], vv[8];
            if (is_sample && s < 2) {
                if (s < 2) {
#pragma unroll
                    for (int j = 0; j < 4; ++j) { kv[j] = ck[s < 2 ? s : 0][0][j]; kv[4 + j] = ck[s < 2 ? s : 0][1][j]; vv[j] = cv[s < 2 ? s : 0][0][j]; vv[4 + j] = cv[s < 2 ? s : 0][1][j]; }
                }
                if (s == 1) { const size_t oo = (((size_t)bseq * 128 + row) * 4 + kvh) * 64 + d8 * 8;
                    *(f32x4*)(p.out + O_KS + oo) = ck[1][0]; *(f32x4*)(p.out + O_KS + oo + 4) = ck[1][1]; *(f32x4*)(p.out + O_VS + oo) = cv[1][0]; *(f32x4*)(p.out + O_VS + oo + 4) = cv[1][1]; }
            } else if (!is_sample && cl - (nkc - 1 - s) < 0) {
                unpack8(kr[s], kv); unpack8(vr[s], vv);
            } else {
                unpack8(kr[s], kv); unpack8(vr[s], vv);
                float ss = 0.f;
#pragma unroll
                for (int j = 0; j < 8; ++j) ss += kv[j] * kv[j];
                ss += __shfl_xor(ss, 1); ss += __shfl_xor(ss, 2); ss += __shfl_xor(ss, 4);
                const float sc = rsqrtf(ss * (1.f / 64.f) + EPS);
#pragma unroll
                for (int j = 0; j < 4; ++j) { kv[j] *= sc * kn0[j]; kv[4 + j] *= sc * kn1[j]; }
                if (s == nkc - 1 && !is_sample && g == 0 && cl >= 14) {
                    bf16* dst = KVT + ((size_t)bseq * 128 + 64 * (cl - 14) + row) * 512 + kvh * 64 + d8 * 8; *(u32x4*)dst = pack8(kv); *(u32x4*)(dst + 256) = pack8(vv); }
                if (s == nkc - 1 && (is_sample || c >= 30)) {
                    const int orow = is_sample ? 64 + row : 64 * (c - 30) + row;
                    const size_t oo = (((size_t)bseq * 128 + orow) * 4 + kvh) * 64 + d8 * 8;
                    float* ok = p.out + (is_sample ? O_KS : O_KP) + oo; float* ov = p.out + (is_sample ? O_VS : O_VP) + oo;
                    *(f32x4*)ok = (f32x4){kv[0], kv[1], kv[2], kv[3]}; *(f32x4*)(ok + 4) = (f32x4){kv[4], kv[5], kv[6], kv[7]};
                    *(f32x4*)ov = (f32x4){vv[0], vv[1], vv[2], vv[3]}; *(f32x4*)(ov + 4) = (f32x4){vv[4], vv[5], vv[6], vv[7]};
                }
            }
            const int key = 64 * s + row;
            *(LAS u32x4*)(lds + SL_K + key * 144 + d8 * 16) = pack8(kv);
#pragma unroll
            for (int j = 0; j < 8; ++j) *(LAS unsigned short*)(lds + SL_V + (d8 * 8 + j) * 392 + key * 2) = f2bf(vv[j]);
        }
    }
    __syncthreads();
    bf16x8 qf[2][2];
#pragma unroll
    for (int mb = 0; mb < 2; ++mb) {
        float q0[8], q1[8]; unpack8(qr[mb][0], q0); unpack8(qr[mb][1], q1);
        float ss = 0.f;
#pragma unroll
        for (int j = 0; j < 8; ++j) ss += q0[j] * q0[j] + q1[j] * q1[j];
        ss += __shfl_xor(ss, 16); ss += __shfl_xor(ss, 32);
        const float sc = rsqrtf(ss * (1.f / 64.f) + EPS) * 0.125f;
#pragma unroll
        for (int j = 0; j < 4; ++j) { q0[j] *= sc * qn00[j]; q0[4 + j] *= sc * qn01[j]; q1[j] *= sc * qn10[j]; q1[4 + j] *= sc * qn11[j]; }
        qf[mb][0] = as_bf16x8(pack8(q0)); qf[mb][1] = as_bf16x8(pack8(q1));
    }
    f32x4 sacc[12][2];
#pragma unroll
    for (int nb = 0; nb < 12; ++nb) {
#pragma unroll
        for (int mb = 0; mb < 2; ++mb) sacc[nb][mb] = (f32x4){0.f, 0.f, 0.f, 0.f};
        if (nb < 4 * nkc) {
#pragma unroll
            for (int ks = 0; ks < 2; ++ks) { const bf16x8 a = lds_frag16(lds + SL_K + (16 * nb + fr) * 144 + (32 * ks + 8 * fq) * 2);
#pragma unroll
                for (int mb = 0; mb < 2; ++mb) sacc[nb][mb] = MFMA16(a, qf[mb][ks], sacc[nb][mb]); }
        }
    }
    float inv[2];
#pragma unroll
    for (int mb = 0; mb < 2; ++mb) {
        float mx = sink;
#pragma unroll
        for (int nb = 0; nb < 12; ++nb) if (nb < 4 * nkc) {
#pragma unroll
            for (int e = 0; e < 4; ++e) mx = fmaxf(mx, sacc[nb][mb][e]); }
        mx = fmaxf(mx, __shfl_xor(mx, 16)); mx = fmaxf(mx, __shfl_xor(mx, 32));
        float sum = 0.f;
#pragma unroll
        for (int nb = 0; nb < 12; ++nb) {
#pragma unroll
            for (int e = 0; e < 4; ++e) { const float pv = (nb < 4 * nkc) ? __expf(sacc[nb][mb][e] - mx) : 0.f; sacc[nb][mb][e] = pv; sum += pv; } }
        sum += __shfl_xor(sum, 16); sum += __shfl_xor(sum, 32);
        inv[mb] = 1.f / (sum + __expf(sink - mx));
    }
    f32x4 oacc[4][2];
#pragma unroll
    for (int db = 0; db < 4; ++db)
#pragma unroll
        for (int mb = 0; mb < 2; ++mb) oacc[db][mb] = (f32x4){0.f, 0.f, 0.f, 0.f};
#pragma unroll
    for (int ks2 = 0; ks2 < 6; ++ks2) {
        if (ks2 < 2 * nkc) {
            bf16x8 bp[2];
#pragma unroll
            for (int mb = 0; mb < 2; ++mb) bp[mb] = pack_acc2(sacc[2 * ks2][mb], sacc[2 * ks2 + 1][mb]);
#pragma unroll
            for (int db = 0; db < 4; ++db) {
                const LAS unsigned char* vb = lds + SL_V + (16 * db + fr) * 392 + (32 * ks2 + 4 * fq) * 2;
                const bf16x8 a = lds_frag8x2(vb, vb + 32);
#pragma unroll
                for (int mb = 0; mb < 2; ++mb) oacc[db][mb] = MFMA16(a, bp[mb], oacc[db][mb]);
            }
        }
    }
#pragma unroll
    for (int mb = 0; mb < 2; ++mb) {
        bf16* od = PROJ + (size_t)(lr0 + t0 + 16 * mb + fr) * NPROJ + PC_QS + hq * 64 + 4 * fq;
#pragma unroll
        for (int db = 0; db < 4; ++db) { const f32x4 v = oacc[db][mb] * inv[mb]; u32x2 o; o.x = cvt_pk_bf16(v[0], v[1]); o.y = cvt_pk_bf16(v[2], v[3]); *(u32x2*)(od + 16 * db) = o; }
    }
    __syncthreads();
}

constexpr int CL_WN = 0, CL_QD = 17408, CL_UT = 34816, CL_KDT = 52224, CL_QK = 69632, CL_OT = 78336, CL_SSQ = 112128, CL_DL = 114176, CL_PR = 114304;
__device__ __forceinline__ void scan_chain(const Params& p, int g, int s, int h, LAS unsigned char* lds, int tid, int wave, int lane) {
    const bool is_sample = s >= 16; const int nsteps = is_sample ? 1 : 16; const int cu0 = is_sample ? 256 + (s - 16) : 16 * s;
    const int bseq = is_sample ? (s - 16) : s;
    const int fr = lane & 15, fq = lane >> 4;
    bf16* PROJ = (bf16*)(p.ws + WS_BIG);
    const float* DL = (const float*)(p.ws + WS_DL);
    f32x4 sacc[8];
    const int e = 16 * wave + fr;
    if (is_sample || g == 1) { const float* S0 = (is_sample ? p.state_gdn : p.out + O_GDNP) + ((size_t)bseq * 8 + h) * 16384;
#pragma unroll
        for (int db = 0; db < 8; ++db) { const float* pb = S0 + (4 * fq) * 128 + e + db * 2048; asm volatile("" : "+v"(pb));
#pragma unroll
            for (int j = 0; j < 4; ++j) sacc[db][j] = pb[j * 128]; }
    } else {
#pragma unroll
        for (int db = 0; db < 8; ++db) sacc[db] = (f32x4){0.f, 0.f, 0.f, 0.f};
    }
    u32x4 pf[9];
    const unsigned char* exb = p.ws + WS_EX + (size_t)(cu0 * 8 + h) * EX_ITEM;
#define SCAN_LOAD(ptr) do { _Pragma("unroll") for (int k = 0; k < 9; ++k) pf[k] = *(const u32x4*)((ptr) + (size_t)(tid + 512 * k) * 16); } while (0)
#define SCAN_STORE() do { _Pragma("unroll") for (int k = 0; k < 9; ++k) { const int off = (tid + 512 * k) * 16, wi = off & 16383; \
        if (k == 2 || k == 3) *(LAS u32x4*)(lds + CL_WN + (wi >> 8) * 272 + (wi & 255)) = pf[k]; \
        else if (k == 4 || k == 5) *(LAS u32x4*)(lds + CL_QD + (wi >> 8) * 272 + (wi & 255)) = pf[k]; \
        else { const int base = (k < 2) ? CL_UT : (k < 8 ? CL_KDT : CL_QK); LAS unsigned char* d = lds + base + (wi >> 7) * 136 + (wi & 127); \
            u32x2 lo, hi; lo.x = pf[k].x; lo.y = pf[k].y; hi.x = pf[k].z; hi.y = pf[k].w; *(LAS u32x2*)d = lo; *(LAS u32x2*)(d + 8) = hi; } } } while (0)
    SCAN_LOAD(exb); SCAN_STORE();
    if (tid < nsteps) *(LAS float*)(lds + CL_DL + tid * 4) = DL[(cu0 + tid) * 8 + h];
    if (tid < 384) { const int w3 = tid >> 7, cc = tid & 127; *(LAS float*)(lds + CL_PR + tid * 4) = w3 == 0 ? p.gdn_norm[cc] : p.b_merge[(w3 - 1) * 1024 + h * 128 + cc]; }
    __syncthreads();
    u32x4 mg[4][2];
#define SCAN_MG(cu_) do { const bf16* prow = PROJ + (size_t)(64 * (cu_) + (tid >> 3)) * NPROJ + h * 128 + (tid & 7) * 16; _Pragma("unroll") for (int hh = 0; hh < 2; ++hh) { \
        mg[0][hh] = *(const u32x4*)(prow + PC_Z + 8 * hh); mg[1][hh] = *(const u32x4*)(prow + PC_GA + 8 * hh); mg[2][hh] = *(const u32x4*)(prow + PC_GB + 8 * hh); mg[3][hh] = *(const u32x4*)(prow + PC_QS + 8 * hh); } } while (0)
    SCAN_MG(cu0);
    if (nsteps > 1) SCAN_LOAD(exb + (size_t)8 * EX_ITEM);
    for (int st = 0; st < nsteps; ++st) {
        const int cu = cu0 + st, lr0 = 64 * cu;
        const float dl = *(const LAS float*)(lds + CL_DL + st * 4);
        bf16x8 Bs[4];
#pragma unroll
        for (int ks = 0; ks < 4; ++ks) Bs[ks] = pack_acc2(sacc[2 * ks], sacc[2 * ks + 1]);
        f32x4 vacc[4], oacc[4];
        bf16x8 FA[4], FB[4];
#define LD_W(F, mb) do { _Pragma("unroll") for (int ks = 0; ks < 4; ++ks) { const LAS unsigned char* wb = lds + CL_WN + (16 * (mb) + fr) * 272 + (32 * ks + 4 * fq) * 2; F[ks] = lds_frag8x2(wb, wb + 32); } } while (0)
#define LD_Q(F, mb) do { _Pragma("unroll") for (int ks = 0; ks < 4; ++ks) { const LAS unsigned char* qb = lds + CL_QD + (16 * (mb) + fr) * 272 + (32 * ks + 4 * fq) * 2; F[ks] = lds_frag8x2(qb, qb + 32); } } while (0)
#define LD_QK(F, m0) do { _Pragma("unroll") for (int mb = 0; mb < 2; ++mb) _Pragma("unroll") for (int k2 = 0; k2 < 2; ++k2) { \
            const LAS unsigned char* kb = lds + CL_QK + (16 * ((m0) + mb) + fr) * 136 + (32 * k2 + 4 * fq) * 2; F[2 * mb + k2] = lds_frag8x2(kb, kb + 32); } } while (0)
#define LD_KD(F, d0) do { _Pragma("unroll") for (int d = 0; d < 2; ++d) _Pragma("unroll") for (int k2 = 0; k2 < 2; ++k2) { \
            const LAS unsigned char* kb = lds + CL_KDT + (16 * ((d0) + d) + fr) * 136 + (32 * k2 + 4 * fq) * 2; F[2 * d + k2] = lds_frag8x2(kb, kb + 32); } } while (0)
#define MM_W(F, mb) do { _Pragma("unroll") for (int ks = 0; ks < 4; ++ks) vacc[mb] = MFMA16(F[ks], Bs[ks], vacc[mb]); } while (0)
#define MM_Q(F, mb) do { _Pragma("unroll") for (int ks = 0; ks < 4; ++ks) oacc[mb] = MFMA16(F[ks], Bs[ks], oacc[mb]); } while (0)
#define MM_QK(F, m0) do { _Pragma("unroll") for (int mb = 0; mb < 2; ++mb) _Pragma("unroll") for (int k2 = 0; k2 < 2; ++k2) oacc[(m0) + mb] = MFMA16(F[2 * mb + k2], Bv[k2], oacc[(m0) + mb]); } while (0)
#define MM_KD(F, d0) do { _Pragma("unroll") for (int d = 0; d < 2; ++d) { sacc[(d0) + d] = sacc[(d0) + d] * dl; _Pragma("unroll") for (int k2 = 0; k2 < 2; ++k2) sacc[(d0) + d] = MFMA16(F[2 * d + k2], Bv[k2], sacc[(d0) + d]); } } while (0)
#define SB() __builtin_amdgcn_sched_barrier(0)
#pragma unroll
        for (int mb = 0; mb < 4; ++mb) {
            const u32x2 uu = *(const LAS u32x2*)(lds + CL_UT + e * 136 + (16 * mb + 4 * fq) * 2);
            vacc[mb] = (f32x4){bflo(uu.x), bfhi(uu.x), bflo(uu.y), bfhi(uu.y)};
            oacc[mb] = (f32x4){0.f, 0.f, 0.f, 0.f};
        }
        LD_W(FA, 0); SB();
        LD_W(FB, 1); MM_W(FA, 0); SB();
        LD_W(FA, 2); MM_W(FB, 1); SB();
        LD_W(FB, 3); MM_W(FA, 2); SB();
        LD_Q(FA, 0); MM_W(FB, 3); SB();
        LD_Q(FB, 1); MM_Q(FA, 0); SB();
        LD_Q(FA, 2); MM_Q(FB, 1); SB();
        LD_Q(FB, 3); MM_Q(FA, 2); SB();
        LD_QK(FA, 0); MM_Q(FB, 3); SB();
        bf16x8 Bv[2];
#pragma unroll
        for (int k2 = 0; k2 < 2; ++k2) Bv[k2] = pack_acc2(vacc[2 * k2], vacc[2 * k2 + 1]);
        LD_QK(FB, 2); MM_QK(FA, 0); SB();
        LD_KD(FA, 0); MM_QK(FB, 2); SB();
        LD_KD(FB, 2); MM_KD(FA, 0); SB();
        LD_KD(FA, 4); MM_KD(FB, 2); SB();
        LD_KD(FB, 6); MM_KD(FA, 4); SB();
        MM_KD(FB, 6);
#undef LD_W
#undef LD_Q
#undef MM_W
#undef MM_Q
#undef MM_QK
#undef MM_KD
#undef SB
#undef LD_QK
#undef LD_KD
        SEC(16);
#pragma unroll
        for (int mb = 0; mb < 4; ++mb)
#pragma unroll
            for (int j = 0; j < 4; ++j) *(LAS float*)(lds + CL_OT + ((16 * mb + 4 * fq + j) * 132 + e) * 4) = oacc[mb][j];
        __syncthreads();
        SEC(17);
        if (st + 1 < nsteps) { SCAN_STORE(); if (st + 2 < nsteps) SCAN_LOAD(exb + (size_t)(st + 2) * 8 * EX_ITEM); }
        {
            const int i = tid >> 3, c0 = (tid & 7) * 16;
            f32x4 ov[4]; float ssq = 0.f;
#pragma unroll
            for (int q4 = 0; q4 < 4; ++q4) { ov[q4] = *(const LAS f32x4*)(lds + CL_OT + (i * 132 + c0 + 4 * q4) * 4); ssq += (ov[q4][0] * ov[q4][0] + ov[q4][1] * ov[q4][1]) + (ov[q4][2] * ov[q4][2] + ov[q4][3] * ov[q4][3]); }
            ssq += __shfl_xor(ssq, 1); ssq += __shfl_xor(ssq, 2); ssq += __shfl_xor(ssq, 4);
            const float rstd = rsqrtf(ssq * (1.f / 128.f) + EPS);
            const LAS float* PR = (const LAS float*)(lds + CL_PR);
#pragma unroll
            for (int hh = 0; hh < 2; ++hh) {
                float z[8], ga[8], gb[8], os[8], r[8];
                unpack8(mg[0][hh], z); unpack8(mg[1][hh], ga); unpack8(mg[2][hh], gb); unpack8(mg[3][hh], os);
#pragma unroll
                for (int j = 0; j < 8; ++j) { const int cc = c0 + 8 * hh + j;
                    const float o = ov[2 * hh + (j >> 2)][j & 3] * rstd * PR[cc] * siluf_(z[j]);
                    r[j] = sigmoidf_(ga[j] + PR[128 + cc]) * o + sigmoidf_(gb[j] + PR[256 + cc]) * os[j]; }
                *(u32x4*)(PROJ + (size_t)(lr0 + i) * NPROJ + PC_Z + h * 128 + c0 + 8 * hh) = pack8(r);
            }
        }
        if (st + 1 < nsteps) SCAN_MG(cu + 1);
        __syncthreads();
        SEC(18);
    }
    {   float* So = p.out + (is_sample ? O_GDNS : O_GDNP) + ((size_t)bseq * 8 + h) * 16384;
#pragma unroll
        for (int db = 0; db < 8; ++db) { float* pb = So + (4 * fq) * 128 + e + db * 2048; asm volatile("" : "+v"(pb));
#pragma unroll
            for (int j = 0; j < 4; ++j) pb[j * 128] = sacc[db][j]; }
    }
#undef SCAN_LOAD
#undef SCAN_STORE
}
__global__ void __launch_bounds__(512, 2) mega_fwd(Params p) {
    extern __shared__ __attribute__((aligned(16))) unsigned char lds_raw[];
    if (threadIdx.x < 4) ((LAS unsigned*)((LAS unsigned char*)lds_raw + LDS_BARST))[threadIdx.x] = 0u;
    __syncthreads();
    const XcdBarrier xbar = xcd_barrier_post((unsigned*)(p.ws + WS_BAR), (volatile LAS unsigned*)((LAS unsigned char*)lds_raw + LDS_BARST));
    LAS unsigned char* lds = (LAS unsigned char*)lds_raw;
    const int G = gridDim.x;
    unsigned char* ws = p.ws;
    float* MOD = (float*)(ws + WS_MOD);
    bf16* H = (bf16*)(ws + WS_H); bf16* ACT = (bf16*)(ws + WS_BIG); bf16* PROJ = (bf16*)(ws + WS_BIG);
    float* Y = p.out + O_Y;

    enum { K_P0, K_MOD, K_SWIGLU, K_RES, K_PROJ, K_MIX, K_SCAN };
#pragma nounroll
    for (int ph = 0; ph < 17; ++ph) {
        int tid_ = threadIdx.x; asm volatile("" : "+v"(tid_));
        const int tid = tid_, lane = tid & 63, wave = __builtin_amdgcn_readfirstlane(tid >> 6);
        int bx_ = blockIdx.x; asm volatile("" : "+s"(bx_)); const int bx = bx_;
        int kind, g = -1, ffn = 0;
        if (ph == 0) kind = K_P0;
        else if (ph <= 3) { kind = ph == 1 ? K_MOD : (ph == 2 ? K_SWIGLU : K_RES); }
        else if (ph <= 13) { const int q = ph - 4; g = q / 5; const int r = q - 5 * g; kind = r == 0 ? K_MOD : (r == 1 ? K_PROJ : (r == 2 ? K_MIX : (r == 3 ? K_SCAN : K_RES))); }
        else { ffn = 1; kind = ph == 14 ? K_MOD : (ph == 15 ? K_SWIGLU : K_RES); }
        const bool first = (ph <= 3);
        switch (kind) {
        case K_P0: p0_phase(p, lds, tid, wave, lane); break;
        case K_MOD: {
            const float* xp = first ? p.x_prompt : Y; const float* xs = first ? p.x_sample : Y + (size_t)NPROMPT * D;
            const float* gain = g >= 0 ? p.norm_mix : (ffn ? p.norm_ffn2 : p.norm_ffn1);
            mod_phase(p, g >= 0, xp, xs, gain, g >= 0 ? 3072 : (ffn ? 6144 : 0), H, g, g >= 0 ? grows_of(g) : NROWS, lds, tid, wave, lane);
        } break;
        case K_SWIGLU: { pg8::Gemm gm{H, (const bf16*)(ws + (ffn ? WS_W2IN : WS_W1IN)), NROWS, 2 * FF, D, D, D, 128, 512 * D}; pg8::StaticOrder S; S.init(NROWS, 2 * FF, G, bx); EpiSwiglu E{ACT};
            pg8::gemm_phase<EpiSwiglu, pg8::StaticOrder, true, true>(lds, gm, S, E, tid); } break;
        case K_RES: {
            const float* xp = first ? p.x_prompt : Y; const float* xs = first ? p.x_sample : Y + (size_t)NPROMPT * D;
            pg8::Gemm gm; EpiRes E{xp, xs, Y, MOD, 0, 0.5f, g};
            if (g >= 0) { gm = pg8::Gemm{PROJ + PC_Z, (const bf16*)(ws + WS_WOUT), grows_of(g), D, D, NPROJ, D, 128, 512 * NPROJ}; E.goff = 5120; E.gscale = 1.0f; }
            else { gm = pg8::Gemm{ACT, (const bf16*)(ws + (ffn ? WS_W2OUT : WS_W1OUT)), NROWS, D, FF, 64, FF, 32768, 44 * 32768};   E.goff = ffn ? 8192 : 2048; }
            pg8::StaticOrder S; S.init(gm.M, gm.N, G, bx);
            pg8::gemm_phase<EpiRes, pg8::StaticOrder, true, true>(lds, gm, S, E, tid); } break;
        case K_PROJ: { pg8::Gemm gm{H, (const bf16*)(ws + WS_WIN), grows_of(g), NPROJ, D, D, D, 128, 512 * D}; pg8::StaticOrder S; S.init(grows_of(g), NPROJ, G, bx); EpiBf16Plain E{PROJ, NPROJ};
            pg8::gemm_phase<EpiBf16Plain, pg8::StaticOrder, true, true>(lds, gm, S, E, tid); } break;
        case K_MIX:
            gdn_prep_stage_cw(p, bx & 7, lds, tid); __syncthreads();
#pragma nounroll
            for (int it = bx; it < ncu_of(g) * 8; it += G) { int t2 = tid; asm volatile("" : "+v"(t2)); gdn_prep_item(p, g, it >> 3, it & 7, lds, t2, __builtin_amdgcn_readfirstlane(t2 >> 6), t2 & 63); }
#pragma nounroll
            for (int it = (bx + 128) % G; it < ncu_of(g) * 4; it += G) { int t2 = tid; asm volatile("" : "+v"(t2)); swa_item(p, g, it >> 2, it & 3, lds, t2, __builtin_amdgcn_readfirstlane(t2 >> 6), t2 & 63); }
            break;
        default:
#pragma nounroll
            for (int ch = bx; ch < (g == 0 ? 384 : 128); ch += G) { int t2 = tid; asm volatile("" : "+v"(t2)); scan_chain(p, g, ch >> 3, ch & 7, lds, t2, __builtin_amdgcn_readfirstlane(t2 >> 6), t2 & 63); }
            break;
        }
        if (ph != 16) xcd_barrier(xbar);
    }
#ifdef EXTRA_SYNCS
    grid.sync(); grid.sync(); grid.sync(); grid.sync(); grid.sync(); grid.sync(); grid.sync(); grid.sync(); grid.sync(); grid.sync();
#endif
}

extern "C" void kernel_launch(void* const* d_in, const int* in_sizes, int n_in, void* d_out, int out_size, void* d_ws, size_t ws_size, hipStream_t stream) {
    static int grid_blocks = 0;
    if (grid_blocks == 0) {
        if (n_in != 27 || ws_size < WS_END) { fprintf(stderr, "kernel_launch: unexpected n_in %d / ws_size %zu (need %zu)\n", n_in, ws_size, (size_t)WS_END); grid_blocks = -1; return; }
        int dev = 0, cus = 0, per_cu = 0;
        (void)hipGetDevice(&dev); (void)hipDeviceGetAttribute(&cus, hipDeviceAttributeMultiprocessorCount, dev);
        (void)hipFuncSetAttribute((const void*)mega_fwd, hipFuncAttributeMaxDynamicSharedMemorySize, LDS_BYTES);
        (void)hipOccupancyMaxActiveBlocksPerMultiprocessor(&per_cu, (const void*)mega_fwd, 512, LDS_BYTES);
        if (per_cu < 1) { fprintf(stderr, "kernel_launch: occupancy query says %d blocks per CU; the in-kernel barriers need every workgroup resident: nothing launched\n", per_cu); grid_blocks = -1; return; }
        grid_blocks = cus;
    }
    if (grid_blocks < 0) return;
    if (hipMemsetAsync((char*)d_ws + WS_BAR, 0, 16384, stream) != hipSuccess) { fprintf(stderr, "kernel_launch: memset of the barrier words failed\n"); return; }
    Params p{};
    const float** pp = (const float**)&p;
    for (int i = 0; i < 27; ++i) pp[i] = (const float*)d_in[i];
    p.out = (float*)d_out; p.ws = (unsigned char*)d_ws;
    void* args[] = {&p};
    hipError_t e = hipLaunchCooperativeKernel((const void*)mega_fwd, dim3(grid_blocks), dim3(512), args, LDS_BYTES, stream);
    if (e != hipSuccess) fprintf(stderr, "cooperative launch failed: %s (grid %d)\n", hipGetErrorString(e), grid_blocks);
}
```

```cpp
#include <hip/hip_runtime.h>
#include <hip/hip_cooperative_groups.h>
#include <cstdio>
#include <cstdint>
namespace cg = cooperative_groups;
namespace pg8 {
#define PG8_LAS __attribute__((address_space(3)))
typedef unsigned short bf16_t;
typedef short bf16x8 __attribute__((ext_vector_type(8)));
typedef float f32x4 __attribute__((ext_vector_type(4)));
typedef unsigned u32x4 __attribute__((ext_vector_type(4)));
constexpr int BM = 256, BK = 64, HALF = 128, HTB = HALF * BK * 2  , STAGE_BYTES = 8 * HTB, NXCD = 8, WGM = 4;

__host__ __device__ __forceinline__ int lds_byte(int r, int c) { const int st = (r >> 4) * 2 + (c >> 5), rr = r & 15, cc = c & 31, ob = rr * 64 + cc * 2; return st * 1024 + (ob ^ (((ob >> 9) & 1) << 5)); }
__host__ __device__ __forceinline__ void stage_rc(int b, int& R, int& C) { const int st = b / 1024, sb = b % 1024, swz = sb ^ (((sb >> 9) & 1) << 5); R = (st >> 1) * 16 + swz / 64; C = (st & 1) * 32 + (swz % 64) / 2; }
__host__ __device__ __forceinline__ int perm32(int rho) { const int n = rho >> 4, i = rho & 15; return 8 * (i >> 2) + 4 * n + (i & 3); }

struct Unit { int pm, pn; };
struct Gemm { const bf16_t* A; const bf16_t* Bt; int M, N, K, lda, ldb, a_kstep, a_tstep; };

struct StaticOrder {
    int nM, nN, nwg, G, c;
    __host__ __device__ void init(int M, int N, int G_, int c_) { nM = M / BM; nN = N / BM; nwg = nM * nN; G = G_; c = c_; }
    __host__ __device__ bool next(int i, Unit& u) const {
        const long L = (long)i * G + c; if (L >= nwg) return false;
        int wgid = (int)L; { const int q = nwg / NXCD, r = nwg % NXCD, xcd = wgid % NXCD, off = wgid / NXCD; wgid = (xcd < r ? xcd * (q + 1) : r * (q + 1) + (xcd - r) * q) + off; }
        const int nig = WGM * nN, gid = wgid / nig, fm = gid * WGM, gsz = (nM - fm) < WGM ? (nM - fm) : WGM;
        u.pm = fm + ((wgid % nig) % gsz); u.pn = (wgid % nig) / gsz; return true;
    }
    __device__ __forceinline__ void a_ready(const Unit&) const {}
    __device__ __forceinline__ void done(const Unit&) const {}
};

__device__ __forceinline__ unsigned cvt_pk_bf16(float lo, float hi) { unsigned r; asm volatile("v_cvt_pk_bf16_f32 %0, %1, %2" : "=v"(r) : "v"(lo), "v"(hi)); return r; }
typedef float f32x2 __attribute__((ext_vector_type(2)));
template <class Epi, class Sched, bool ALIGN_EPI = false, bool SP2 = false>
__device__ __forceinline__ void gemm_phase(PG8_LAS unsigned char* lds, const Gemm g, const Sched& S, const Epi& E, const int tid_in) {
    const int tid = tid_in, wid = __builtin_amdgcn_readfirstlane(tid >> 6), lane = tid & 63, wr = wid >> 2, wc = wid & 3, fr = lane & 15, fq = lane >> 4;
    const int K = g.K, nt = K / BK;
    unsigned voffA[2], voffB[2];
#pragma unroll
    for (int i = 0; i < 2; ++i) { int R, C; stage_rc(tid * 16 + i * 8192, R, C); const int Rb = Epi::PERM ? ((R & ~31) + perm32(R & 31)) : R;
        voffA[i] = (unsigned)(R * g.lda + C) * 2u; voffB[i] = (unsigned)(Rb * g.ldb + C) * 2u; }
    const size_t kstep = (size_t)(BK * 2);
    const size_t hstep = (size_t)HALF * g.ldb * 2;
    const size_t tstep = 2 * hstep;
    const size_t hstepA = (size_t)HALF * g.lda * 2, tstepA = (size_t)g.a_tstep, kstepA = (size_t)g.a_kstep;
    const unsigned ldsw = (unsigned)wid * 1024u;
    const int aoff = lds_byte(wr * 64 + fr, fq * 8), boff = lds_byte(wc * 32 + fr, fq * 8);
#define PG8_SA(b, h) (((b) * 2 + (h)) * HTB)
#define PG8_SB(b, h) ((4 + (b) * 2 + (h)) * HTB)
#define PG8_STAGE(bufoff, gbase, voff) do { _Pragma("unroll") for (int _i = 0; _i < 2; ++_i) \
        __builtin_amdgcn_global_load_lds((const unsigned*)((const char*)(gbase) + (voff)[_i]), (PG8_LAS unsigned*)(lds + (bufoff) + ldsw + _i * 8192), 16, 0, 0); } while (0)
#define PG8_LDA(dst, b, h) do { _Pragma("unroll") for (int m = 0; m < 4; ++m) _Pragma("unroll") for (int k = 0; k < 2; ++k) dst[m][k] = *(const PG8_LAS bf16x8*)(lds + PG8_SA(b, h) + aoff + m * 2048 + k * 1024); } while (0)
#define PG8_LDB(dst, b, h) do { _Pragma("unroll") for (int n = 0; n < 2; ++n) _Pragma("unroll") for (int k = 0; k < 2; ++k) dst[n][k] = *(const PG8_LAS bf16x8*)(lds + PG8_SB(b, h) + boff + n * 2048 + k * 1024); } while (0)
#define PG8_MMA(ai, bj, At, Bt) do { __builtin_amdgcn_s_setprio(1); _Pragma("unroll") for (int m = 0; m < 4; ++m) _Pragma("unroll") for (int n = 0; n < 2; ++n) _Pragma("unroll") for (int k = 0; k < 2; ++k) \
        acc[ai][bj][m][n] = __builtin_amdgcn_mfma_f32_16x16x32_bf16(Bt[n][k], At[m][k], acc[ai][bj][m][n], 0, 0, 0); __builtin_amdgcn_s_setprio(0); } while (0)
#define PG8_WAIT_V(n) asm volatile("s_waitcnt vmcnt(" #n ")" ::: "memory")
#define PG8_WAIT_L(n) asm volatile("s_waitcnt lgkmcnt(" #n ")" ::: "memory")
#define PG8_BAR __builtin_amdgcn_s_barrier()
#define PG8_SCHED __builtin_amdgcn_sched_barrier(0)
    Unit cur, nxt; int ui = 0;
    if (!S.next(0, cur)) return;
    f32x4 acc[2][2][4][2];
#pragma unroll
    for (int a = 0; a < 2; ++a)
#pragma unroll
        for (int b = 0; b < 2; ++b)
#pragma unroll
            for (int m = 0; m < 4; ++m)
#pragma unroll
                for (int n = 0; n < 2; ++n) acc[a][b][m][n] = (f32x4){0.f, 0.f, 0.f, 0.f};
    bf16x8 At[4][2], B0[2][2], B1[2][2];
    const char* cA = (const char*)g.A + (size_t)cur.pm * tstepA; const char* cB = (const char*)g.Bt + (size_t)cur.pn * tstep;
    S.a_ready(cur);
    if constexpr (SP2) {
        PG8_STAGE(PG8_SB(0, 0), cB, voffB); PG8_STAGE(PG8_SB(0, 1), cB + hstep, voffB); PG8_STAGE(PG8_SA(0, 0), cA, voffA); PG8_STAGE(PG8_SA(0, 1), cA + hstepA, voffA);
        if (wr == 1) PG8_BAR;
        PG8_WAIT_V(2); PG8_BAR;
        PG8_STAGE(PG8_SB(1, 0), cB + kstep, voffB); PG8_STAGE(PG8_SA(1, 0), cA + kstepA, voffA); PG8_STAGE(PG8_SB(1, 1), cB + hstep + kstep, voffB);
        PG8_WAIT_V(6); PG8_BAR;
    } else {
        PG8_STAGE(PG8_SB(0, 0), cB, voffB); PG8_STAGE(PG8_SA(0, 0), cA, voffA); PG8_STAGE(PG8_SB(0, 1), cB + hstep, voffB); PG8_STAGE(PG8_SA(0, 1), cA + hstepA, voffA);
        if (wr == 1) PG8_BAR;
        PG8_WAIT_V(4); PG8_BAR;
        PG8_STAGE(PG8_SB(1, 0), cB + kstep, voffB); PG8_STAGE(PG8_SA(1, 0), cA + kstepA, voffA); PG8_STAGE(PG8_SB(1, 1), cB + hstep + kstep, voffB);
        PG8_WAIT_V(6); PG8_BAR;
    }
    for (;;) {
        const bool has_next = S.next(ui + 1, nxt);
        const char* nA = has_next ? (const char*)g.A + (size_t)nxt.pm * tstepA : cA; const char* nB = has_next ? (const char*)g.Bt + (size_t)nxt.pn * tstep : cB;
        for (int t = 0; t < nt; t += 2) {
            const bool last = (t == nt - 2);
            const char* a1 = cA + (size_t)(t + 1) * kstepA;
            const char* a2 = last ? nA : cA + (size_t)(t + 2) * kstepA; const char* b2 = last ? nB : cB + (size_t)(t + 2) * kstep;
            const char* a3 = a2 + kstepA; const char* b3 = b2 + kstep;
            if (last && has_next) S.a_ready(nxt);
            if constexpr (SP2) {
            PG8_LDB(B0, 0, 0); PG8_LDB(B1, 0, 1); PG8_SCHED; PG8_LDA(At, 0, 0); PG8_STAGE(PG8_SA(1, 1), a1 + hstepA, voffA);
            PG8_WAIT_V(8); PG8_WAIT_L(0); PG8_BAR; PG8_MMA(0, 0, At, B0); PG8_MMA(0, 1, At, B1); PG8_BAR; PG8_SCHED;
            PG8_LDA(At, 0, 1); PG8_STAGE(PG8_SB(0, 0), b2, voffB); PG8_STAGE(PG8_SB(0, 1), b2 + hstep, voffB); PG8_STAGE(PG8_SA(0, 0), a2, voffA);
            PG8_WAIT_V(8); PG8_WAIT_L(0); PG8_BAR; PG8_MMA(1, 0, At, B0); PG8_MMA(1, 1, At, B1); PG8_BAR; PG8_SCHED;
            PG8_LDB(B0, 1, 0); PG8_LDB(B1, 1, 1); PG8_SCHED; PG8_LDA(At, 1, 0); PG8_STAGE(PG8_SA(0, 1), a2 + hstepA, voffA);
            PG8_WAIT_V(8); PG8_WAIT_L(0); PG8_BAR; PG8_MMA(0, 0, At, B0); PG8_MMA(0, 1, At, B1); PG8_BAR; PG8_SCHED;
            PG8_LDA(At, 1, 1); PG8_STAGE(PG8_SB(1, 0), b3, voffB); PG8_STAGE(PG8_SB(1, 1), b3 + hstep, voffB); PG8_STAGE(PG8_SA(1, 0), a3, voffA);
            PG8_WAIT_V(8); PG8_WAIT_L(0); PG8_BAR; PG8_MMA(1, 0, At, B0); PG8_MMA(1, 1, At, B1); PG8_BAR; PG8_SCHED;
            } else {
            PG8_LDB(B0, 0, 0); PG8_SCHED; PG8_LDA(At, 0, 0); PG8_STAGE(PG8_SA(1, 1), a1 + hstepA, voffA);
            PG8_WAIT_L(8); PG8_BAR; PG8_WAIT_L(0); PG8_MMA(0, 0, At, B0); PG8_BAR; PG8_SCHED;
            PG8_LDB(B1, 0, 1); PG8_STAGE(PG8_SB(0, 0), b2, voffB);
            PG8_BAR; PG8_WAIT_L(0); PG8_MMA(0, 1, At, B1); PG8_BAR;
            PG8_LDA(At, 0, 1); PG8_STAGE(PG8_SA(0, 0), a2, voffA);
            PG8_BAR; PG8_WAIT_L(0); PG8_MMA(1, 0, At, B0); PG8_BAR; PG8_SCHED;
            PG8_STAGE(PG8_SB(0, 1), b2 + hstep, voffB);
            PG8_WAIT_V(6); PG8_BAR; PG8_MMA(1, 1, At, B1); PG8_BAR;
            PG8_LDB(B0, 1, 0); PG8_SCHED; PG8_LDA(At, 1, 0); PG8_STAGE(PG8_SA(0, 1), a2 + hstepA, voffA);
            PG8_WAIT_L(8); PG8_BAR; PG8_WAIT_L(0); PG8_MMA(0, 0, At, B0); PG8_BAR; PG8_SCHED;
            PG8_LDB(B1, 1, 1); PG8_STAGE(PG8_SB(1, 0), b3, voffB);
            PG8_BAR; PG8_WAIT_L(0); PG8_MMA(0, 1, At, B1); PG8_BAR;
            PG8_LDA(At, 1, 1); PG8_STAGE(PG8_SA(1, 0), a3, voffA);
            PG8_BAR; PG8_WAIT_L(0); PG8_MMA(1, 0, At, B0); PG8_BAR; PG8_SCHED;
            PG8_STAGE(PG8_SB(1, 1), b3 + hstep, voffB);
            PG8_WAIT_V(6); PG8_BAR; PG8_MMA(1, 1, At, B1); PG8_BAR;
            }
        }
        if constexpr (ALIGN_EPI) { if (wr == 0) PG8_BAR; }
        if constexpr (!Epi::AFTER_DRAIN) { E(acc, cur, wr, wc, fr, fq); S.done(cur); }
        if (!has_next) break;
#pragma unroll
        for (int a = 0; a < 2; ++a)
#pragma unroll
            for (int b = 0; b < 2; ++b)
#pragma unroll
                for (int m = 0; m < 4; ++m)
#pragma unroll
                    for (int n = 0; n < 2; ++n) acc[a][b][m][n] = (f32x4){0.f, 0.f, 0.f, 0.f};
        cur = nxt; cA = nA; cB = nB; ++ui;
        if constexpr (ALIGN_EPI) { if (wr == 1) PG8_BAR; }
    }
    PG8_WAIT_V(0);
    if constexpr (!ALIGN_EPI) { if (wr == 0) PG8_BAR; }
    PG8_BAR;
    if constexpr (Epi::AFTER_DRAIN) { E.fused(acc, cur, wr, wc, fr, fq, lds, wid, lane); S.done(cur); }
#undef PG8_SA
#undef PG8_SB
#undef PG8_STAGE
#undef PG8_LDA
#undef PG8_LDB
#undef PG8_MMA
#undef PG8_WAIT_V
#undef PG8_WAIT_L
#undef PG8_BAR
#undef PG8_SCHED
}
}
#define LAS __attribute__((address_space(3)))
typedef unsigned short bf16;
typedef short bf16x8 __attribute__((ext_vector_type(8)));
typedef float f32x4 __attribute__((ext_vector_type(4)));
typedef unsigned u32x4 __attribute__((ext_vector_type(4)));
typedef unsigned u32x2 __attribute__((ext_vector_type(2)));
typedef float f32x2_t __attribute__((ext_vector_type(2)));
typedef __bf16 bf16x2_t __attribute__((ext_vector_type(2)));
__device__ __forceinline__ unsigned cvt_pk_bf16(float lo, float hi) { const f32x2_t v = {lo, hi}; const bf16x2_t b = __builtin_convertvector(v, bf16x2_t); return __builtin_bit_cast(unsigned, b); }

constexpr int D = 1024, NROWS = 34816, NPROMPT = 32768, FF = 2816, NPROJ = 7680, WIN_N = 7696, NMOD = 9216;
constexpr int GROWS_MAX = 18432;
__host__ __device__ constexpr int grows_of(int g) { return g == 0 ? 18432 : 16384; }
__host__ __device__ constexpr int ncu_of(int g) { return g == 0 ? 288 : 256; }
constexpr float EPS = 1e-6f;
constexpr int PC_Z = 3072, PC_QS = 4096, PC_KS = 5120, PC_VS = 5376, PC_GA = 5632, PC_GB = 6656;
constexpr size_t O_Y = 0, O_CONVP = 35651584, O_GDNP = 35799040, O_KP = 37896192, O_VP = 38420480, O_CONVS = 38944768, O_GDNS = 39239680, O_KS = 43433984, O_VS = 44482560;
constexpr size_t MiB = 1u << 20;
constexpr size_t WS_MOD = 0, WS_GB = 2 * MiB, WS_HALO = 3 * MiB + 512 * 1024  , WS_DL = 4 * MiB, WS_KVT = 5 * MiB  ,
    WS_W1IN = 7 * MiB, WS_W1OUT = 18 * MiB, WS_WIN = 24 * MiB, WS_WOUT = 39 * MiB, WS_W2IN = 41 * MiB, WS_W2OUT = 52 * MiB;
constexpr size_t WS_H = 58 * MiB;
constexpr size_t WS_EX = 58 * MiB, WS_BIG = 220 * MiB;
constexpr size_t WS_END = 490 * MiB;
constexpr int EX_ITEM = 73728, EX_UT = 0, EX_WN = 16384, EX_QD = 32768, EX_KDT = 49152, EX_QK = 65536;
constexpr int LDS_BYTES = 151552;
constexpr size_t WS_BAR = 4 * MiB + 256 * 1024;
constexpr int LDS_BARST = LDS_BYTES - 16;

struct Params {
    const float *x_prompt, *x_sample, *state_conv, *state_gdn, *cache_k, *cache_v, *c_prompt, *c_sample, *w_ada, *b_ada, *norm_ffn1, *ffn1_w_in, *ffn1_w_out,
        *norm_mix, *w_in, *conv_w, *a_log, *dt_bias, *gdn_norm, *q_norm, *k_norm, *sinks, *b_merge, *w_out, *norm_ffn2, *ffn2_w_in, *ffn2_w_out;
    float* out; unsigned char* ws;
};

__device__ __forceinline__ float bflo(unsigned w) { return __uint_as_float(w << 16); }
__device__ __forceinline__ float bfhi(unsigned w) { return __uint_as_float(w & 0xffff0000u); }
__device__ __forceinline__ unsigned short f2bf(float f) { return (unsigned short)(cvt_pk_bf16(f, 0.f) & 0xffffu); }
__device__ __forceinline__ float sigmoidf_(float x) { return __builtin_amdgcn_rcpf(1.f + __expf(-x)); }
__device__ __forceinline__ float siluf_(float x) { return x * sigmoidf_(x); }
__device__ __forceinline__ void unpack8(const u32x4 w, float (&f)[8]) { f[0] = bflo(w.x); f[1] = bfhi(w.x); f[2] = bflo(w.y); f[3] = bfhi(w.y); f[4] = bflo(w.z); f[5] = bfhi(w.z); f[6] = bflo(w.w); f[7] = bfhi(w.w); }
__device__ __forceinline__ u32x4 pack8(const float (&f)[8]) { u32x4 w; w.x = cvt_pk_bf16(f[0], f[1]); w.y = cvt_pk_bf16(f[2], f[3]); w.z = cvt_pk_bf16(f[4], f[5]); w.w = cvt_pk_bf16(f[6], f[7]); return w; }
__device__ __forceinline__ bf16x8 as_bf16x8(u32x4 w) { return __builtin_bit_cast(bf16x8, w); }
__device__ __forceinline__ float wave_sum(float v) {
#pragma unroll
    for (int o = 1; o < 64; o <<= 1) v += __shfl_xor(v, o);
    return v;
}
__device__ __forceinline__ int grow_of(int g, int lr) { return lr < 16384 ? (lr >> 10) * 2048 + 1024 * g + (lr & 1023) : NPROMPT + (lr - 16384); }
__device__ __forceinline__ int modrow_of(int m) { return m < NPROMPT ? (m >> 11) : 16 + ((m - NPROMPT) >> 6); }

struct EpiSwiglu {
    static constexpr bool PERM = true, AFTER_DRAIN = false;
    bf16* O;
    __device__ __forceinline__ void operator()(const pg8::f32x4 (&acc)[2][2][4][2], const pg8::Unit& u, int wr, int wc, int fr, int fq) const {
        const int row0 = u.pm * 256 + wr * 64 + fr, col0 = u.pn * 128 + wc * 32 + 8 * fq; const int kt = col0 >> 6, cin = col0 & 63;
#pragma unroll
        for (int ai = 0; ai < 2; ++ai)
#pragma unroll
            for (int m = 0; m < 4; ++m) {
                float v[8];
#pragma unroll
                for (int n = 0; n < 2; ++n)
#pragma unroll
                    for (int i = 0; i < 4; ++i) { const float gt = acc[ai][0][m][n][i], up = acc[ai][1][m][n][i]; v[n * 4 + i] = siluf_(gt) * up; }
                *(u32x4*)(O + ((size_t)(u.pm * 44 + kt) * 256 + (row0 - u.pm * 256) + ai * 128 + m * 16) * 64 + cin) = pack8(v);
            }
    }
};
struct EpiBf16Plain {
    static constexpr bool PERM = true, AFTER_DRAIN = false;
    bf16* O; int ldc;
    __device__ __forceinline__ void operator()(const pg8::f32x4 (&acc)[2][2][4][2], const pg8::Unit& u, int wr, int wc, int fr, int fq) const {
        const int row0 = u.pm * 256 + wr * 64 + fr, col0 = u.pn * 256 + wc * 32 + 8 * fq;
#pragma unroll
        for (int ai = 0; ai < 2; ++ai)
#pragma unroll
            for (int m = 0; m < 4; ++m)
#pragma unroll
                for (int bj = 0; bj < 2; ++bj) {
                    float v[8];
#pragma unroll
                    for (int n = 0; n < 2; ++n)
#pragma unroll
                        for (int i = 0; i < 4; ++i) v[n * 4 + i] = acc[ai][bj][m][n][i];
                    *(u32x4*)(O + (size_t)(row0 + ai * 128 + m * 16) * ldc + col0 + bj * 128) = pack8(v);
                }
    }
};
struct EpiRes {
    static constexpr bool PERM = false, AFTER_DRAIN = false;
    const float* xin_p; const float* xin_s; float* out; const float* mod; int goff; float gscale; int grp;
    __device__ __forceinline__ void operator()(const pg8::f32x4 (&acc)[2][2][4][2], const pg8::Unit& u, int wr, int wc, int fr, int fq) const {
        const int col0 = u.pn * 256 + wc * 32 + 4 * fq;
        f32x4 xv[2][4], gv[2][4]; float* orow[2];
#define EPIRES_LOAD(buf, it) do { const int R_ = u.pm * 256 + ((it) >> 2) * 128 + wr * 64 + ((it) & 3) * 16 + fr; const int gm_ = grp < 0 ? R_ : grow_of(grp, R_); \
            const float* xr_ = gm_ < NPROMPT ? xin_p + (size_t)gm_ * D : xin_s + (size_t)(gm_ - NPROMPT) * D; const float* mr_ = mod + (size_t)modrow_of(gm_) * NMOD + goff; orow[buf] = out + (size_t)gm_ * D; \
            _Pragma("unroll") for (int q_ = 0; q_ < 4; ++q_) { const int c_ = col0 + (q_ >> 1) * 128 + (q_ & 1) * 16; xv[buf][q_] = *(const f32x4*)(xr_ + c_); gv[buf][q_] = *(const f32x4*)(mr_ + c_); } } while (0)
        EPIRES_LOAD(0, 0);
#pragma unroll
        for (int it = 0; it < 8; ++it) {
            if (it < 7) EPIRES_LOAD((it + 1) & 1, it + 1);
#pragma unroll
            for (int q = 0; q < 4; ++q) { const int c = col0 + (q >> 1) * 128 + (q & 1) * 16;
                *(f32x4*)(orow[it & 1] + c) = xv[it & 1][q] + gscale * gv[it & 1][q] * acc[it >> 2][q >> 1][it & 3][q & 1]; }
        }
#undef EPIRES_LOAD
    }
};

__device__ __forceinline__ void transpose_tile(const float* W, int ldw, int K, bf16* WT, int dst_row0, int src_col0, int k0, LAS float* scr, int lane) {
    const int voff = (lane >> 5) * ldw + (lane & 31);
#pragma unroll
    for (int i = 0; i < 32; ++i) { const float* wr = W + (size_t)(k0 + 2 * i) * ldw + src_col0; scr[(2 * i + (lane >> 5)) * 33 + (lane & 31)] = wr[voff]; }
    asm volatile("s_waitcnt lgkmcnt(0)" ::: "memory");
    const int c = lane & 7;
#pragma unroll
    for (int j = 0; j < 4; ++j) { const int n = (lane >> 3) + 8 * j; const LAS float* s = scr + (8 * c) * 33 + n;
        u32x4 o; o.x = cvt_pk_bf16(s[0 * 33], s[1 * 33]); o.y = cvt_pk_bf16(s[2 * 33], s[3 * 33]); o.z = cvt_pk_bf16(s[4 * 33], s[5 * 33]); o.w = cvt_pk_bf16(s[6 * 33], s[7 * 33]);
        *(u32x4*)(WT + (size_t)(dst_row0 + n) * K + k0 + 8 * c) = o; }
    asm volatile("s_waitcnt lgkmcnt(0)" ::: "memory");
}
__device__ __forceinline__ int swiglu_src(int n) { const int pn = n >> 8, r = n & 255; return r < 128 ? 128 * pn + r : FF + 128 * pn + (r - 128); }
__device__ __forceinline__ void p0_phase(const Params& p, LAS unsigned char* lds, int tid, int wave, int lane) {
    unsigned char* ws = p.ws;
    if (blockIdx.x < 144) {
        const int n0 = blockIdx.x * 64, fr = lane & 15, fq = lane >> 4;
        float* MOD = (float*)(ws + WS_MOD);
#pragma unroll 4
        for (int i = 0; i < 12; ++i) { const int idx = tid + 512 * i, r = idx >> 7, k8 = (idx & 127) * 8;
            const float* cp = r < 16 ? p.c_prompt + r * D + k8 : p.c_sample + (r - 16) * D + k8;
            const f32x4 a = *(const f32x4*)cp, b2 = *(const f32x4*)(cp + 4); float v[8];
#pragma unroll
            for (int j = 0; j < 4; ++j) { v[j] = a[j] / (1.f + __expf(-a[j])); v[4 + j] = b2[j] / (1.f + __expf(-b2[j])); }
            *(LAS u32x4*)(lds + r * 2064 + k8 * 2) = pack8(v); }
        __syncthreads();
        f32x4 acc[3][4];
#pragma unroll
        for (int mb = 0; mb < 3; ++mb)
#pragma unroll
            for (int nb = 0; nb < 4; ++nb) acc[mb][nb] = (f32x4){0.f, 0.f, 0.f, 0.f};
        const int kb = wave * 128;
        const int voff = (8 * fq) * NMOD + fr;
#pragma unroll
        for (int ks = 0; ks < 4; ++ks) {
            bf16x8 bfr[4];
#pragma unroll
            for (int nb = 0; nb < 4; ++nb) { float w[8];
#pragma unroll
                for (int j = 0; j < 8; ++j) { const float* wr = p.w_ada + (size_t)(kb + 32 * ks + j) * NMOD + n0 + 16 * nb; w[j] = wr[voff]; }
                bfr[nb] = as_bf16x8(pack8(w)); }
#pragma unroll
            for (int mb = 0; mb < 3; ++mb) { const bf16x8 af = *(const LAS bf16x8*)(lds + (16 * mb + fr) * 2064 + (kb + 32 * ks + 8 * fq) * 2);
#pragma unroll
                for (int nb = 0; nb < 4; ++nb) acc[mb][nb] = __builtin_amdgcn_mfma_f32_16x16x32_bf16(af, bfr[nb], acc[mb][nb], 0, 0, 0); }
        }
        __syncthreads();
        LAS float* part = (LAS float*)lds;
#pragma unroll
        for (int mb = 0; mb < 3; ++mb)
#pragma unroll
            for (int nb = 0; nb < 4; ++nb)
#pragma unroll
                for (int j = 0; j < 4; ++j) part[(wave * 48 + 16 * mb + 4 * fq + j) * 64 + 16 * nb + fr] = acc[mb][nb][j];
        __syncthreads();
#pragma unroll
        for (int i = 0; i < 6; ++i) { const int idx = tid + 512 * i, r = idx >> 6, col = idx & 63; float sm = p.b_ada[n0 + col];
#pragma unroll
            for (int w = 0; w < 8; ++w) sm += part[(w * 48 + r) * 64 + col];
            MOD[(size_t)r * NMOD + n0 + col] = sm; }
        __syncthreads();
    }
    LAS float* scr = (LAS float*)(lds + wave * 16384);
    const int gw = blockIdx.x * 8 + wave, NGW = gridDim.x * 8;
    constexpr int I0 = 16 * 176, I1 = 44 * 32, I2 = 16 * 240, I3 = 16 * 32;
    constexpr int NIT = 2 * I0 + 2 * I1 + I2 + I3;
#pragma unroll 1
    for (int it = gw; it < NIT; it += NGW) {
        int r = it; const float* W; int ldw, K, nb, kb, srcc; size_t wso;
        if (r < I0) { nb = r % 176; kb = r / 176; W = p.ffn1_w_in; ldw = 2 * FF; K = D; wso = WS_W1IN; srcc = swiglu_src(32 * nb); }
        else if ((r -= I0) < I0) { nb = r % 176; kb = r / 176; W = p.ffn2_w_in; ldw = 2 * FF; K = D; wso = WS_W2IN; srcc = swiglu_src(32 * nb); }
        else if ((r -= I0) < I1) { nb = r % 32; kb = r / 32; W = p.ffn1_w_out; ldw = D; K = FF; wso = WS_W1OUT; srcc = 32 * nb; }
        else if ((r -= I1) < I1) { nb = r % 32; kb = r / 32; W = p.ffn2_w_out; ldw = D; K = FF; wso = WS_W2OUT; srcc = 32 * nb; }
        else if ((r -= I1) < I2) { nb = r % 240; kb = r / 240; W = p.w_in; ldw = WIN_N; K = D; wso = WS_WIN; srcc = 32 * nb < 4096 ? 32 * nb : 32 * nb + 16; }
        else { r -= I2; nb = r % 32; kb = r / 32; W = p.w_out; ldw = D; K = D; wso = WS_WOUT; srcc = 32 * nb; }
        transpose_tile(W, ldw, K, (bf16*)(ws + wso), 32 * nb, srcc, 64 * kb, scr, lane);
    }
}

__device__ __forceinline__ void mod_phase(const Params& p, const bool AB, const float* xin_p, const float* xin_s, const float* gain, int moff, bf16* H, int grp, int nrows, LAS unsigned char* lds, int tid, int wave, int lane) {
    const float* MOD = (const float*)(p.ws + WS_MOD);
    LAS float* wabt = (LAS float*)lds;
    if (AB) {
        for (int i = 0; i < 8; ++i) { const int idx = tid + 512 * i, k = idx >> 2, j4 = idx & 3; const f32x4 w = *(const f32x4*)(p.w_in + (size_t)k * WIN_N + 4096 + 4 * j4);
#pragma unroll
            for (int e = 0; e < 4; ++e) wabt[(4 * j4 + e) * 1024 + k] = w[e]; }
        __syncthreads();
    }
    const int gw = blockIdx.x * 8 + wave, NGW = gridDim.x * 8;
    const int rpw = (nrows + NGW - 1) / NGW, rbeg = gw * rpw, rend = (rbeg + rpw < nrows) ? rbeg + rpw : nrows;
    f32x4 gn[4], sh[4], sc[4];
#pragma unroll
    for (int j = 0; j < 4; ++j) gn[j] = *(const f32x4*)(gain + 4 * lane + 256 * j);
    int cur_mod = -1;
    f32x4 xa[4], xb[4];
#define MOD_XPTR(r) ({ const int gm_ = grp < 0 ? (r) : grow_of(grp, (r)); (gm_ < NPROMPT ? xin_p + (size_t)gm_ * D : xin_s + (size_t)(gm_ - NPROMPT) * D); })
#define MOD_LOADX(dst, r) do { const int rc_ = (r) < rend ? (r) : (rend - 1); const float* xr_ = MOD_XPTR(rc_); _Pragma("unroll") for (int j = 0; j < 4; ++j) dst[j] = *(const f32x4*)(xr_ + 4 * lane + 256 * j); } while (0)
    if (rbeg < rend) { MOD_LOADX(xa, rbeg); MOD_LOADX(xb, rbeg + 1); }
#pragma unroll 1
    for (int r = rbeg; r < rend; ++r) {
        f32x4 v[4];
#pragma unroll
        for (int j = 0; j < 4; ++j) { v[j] = xa[j]; xa[j] = xb[j]; }
        MOD_LOADX(xb, r + 2);
        const int gm = grp < 0 ? r : grow_of(grp, r); const int mrow = modrow_of(gm);
        if (mrow != cur_mod) { cur_mod = mrow; const float* mr = MOD + (size_t)mrow * NMOD + moff;
#pragma unroll
            for (int j = 0; j < 4; ++j) { sh[j] = *(const f32x4*)(mr + 4 * lane + 256 * j); sc[j] = *(const f32x4*)(mr + 1024 + 4 * lane + 256 * j); } }
        float ss = 0.f;
#pragma unroll
        for (int j = 0; j < 4; ++j) ss += (v[j][0] * v[j][0] + v[j][1] * v[j][1]) + (v[j][2] * v[j][2] + v[j][3] * v[j][3]);
        const float rstd = rsqrtf(wave_sum(ss) * (1.f / D) + EPS);
#pragma unroll
        for (int j = 0; j < 4; ++j) { v[j] = v[j] * rstd * gn[j] * (1.f + sc[j]) + sh[j];
            u32x2 o; o.x = cvt_pk_bf16(v[j][0], v[j][1]); o.y = cvt_pk_bf16(v[j][2], v[j][3]);
            *(u32x2*)(H + (size_t)r * D + 4 * lane + 256 * j) = o; }
        if (AB) {
            float s16[16];
#pragma unroll
            for (int o = 0; o < 16; ++o) { float s = 0.f;
#pragma unroll
                for (int j = 0; j < 4; ++j) { const f32x4 w = *(const LAS f32x4*)(wabt + o * 1024 + 4 * lane + 256 * j); s += (v[j][0] * w[0] + v[j][1] * w[1]) + (v[j][2] * w[2] + v[j][3] * w[3]); }
                s16[o] = s; }
            const bool b5 = lane & 32, b4 = lane & 16, b3 = lane & 8, b2 = lane & 4;
            float t8[8], t4[4], t2[2], t1;
#pragma unroll
            for (int j = 0; j < 8; ++j) { const float snd = b5 ? s16[j] : s16[8 + j], mine = b5 ? s16[8 + j] : s16[j]; t8[j] = mine + __shfl_xor(snd, 32); }
#pragma unroll
            for (int j = 0; j < 4; ++j) { const float snd = b4 ? t8[j] : t8[4 + j], mine = b4 ? t8[4 + j] : t8[j]; t4[j] = mine + __shfl_xor(snd, 16); }
#pragma unroll
            for (int j = 0; j < 2; ++j) { const float snd = b3 ? t4[j] : t4[2 + j], mine = b3 ? t4[2 + j] : t4[j]; t2[j] = mine + __shfl_xor(snd, 8); }
            { const float snd = b2 ? t2[0] : t2[1], mine = b2 ? t2[1] : t2[0]; t1 = mine + __shfl_xor(snd, 4); }
            t1 += __shfl_xor(t1, 2); t1 += __shfl_xor(t1, 1);
            if ((lane & 3) == 0) { const int o = lane >> 2; float res;
                if (o < 8) { const float A = __expf(p.a_log[o]); const float xx = t1 + p.dt_bias[o]; const float sp = xx > 20.f ? xx : log1pf(__expf(xx)); res = -A * sp; }
                else res = 1.f / (1.f + __expf(-t1));
                ((float*)(p.ws + WS_GB))[(size_t)r * 16 + o] = res; }
        }
    }
#undef MOD_XPTR
#undef MOD_LOADX
}
#define XB_TMO      128
#define XB_XCNT(j)  (256  + 64 * (j))
#define XB_XSUB(j)  (1280 + 64 * (j))
#define XB_XGEN(j)  (2304 + 64 * (j))
#define XB_TOP      3328
#define XB_TOPGEN   3392
#define XCD_BAR_WORDS 3456
#define XB_SPIN_CAP (1u << 18)

__device__ __forceinline__ unsigned xb_ld(unsigned* p)              { return __hip_atomic_load(p, __ATOMIC_RELAXED, __HIP_MEMORY_SCOPE_AGENT); }
__device__ __forceinline__ unsigned xb_add(unsigned* p, unsigned v) { return __hip_atomic_fetch_add(p, v, __ATOMIC_RELAXED, __HIP_MEMORY_SCOPE_AGENT); }
__device__ __forceinline__ unsigned xb_xcc_id() { return (unsigned)__builtin_amdgcn_s_getreg((3 << 11) | 20) & 0xFu; }
#define XB_SPIN(cond, bar) do { unsigned _sp = 0; while (cond) { __builtin_amdgcn_s_sleep(1); \
    if ((++_sp & 255u) == 0u) { if (xb_ld(&(bar)[XB_TMO])) break; if (_sp > XB_SPIN_CAP) { atomicAdd(&(bar)[XB_TMO], 1u); break; } } } } while (0)

struct XcdBarrier {
    unsigned* bar; unsigned x;
    volatile LAS unsigned* st;
};

__device__ __forceinline__ XcdBarrier xcd_barrier_post(unsigned* bar, volatile LAS unsigned* st) {
    XcdBarrier b; b.bar = bar; b.x = xb_xcc_id(); b.st = st;
    if (threadIdx.x == 0) (void)xb_add(&bar[XB_XCNT(b.x)], 1u);
    return b;
}
__device__ __forceinline__ void xcd_barrier_complete(unsigned* bar, unsigned x, unsigned& nloc, unsigned& nx) {
    const unsigned G = gridDim.x * gridDim.y * gridDim.z;
    unsigned sum, cnt, mine, sp = 0u;
    for (;;) {
        sum = 0u; cnt = 0u; mine = 0u;
#pragma unroll
        for (unsigned j = 0; j < 16; ++j) { const unsigned c = xb_ld(&bar[XB_XCNT(j)]); sum += c; cnt += (c > 0u) ? 1u : 0u; mine = (j == x) ? c : mine; }
        if (sum == G) break;
        __builtin_amdgcn_s_sleep(1);
        if ((++sp & 255u) == 0u) { if (xb_ld(&bar[XB_TMO])) break; if (sp > XB_SPIN_CAP) { atomicAdd(&bar[XB_TMO], 1u); break; } }
    }
    nloc = mine > 0u ? mine : 1u; nx = cnt > 0u ? cnt : 1u;
}

__device__ __forceinline__ void xcd_barrier(const XcdBarrier& b) {
    asm volatile("s_waitcnt vmcnt(0)" ::: "memory");
    __syncthreads();
    if (threadIdx.x == 0) {
        unsigned* bar = b.bar;
        __builtin_amdgcn_s_waitcnt(0);
        unsigned nloc = b.st[0], nx = b.st[1];
        if (nloc == 0u) { xcd_barrier_complete(bar, b.x, nloc, nx); b.st[0] = nloc; b.st[1] = nx; }
        const unsigned old = xb_add(&bar[XB_XSUB(b.x)], 1u);
        const unsigned gen = old / nloc;
        if (old + 1u == (gen + 1u) * nloc) {
            __builtin_amdgcn_fence(__ATOMIC_RELEASE, "agent");
            asm volatile("s_waitcnt vmcnt(0)" ::: "memory");
            const unsigned og = xb_add(&bar[XB_TOP], 1u);
            const unsigned tg = og / nx;
            if (og + 1u == (tg + 1u) * nx) xb_add(&bar[XB_TOPGEN], 1u);
            else XB_SPIN(xb_ld(&bar[XB_TOPGEN]) == tg, bar);
            __builtin_amdgcn_fence(__ATOMIC_ACQUIRE, "agent");
            xb_add(&bar[XB_XGEN(b.x)], 1u);
            asm volatile("s_waitcnt vmcnt(0)" ::: "memory");
        } else {
            XB_SPIN(xb_ld(&bar[XB_XGEN(b.x)]) == gen, bar);
            __builtin_amdgcn_fence(__ATOMIC_ACQUIRE, "agent");
            asm volatile("s_waitcnt vmcnt(0)" ::: "memory");
        }
    }
    __syncthreads();
}

#ifdef PROBE_TS
#define SEC(slot) do { if (blockIdx.x == 0 && threadIdx.x == 0) { unsigned long long* TS_ = (unsigned long long*)(p.ws + WS_DL + 512 * 1024); const unsigned long long t_ = __builtin_amdgcn_s_memrealtime(); TS_[(slot)] += t_ - TS_[31]; TS_[31] = t_; } } while (0)
#define SEC0() do { if (blockIdx.x == 0 && threadIdx.x == 0) { unsigned long long* TS_ = (unsigned long long*)(p.ws + WS_DL + 512 * 1024); TS_[31] = __builtin_amdgcn_s_memrealtime(); } } while (0)
#else
#define SEC(slot) do { } while (0)
#define SEC0() do { } while (0)
#endif
#define MFMA16(a, b, c) __builtin_amdgcn_mfma_f32_16x16x32_bf16((a), (b), (c), 0, 0, 0)
__device__ __forceinline__ bf16x8 lds_frag16(const LAS unsigned char* base) { return *(const LAS bf16x8*)base; }
__device__ __forceinline__ bf16x8 lds_frag8x2(const LAS unsigned char* lo, const LAS unsigned char* hi) {
    const u32x2 a = *(const LAS u32x2*)lo, b = *(const LAS u32x2*)hi; u32x4 w; w.x = a.x; w.y = a.y; w.z = b.x; w.w = b.y; return as_bf16x8(w); }
__device__ __forceinline__ bf16x8 pack_acc2(const f32x4 a, const f32x4 b) { u32x4 w; w.x = cvt_pk_bf16(a[0], a[1]); w.y = cvt_pk_bf16(a[2], a[3]); w.z = cvt_pk_bf16(b[0], b[1]); w.w = cvt_pk_bf16(b[2], b[3]); return as_bf16x8(w); }

constexpr int PL_QL = 0, PL_KL = 17408, PL_RT = 34816, PL_KDT = 71680, PL_AM = 90112  , PL_TB = 106752, PL_GS = 115968, PL_CW = 116992, PL_TM = 123136  ,
    PL_UTS = 0  , PL_WNS = 123136  , PL_QKS = 140544  ;
__device__ __forceinline__ void gdn_prep_stage_cw(const Params& p, int h, LAS unsigned char* lds, int tid) {
    for (int idx = tid; idx < 1536; idx += 512) { const int i = idx / 384, rem = idx - 384 * i, arr = rem >> 7, ch = rem & 127; ((LAS float*)(lds + PL_CW))[idx] = p.conv_w[i * 3072 + arr * 1024 + h * 128 + ch]; }
}
__device__ __forceinline__ void gdn_prep_item(const Params& p, int g, int cu, int h, LAS unsigned char* lds, int tid, int wave, int lane) {
    const bool is_sample = cu >= 256; const int cl = is_sample ? 0 : (cu & 15), c = is_sample ? 0 : 16 * g + cl; const int lr0 = 64 * cu;
    const int bseq = is_sample ? (cu - 256) : (cu >> 4);
    const bf16* PROJ = (const bf16*)(p.ws + WS_BIG); bf16* HALO = (bf16*)(p.ws + WS_HALO);
    unsigned char* ex = p.ws + WS_EX + (size_t)(cu * 8 + h) * EX_ITEM;
    LAS float* GS = (LAS float*)(lds + PL_GS);
    const int fr = lane & 15, fq = lane >> 4;
    const int r = tid >> 3, ch0 = (tid & 7) * 16;
    u32x4 raw[3][4][2];
#pragma unroll
    for (int arr = 0; arr < 3; ++arr)
#pragma unroll
        for (int i = 0; i < 4; ++i) {
            const int rr = r - 3 + i, col = arr * 1024 + h * 128 + ch0;
            if (rr >= 0 || cl > 0) { const bf16* src = PROJ + (size_t)(lr0 + rr) * NPROJ + col; raw[arr][i][0] = *(const u32x4*)src; raw[arr][i][1] = *(const u32x4*)(src + 8); }
            else if (!is_sample && g == 1) { const bf16* src = HALO + ((size_t)bseq * 3 + (3 + rr)) * 3072 + col; raw[arr][i][0] = *(const u32x4*)src; raw[arr][i][1] = *(const u32x4*)(src + 8); }
            else if (is_sample) { const float* src = p.state_conv + ((size_t)bseq * 3 + (3 + rr)) * 3072 + col; float t[8];
#pragma unroll
                for (int hh = 0; hh < 2; ++hh) { const f32x4 t0 = *(const f32x4*)(src + 8 * hh), t1 = *(const f32x4*)(src + 8 * hh + 4);
#pragma unroll
                    for (int j = 0; j < 4; ++j) { t[j] = t0[j]; t[4 + j] = t1[j]; }
                    raw[arr][i][hh] = pack8(t); }
            } else { raw[arr][i][0] = (u32x4){0u, 0u, 0u, 0u}; raw[arr][i][1] = (u32x4){0u, 0u, 0u, 0u}; }
        }
    {
        const float* GB = (const float*)(p.ws + WS_GB) + (size_t)(lr0 + lane) * 16;
        float gv = GB[h]; const float bt = GB[8 + h];
#pragma unroll
        for (int o = 1; o < 64; o <<= 1) { const float t = __shfl_up(gv, o); if (lane >= o) gv += t; }
        GS[lane] = gv; GS[64 + lane] = bt;
    }
    {
        const float Gr = GS[r], Gl = GS[63], br = GS[64 + r];
        const int tsw = (((r >> 3) ^ (tid & 7)) << 4) + (r & 7) * 2;
        const float eg = __expf(Gr), egl = __expf(Gl - Gr);
        const bool lastc = is_sample || c == 31;
#pragma unroll
        for (int arr = 0; arr < 3; ++arr) {
            const int col = arr * 1024 + h * 128 + ch0;
            float acc[16];
#pragma unroll
            for (int j = 0; j < 16; ++j) acc[j] = 0.f;
#pragma unroll
            for (int i = 0; i < 4; ++i) {
                float x[16]; { float t[8]; unpack8(raw[arr][i][0], t);
#pragma unroll
                    for (int j = 0; j < 8; ++j) x[j] = t[j];
                    unpack8(raw[arr][i][1], t);
#pragma unroll
                    for (int j = 0; j < 8; ++j) x[8 + j] = t[j]; }
                const LAS float* wsrc = (const LAS float*)(lds + PL_CW) + (i * 3 + arr) * 128 + ch0;
#pragma unroll
                for (int j4 = 0; j4 < 4; ++j4) { const f32x4 w = *(const LAS f32x4*)(wsrc + 4 * j4);
#pragma unroll
                    for (int e = 0; e < 4; ++e) acc[4 * j4 + e] += x[4 * j4 + e] * w[e]; }
                if (i == 3 && g == 0 && !is_sample && cl == 15 && r >= 61) {
                    bf16* hd = HALO + ((size_t)bseq * 3 + (r - 61)) * 3072 + col; *(u32x4*)hd = raw[arr][3][0]; *(u32x4*)(hd + 8) = raw[arr][3][1]; }
                if (i == 3 && lastc && r >= 61) {
                    float* o = p.out + (is_sample ? O_CONVS : O_CONVP) + ((size_t)bseq * 3 + (r - 61)) * 3072 + col;
#pragma unroll
                    for (int j4 = 0; j4 < 4; ++j4) *(f32x4*)(o + 4 * j4) = (f32x4){x[4 * j4], x[4 * j4 + 1], x[4 * j4 + 2], x[4 * j4 + 3]};
                }
            }
            float ss = 0.f;
#pragma unroll
            for (int j = 0; j < 16; ++j) { acc[j] = siluf_(acc[j]); ss += acc[j] * acc[j]; }
            if (arr < 2) { ss += __shfl_xor(ss, 1); ss += __shfl_xor(ss, 2); ss += __shfl_xor(ss, 4);
                const float sc = rsqrtf(ss + EPS) * (arr == 0 ? 0.08838834764831845f : 1.f);
#pragma unroll
                for (int j = 0; j < 16; ++j) acc[j] *= sc; }
            if (arr == 0) {
                float t[8];
#pragma unroll
                for (int hh = 0; hh < 2; ++hh) {
#pragma unroll
                    for (int j = 0; j < 8; ++j) t[j] = acc[8 * hh + j];
                    *(LAS u32x4*)(lds + PL_QL + r * 272 + (ch0 + 8 * hh) * 2) = pack8(t);
#pragma unroll
                    for (int j = 0; j < 8; ++j) t[j] = acc[8 * hh + j] * eg;
                    *(u32x4*)(ex + EX_QD + r * 256 + (ch0 + 8 * hh) * 2) = pack8(t);
                }
            } else if (arr == 1) {
                float t[8];
#pragma unroll
                for (int hh = 0; hh < 2; ++hh) {
#pragma unroll
                    for (int j = 0; j < 8; ++j) t[j] = acc[8 * hh + j];
                    *(LAS u32x4*)(lds + PL_KL + r * 272 + (ch0 + 8 * hh) * 2) = pack8(t);
                }
                const float wsc = br * eg;
#pragma unroll
                for (int j = 0; j < 16; ++j) {
                    *(LAS unsigned short*)(lds + PL_KDT + (ch0 + j) * 144 + tsw) = f2bf(acc[j] * egl);
                    *(LAS unsigned short*)(lds + PL_RT + (128 + ch0 + j) * 144 + tsw) = f2bf(acc[j] * wsc);
                }
            } else {
#pragma unroll
                for (int j = 0; j < 16; ++j) *(LAS unsigned short*)(lds + PL_RT + (ch0 + j) * 144 + tsw) = f2bf(acc[j] * br);
            }
            __builtin_amdgcn_sched_barrier(0);
        }
    }
    __syncthreads();
    {
#pragma unroll
        for (int n = 0; n < 4; ++n) {
            const int job = wave * 4 + n, typ = job >> 4, t = job & 15, ib = t >> 2, jb = t & 3;
            if (jb > ib) continue;
            f32x4 acc = (f32x4){0.f, 0.f, 0.f, 0.f};
            if (typ == 0) {
#pragma unroll
                for (int ks = 0; ks < 4; ++ks) { const bf16x8 a = lds_frag16(lds + PL_KL + (16 * ib + fr) * 272 + (32 * ks + 8 * fq) * 2), b = lds_frag16(lds + PL_KL + (16 * jb + fr) * 272 + (32 * ks + 8 * fq) * 2);
                    acc = MFMA16(a, b, acc); }
                const int j = 16 * jb + fr; const float Gj = GS[j];
#pragma unroll
                for (int e = 0; e < 4; ++e) { const int i = 16 * ib + 4 * fq + e; const float v = (j < i) ? GS[64 + i] * acc[e] * __expf(GS[i] - Gj) : 0.f; *(LAS float*)(lds + PL_AM + (i * 65 + j) * 4) = v; }
            } else {
#pragma unroll
                for (int ks = 0; ks < 4; ++ks) { const bf16x8 a = lds_frag16(lds + PL_KL + (16 * jb + fr) * 272 + (32 * ks + 8 * fq) * 2), b = lds_frag16(lds + PL_QL + (16 * ib + fr) * 272 + (32 * ks + 8 * fq) * 2);
                    acc = MFMA16(a, b, acc); }
                const int i = 16 * ib + fr; const float Gi = GS[i]; float v[4];
#pragma unroll
                for (int e = 0; e < 4; ++e) { const int j = 16 * jb + 4 * fq + e; v[e] = (j <= i) ? acc[e] * __expf(Gi - GS[j]) : 0.f; }
                u32x2 o; o.x = cvt_pk_bf16(v[0], v[1]); o.y = cvt_pk_bf16(v[2], v[3]);
                *(LAS u32x2*)(lds + PL_QKS + i * 144 + (16 * jb + 4 * fq) * 2) = o;
            }
        }
#pragma unroll
        for (int n = 0; n < 4; ++n) {
            const int job = wave * 4 + n, typ = job >> 4, t = job & 15, ib = t >> 2, jb = t & 3;
            if (jb <= ib) continue;
            if (typ == 0) { } else { u32x2 o; o.x = 0u; o.y = 0u; *(LAS u32x2*)(lds + PL_QKS + (16 * ib + fr) * 144 + (16 * jb + 4 * fq) * 2) = o; }
        }
    }
    __syncthreads();
    {
        const LAS float* AMf = (const LAS float*)(lds + PL_AM); LAS float* TMf = (LAS float*)(lds + PL_TM);
        if (wave < 4) {
            const int b0 = 16 * wave; float t[16];
            const LAS float* arow = AMf + b0 * 65 + b0;
#pragma unroll
            for (int i = 0; i < 16; ++i) {
                float sacc_ = fmaxf(1.f - fabsf((float)fr - (float)i), 0.f);
#pragma unroll
                for (int j = 0; j < i; ++j) sacc_ -= arow[i * 65 + j] * t[j];
                t[i] = sacc_;
                if (fq == 0) TMf[(b0 + i) * 65 + b0 + fr] = sacc_;
            }
        } else {
            if (wave == 7 && lane == 0) ((float*)(p.ws + WS_DL))[cu * 8 + h] = __expf(GS[63]);
            const int t2 = tid - 256;
#pragma unroll
            for (int k = 0; k < 4; ++k) { const int idx = t2 + 256 * k, d = idx >> 3, c8 = idx & 7;
                *(u32x4*)(ex + EX_KDT + d * 128 + c8 * 16) = *(const LAS u32x4*)(lds + PL_KDT + d * 144 + ((c8 ^ ((d >> 4) & 7)) << 4)); }
#pragma unroll
            for (int k = 0; k < 2; ++k) { const int idx = t2 + 256 * k;
                *(u32x4*)(ex + EX_QK + (idx >> 3) * 128 + (idx & 7) * 16) = *(const LAS u32x4*)(lds + PL_QKS + (idx >> 3) * 144 + (idx & 7) * 16); }
        }
        __syncthreads();
#pragma unroll
        for (int dd = 1; dd < 4; ++dd) {
            if (wave < 4 - dd) {
                const int J = wave, I = wave + dd;
                f32x4 c4 = (f32x4){0.f, 0.f, 0.f, 0.f};
#pragma unroll
                for (int kk = 0; kk < dd; ++kk) { const int K = J + kk;
#pragma unroll
                    for (int k0 = 0; k0 < 16; k0 += 4) { const float a = AMf[(16 * I + fr) * 65 + 16 * K + k0 + fq], b = TMf[(16 * K + k0 + fq) * 65 + 16 * J + fr];
                        c4 = __builtin_amdgcn_mfma_f32_16x16x4f32(a, b, c4, 0, 0, 0); } }
                f32x4 r4 = (f32x4){0.f, 0.f, 0.f, 0.f};
#pragma unroll
                for (int s4 = 0; s4 < 4; ++s4) { const float a = TMf[(16 * I + fr) * 65 + 16 * I + 4 * fq + s4]; r4 = __builtin_amdgcn_mfma_f32_16x16x4f32(a, c4[s4], r4, 0, 0, 0); }
#pragma unroll
                for (int j = 0; j < 4; ++j) TMf[(16 * I + 4 * fq + j) * 65 + 16 * J + fr] = -r4[j];
            }
            __syncthreads();
        }
        {   const int i = tid >> 3, j0 = (tid & 7) * 8; float v[8];
#pragma unroll
            for (int jj = 0; jj < 8; ++jj) v[jj] = ((j0 >> 4) > (i >> 4)) ? 0.f : TMf[i * 65 + j0 + jj];
            *(LAS u32x4*)(lds + PL_TB + i * 144 + j0 * 2) = pack8(v); }
    }
    __syncthreads();
    {
#pragma unroll
        for (int mb = 0; mb < 4; ++mb) {
            f32x4 au = (f32x4){0.f, 0.f, 0.f, 0.f}, aw = (f32x4){0.f, 0.f, 0.f, 0.f};
#pragma unroll
            for (int ks = 0; ks < 2; ++ks) {
                const bf16x8 tf = lds_frag16(lds + PL_TB + (16 * mb + fr) * 144 + (32 * ks + 8 * fq) * 2);
                const bf16x8 rv = lds_frag16(lds + PL_RT + (16 * wave + fr) * 144 + (((4 * ks + fq) ^ wave) << 4));
                const bf16x8 rk = lds_frag16(lds + PL_RT + (128 + 16 * wave + fr) * 144 + (((4 * ks + fq) ^ wave) << 4));
                au = MFMA16(tf, rv, au);
                aw = MFMA16(rk, tf, aw);
            }
            u32x2 o; o.x = cvt_pk_bf16(au[0], au[1]); o.y = cvt_pk_bf16(au[2], au[3]);
            *(LAS u32x2*)(lds + PL_UTS + (16 * wave + fr) * 144 + (16 * mb + 4 * fq) * 2) = o;
            o.x = cvt_pk_bf16(-aw[0], -aw[1]); o.y = cvt_pk_bf16(-aw[2], -aw[3]);
            *(LAS u32x2*)(lds + PL_WNS + (16 * mb + fr) * 272 + (16 * wave + 4 * fq) * 2) = o;
        }
    }
    __syncthreads();
    {
#pragma unroll
        for (int k = 0; k < 2; ++k) { const int idx = tid + 512 * k;
            *(u32x4*)(ex + EX_UT + (idx >> 3) * 128 + (idx & 7) * 16) = *(const LAS u32x4*)(lds + PL_UTS + (idx >> 3) * 144 + (idx & 7) * 16);
            *(u32x4*)(ex + EX_WN + (idx >> 4) * 256 + (idx & 15) * 16) = *(const LAS u32x4*)(lds + PL_WNS + (idx >> 4) * 272 + (idx & 15) * 16); }
    }
    __syncthreads();
}

constexpr int SL_K = 0, SL_V = 27648;
__device__ __forceinline__ void swa_item(const Params& p, int g, int cu, int kvh, LAS unsigned char* lds, int tid, int wave, int lane) {
    const bool is_sample = cu >= 256; const int cl = is_sample ? 0 : (cu & 15), c = is_sample ? 0 : 16 * g + cl; const int lr0 = 64 * cu;
    const int bseq = is_sample ? (cu - 256) : (cu >> 4);
    const int nkc = is_sample ? 3 : (c < 2 ? c + 1 : 3);
    bf16* PROJ = (bf16*)(p.ws + WS_BIG); bf16* KVT = (bf16*)(p.ws + WS_KVT);
    const int fr = lane & 15, fq = lane >> 4;
    const int hq = kvh * 4 + (wave >> 1), t0 = 32 * (wave & 1);
    u32x4 qr[2][2];
#pragma unroll
    for (int mb = 0; mb < 2; ++mb) { const bf16* qsrc = PROJ + (size_t)(lr0 + t0 + 16 * mb + fr) * NPROJ + PC_QS + hq * 64 + 8 * fq; qr[mb][0] = *(const u32x4*)qsrc; qr[mb][1] = *(const u32x4*)(qsrc + 32); }
    const f32x4 qn00 = *(const f32x4*)(p.q_norm + 8 * fq), qn01 = *(const f32x4*)(p.q_norm + 8 * fq + 4), qn10 = *(const f32x4*)(p.q_norm + 32 + 8 * fq), qn11 = *(const f32x4*)(p.q_norm + 32 + 8 * fq + 4);
    const float sink = p.sinks[hq];
    {
        const int row = tid >> 3, d8 = tid & 7;
        const f32x4 kn0 = *(const f32x4*)(p.k_norm + d8 * 8), kn1 = *(const f32x4*)(p.k_norm + d8 * 8 + 4);
        u32x4 kr[3], vr[3]; f32x4 ck[2][2], cv[2][2];
#pragma unroll
        for (int s = 0; s < 3; ++s) {
            if (s >= nkc) continue;
            if (is_sample && s < 2) {
                const size_t off = (((size_t)bseq * 128 + 64 * s + row) * 4 + kvh) * 64 + d8 * 8;
                ck[s][0] = *(const f32x4*)(p.cache_k + off); ck[s][1] = *(const f32x4*)(p.cache_k + off + 4); cv[s][0] = *(const f32x4*)(p.cache_v + off); cv[s][1] = *(const f32x4*)(p.cache_v + off + 4);
            } else if (!is_sample && cl - (nkc - 1 - s) < 0) {
                const bf16* src = KVT + ((size_t)bseq * 128 + 64 * (cl - (nkc - 1 - s) + 2) + row) * 512 + kvh * 64 + d8 * 8; kr[s] = *(const u32x4*)src; vr[s] = *(const u32x4*)(src + 256);
            } else {
                const int lrk = lr0 - 64 * (nkc - 1 - s) + row;
                kr[s] = *(const u32x4*)(PROJ + (size_t)lrk * NPROJ + PC_KS + kvh * 64 + d8 * 8); vr[s] = *(const u32x4*)(PROJ + (size_t)lrk * NPROJ + PC_VS + kvh * 64 + d8 * 8);
            }
        }
#pragma unroll
        for (int s = 0; s < 3; ++s) {
            if (s >= nkc) continue;
            float kv[8], vv[8];
            if (is_sample && s < 2) {
                if (s < 2) {
#pragma unroll
                    for (int j = 0; j < 4; ++j) { kv[j] = ck[s < 2 ? s : 0][0][j]; kv[4 + j] = ck[s < 2 ? s : 0][1][j]; vv[j] = cv[s < 2 ? s : 0][0][j]; vv[4 + j] = cv[s < 2 ? s : 0][1][j]; }
                }
                if (s == 1) { const size_t oo = (((size_t)bseq * 128 + row) * 4 + kvh) * 64 + d8 * 8;
                    *(f32x4*)(p.out + O_KS + oo) = ck[1][0]; *(f32x4*)(p.out + O_KS + oo + 4) = ck[1][1]; *(f32x4*)(p.out + O_VS + oo) = cv[1][0]; *(f32x4*)(p.out + O_VS + oo + 4) = cv[1][1]; }
            } else if (!is_sample && cl - (nkc - 1 - s) < 0) {
                unpack8(kr[s], kv); unpack8(vr[s], vv);
            } else {
                unpack8(kr[s], kv); unpack8(vr[s], vv);
                float ss = 0.f;
#pragma unroll
                for (int j = 0; j < 8; ++j) ss += kv[j] * kv[j];
                ss += __shfl_xor(ss, 1); ss += __shfl_xor(ss, 2); ss += __shfl_xor(ss, 4);
                const float sc = rsqrtf(ss * (1.f / 64.f) + EPS);
#pragma unroll
                for (int j = 0; j < 4; ++j) { kv[j] *= sc * kn0[j]; kv[4 + j] *= sc * kn1[j]; }
                if (s == nkc - 1 && !is_sample && g == 0 && cl >= 14) {
                    bf16* dst = KVT + ((size_t)bseq * 128 + 64 * (cl - 14) + row) * 512 + kvh * 64 + d8 * 8; *(u32x4*)dst = pack8(kv); *(u32x4*)(dst + 256) = pack8(vv); }
                if (s == nkc - 1 && (is_sample || c >= 30)) {
                    const int orow = is_sample ? 64 + row : 64 * (c - 30) + row;
                    const size_t oo = (((size_t)bseq * 128 + orow) * 4 + kvh) * 64 + d8 * 8;
                    float* ok = p.out + (is_sample ? O_KS : O_KP) + oo; float* ov = p.out + (is_sample ? O_VS : O_VP) + oo;
                    *(f32x4*)ok = (f32x4){kv[0], kv[1], kv[2], kv[3]}; *(f32x4*)(ok + 4) = (f32x4){kv[4], kv[5], kv[6], kv[7]};
                    *(f32x4*)ov = (f32x4){vv[0], vv[1], vv[2], vv[3]}; *(f32x4*)(ov + 4) = (f32x4){vv[4], vv[5], vv[6], vv[7]};
                }
            }
            const int key = 64 * s + row;
            *(LAS u32x4*)(lds + SL_K + key * 144 + d8 * 16) = pack8(kv);
#pragma unroll
            for (int j = 0; j < 8; ++j) *(LAS unsigned short*)(lds + SL_V + (d8 * 8 + j) * 392 + key * 2) = f2bf(vv[j]);
        }
    }
    __syncthreads();
    bf16x8 qf[2][2];
#pragma unroll
    for (int mb = 0; mb < 2; ++mb) {
        float q0[8], q1[8]; unpack8(qr[mb][0], q0); unpack8(qr[mb][1], q1);
        float ss = 0.f;
#pragma unroll
        for (int j = 0; j < 8; ++j) ss += q0[j] * q0[j] + q1[j] * q1[j];
        ss += __shfl_xor(ss, 16); ss += __shfl_xor(ss, 32);
        const float sc = rsqrtf(ss * (1.f / 64.f) + EPS) * 0.125f;
#pragma unroll
        for (int j = 0; j < 4; ++j) { q0[j] *= sc * qn00[j]; q0[4 + j] *= sc * qn01[j]; q1[j] *= sc * qn10[j]; q1[4 + j] *= sc * qn11[j]; }
        qf[mb][0] = as_bf16x8(pack8(q0)); qf[mb][1] = as_bf16x8(pack8(q1));
    }
    f32x4 sacc[12][2];
#pragma unroll
    for (int nb = 0; nb < 12; ++nb) {
#pragma unroll
        for (int mb = 0; mb < 2; ++mb) sacc[nb][mb] = (f32x4){0.f, 0.f, 0.f, 0.f};
        if (nb < 4 * nkc) {
#pragma unroll
            for (int ks = 0; ks < 2; ++ks) { const bf16x8 a = lds_frag16(lds + SL_K + (16 * nb + fr) * 144 + (32 * ks + 8 * fq) * 2);
#pragma unroll
                for (int mb = 0; mb < 2; ++mb) sacc[nb][mb] = MFMA16(a, qf[mb][ks], sacc[nb][mb]); }
        }
    }
    float inv[2];
#pragma unroll
    for (int mb = 0; mb < 2; ++mb) {
        float mx = sink;
#pragma unroll
        for (int nb = 0; nb < 12; ++nb) if (nb < 4 * nkc) {
#pragma unroll
            for (int e = 0; e < 4; ++e) mx = fmaxf(mx, sacc[nb][mb][e]); }
        mx = fmaxf(mx, __shfl_xor(mx, 16)); mx = fmaxf(mx, __shfl_xor(mx, 32));
        float sum = 0.f;
#pragma unroll
        for (int nb = 0; nb < 12; ++nb) {
#pragma unroll
            for (int e = 0; e < 4; ++e) { const float pv = (nb < 4 * nkc) ? __expf(sacc[nb][mb][e] - mx) : 0.f; sacc[nb][mb][e] = pv; sum += pv; } }
        sum += __shfl_xor(sum, 16); sum += __shfl_xor(sum, 32);
        inv[mb] = 1.f / (sum + __expf(sink - mx));
    }
    f32x4 oacc[4][2];
#pragma unroll
    for (int db = 0; db < 4; ++db)
#pragma unroll
        for (int mb = 0; mb < 2; ++mb) oacc[db][mb] = (f32x4){0.f, 0.f, 0.f, 0.f};
#pragma unroll
    for (int ks2 = 0; ks2 < 6; ++ks2) {
        if (ks2 < 2 * nkc) {
            bf16x8 bp[2];
#pragma unroll
            for (int mb = 0; mb < 2; ++mb) bp[mb] = pack_acc2(sacc[2 * ks2][mb], sacc[2 * ks2 + 1][mb]);
#pragma unroll
            for (int db = 0; db < 4; ++db) {
                const LAS unsigned char* vb = lds + SL_V + (16 * db + fr) * 392 + (32 * ks2 + 4 * fq) * 2;
                const bf16x8 a = lds_frag8x2(vb, vb + 32);
#pragma unroll
                for (int mb = 0; mb < 2; ++mb) oacc[db][mb] = MFMA16(a, bp[mb], oacc[db][mb]);
            }
        }
    }
#pragma unroll
    for (int mb = 0; mb < 2; ++mb) {
        bf16* od = PROJ + (size_t)(lr0 + t0 + 16 * mb + fr) * NPROJ + PC_QS + hq * 64 + 4 * fq;
#pragma unroll
        for (int db = 0; db < 4; ++db) { const f32x4 v = oacc[db][mb] * inv[mb]; u32x2 o; o.x = cvt_pk_bf16(v[0], v[1]); o.y = cvt_pk_bf16(v[2], v[3]); *(u32x2*)(od + 16 * db) = o; }
    }
    __syncthreads();
}

constexpr int CL_WN = 0, CL_QD = 17408, CL_UT = 34816, CL_KDT = 52224, CL_QK = 69632, CL_OT = 78336, CL_SSQ = 112128, CL_DL = 114176, CL_PR = 114304;
__device__ __forceinline__ void scan_chain(const Params& p, int g, int s, int h, LAS unsigned char* lds, int tid, int wave, int lane) {
    const bool is_sample = s >= 16; const int nsteps = is_sample ? 1 : 16; const int cu0 = is_sample ? 256 + (s - 16) : 16 * s;
    const int bseq = is_sample ? (s - 16) : s;
    const int fr = lane & 15, fq = lane >> 4;
    bf16* PROJ = (bf16*)(p.ws + WS_BIG);
    const float* DL = (const float*)(p.ws + WS_DL);
    f32x4 sacc[8];
    const int e = 16 * wave + fr;
    if (is_sample || g == 1) { const float* S0 = (is_sample ? p.state_gdn : p.out + O_GDNP) + ((size_t)bseq * 8 + h) * 16384;
#pragma unroll
        for (int db = 0; db < 8; ++db) { const float* pb = S0 + (4 * fq) * 128 + e + db * 2048; asm volatile("" : "+v"(pb));
#pragma unroll
            for (int j = 0; j < 4; ++j) sacc[db][j] = pb[j * 128]; }
    } else {
#pragma unroll
        for (int db = 0; db < 8; ++db) sacc[db] = (f32x4){0.f, 0.f, 0.f, 0.f};
    }
    u32x4 pf[9];
    const unsigned char* exb = p.ws + WS_EX + (size_t)(cu0 * 8 + h) * EX_ITEM;
#define SCAN_LOAD(ptr) do { _Pragma("unroll") for (int k = 0; k < 9; ++k) pf[k] = *(const u32x4*)((ptr) + (size_t)(tid + 512 * k) * 16); } while (0)
#define SCAN_STORE() do { _Pragma("unroll") for (int k = 0; k < 9; ++k) { const int off = (tid + 512 * k) * 16, wi = off & 16383; \
        if (k == 2 || k == 3) *(LAS u32x4*)(lds + CL_WN + (wi >> 8) * 272 + (wi & 255)) = pf[k]; \
        else if (k == 4 || k == 5) *(LAS u32x4*)(lds + CL_QD + (wi >> 8) * 272 + (wi & 255)) = pf[k]; \
        else { const int base = (k < 2) ? CL_UT : (k < 8 ? CL_KDT : CL_QK); LAS unsigned char* d = lds + base + (wi >> 7) * 136 + (wi & 127); \
            u32x2 lo, hi; lo.x = pf[k].x; lo.y = pf[k].y; hi.x = pf[k].z; hi.y = pf[k].w; *(LAS u32x2*)d = lo; *(LAS u32x2*)(d + 8) = hi; } } } while (0)
    SCAN_LOAD(exb); SCAN_STORE();
    if (tid < nsteps) *(LAS float*)(lds + CL_DL + tid * 4) = DL[(cu0 + tid) * 8 + h];
    if (tid < 384) { const int w3 = tid >> 7, cc = tid & 127; *(LAS float*)(lds + CL_PR + tid * 4) = w3 == 0 ? p.gdn_norm[cc] : p.b_merge[(w3 - 1) * 1024 + h * 128 + cc]; }
    __syncthreads();
    u32x4 mg[4][2];
#define SCAN_MG(cu_) do { const bf16* prow = PROJ + (size_t)(64 * (cu_) + (tid >> 3)) * NPROJ + h * 128 + (tid & 7) * 16; _Pragma("unroll") for (int hh = 0; hh < 2; ++hh) { \
        mg[0][hh] = *(const u32x4*)(prow + PC_Z + 8 * hh); mg[1][hh] = *(const u32x4*)(prow + PC_GA + 8 * hh); mg[2][hh] = *(const u32x4*)(prow + PC_GB + 8 * hh); mg[3][hh] = *(const u32x4*)(prow + PC_QS + 8 * hh); } } while (0)
    SCAN_MG(cu0);
    if (nsteps > 1) SCAN_LOAD(exb + (size_t)8 * EX_ITEM);
    for (int st = 0; st < nsteps; ++st) {
        const int cu = cu0 + st, lr0 = 64 * cu;
        const float dl = *(const LAS float*)(lds + CL_DL + st * 4);
        bf16x8 Bs[4];
#pragma unroll
        for (int ks = 0; ks < 4; ++ks) Bs[ks] = pack_acc2(sacc[2 * ks], sacc[2 * ks + 1]);
        f32x4 vacc[4], oacc[4];
        bf16x8 FA[4], FB[4];
#define LD_W(F, mb) do { _Pragma("unroll") for (int ks = 0; ks < 4; ++ks) { const LAS unsigned char* wb = lds + CL_WN + (16 * (mb) + fr) * 272 + (32 * ks + 4 * fq) * 2; F[ks] = lds_frag8x2(wb, wb + 32); } } while (0)
#define LD_Q(F, mb) do { _Pragma("unroll") for (int ks = 0; ks < 4; ++ks) { const LAS unsigned char* qb = lds + CL_QD + (16 * (mb) + fr) * 272 + (32 * ks + 4 * fq) * 2; F[ks] = lds_frag8x2(qb, qb + 32); } } while (0)
#define LD_QK(F, m0) do { _Pragma("unroll") for (int mb = 0; mb < 2; ++mb) _Pragma("unroll") for (int k2 = 0; k2 < 2; ++k2) { \
            const LAS unsigned char* kb = lds + CL_QK + (16 * ((m0) + mb) + fr) * 136 + (32 * k2 + 4 * fq) * 2; F[2 * mb + k2] = lds_frag8x2(kb, kb + 32); } } while (0)
#define LD_KD(F, d0) do { _Pragma("unroll") for (int d = 0; d < 2; ++d) _Pragma("unroll") for (int k2 = 0; k2 < 2; ++k2) { \
            const LAS unsigned char* kb = lds + CL_KDT + (16 * ((d0) + d) + fr) * 136 + (32 * k2 + 4 * fq) * 2; F[2 * d + k2] = lds_frag8x2(kb, kb + 32); } } while (0)
#define MM_W(F, mb) do { _Pragma("unroll") for (int ks = 0; ks < 4; ++ks) vacc[mb] = MFMA16(F[ks], Bs[ks], vacc[mb]); } while (0)
#define MM_Q(F, mb) do { _Pragma("unroll") for (int ks = 0; ks < 4; ++ks) oacc[mb] = MFMA16(F[ks], Bs[ks], oacc[mb]); } while (0)
#define MM_QK(F, m0) do { _Pragma("unroll") for (int mb = 0; mb < 2; ++mb) _Pragma("unroll") for (int k2 = 0; k2 < 2; ++k2) oacc[(m0) + mb] = MFMA16(F[2 * mb + k2], Bv[k2], oacc[(m0) + mb]); } while (0)
#define MM_KD(F, d0) do { _Pragma("unroll") for (int d = 0; d < 2; ++d) { sacc[(d0) + d] = sacc[(d0) + d] * dl; _Pragma("unroll") for (int k2 = 0; k2 < 2; ++k2) sacc[(d0) + d] = MFMA16(F[2 * d + k2], Bv[k2], sacc[(d0) + d]); } } while (0)
#define SB() __builtin_amdgcn_sched_barrier(0)
#pragma unroll
        for (int mb = 0; mb < 4; ++mb) {
            const u32x2 uu = *(const LAS u32x2*)(lds + CL_UT + e * 136 + (16 * mb + 4 * fq) * 2);
            vacc[mb] = (f32x4){bflo(uu.x), bfhi(uu.x), bflo(uu.y), bfhi(uu.y)};
            oacc[mb] = (f32x4){0.f, 0.f, 0.f, 0.f};
        }
        LD_W(FA, 0); SB();
        LD_W(FB, 1); MM_W(FA, 0); SB();
        LD_W(FA, 2); MM_W(FB, 1); SB();
        LD_W(FB, 3); MM_W(FA, 2); SB();
        LD_Q(FA, 0); MM_W(FB, 3); SB();
        LD_Q(FB, 1); MM_Q(FA, 0); SB();
        LD_Q(FA, 2); MM_Q(FB, 1); SB();
        LD_Q(FB, 3); MM_Q(FA, 2); SB();
        LD_QK(FA, 0); MM_Q(FB, 3); SB();
        bf16x8 Bv[2];
#pragma unroll
        for (int k2 = 0; k2 < 2; ++k2) Bv[k2] = pack_acc2(vacc[2 * k2], vacc[2 * k2 + 1]);
        LD_QK(FB, 2); MM_QK(FA, 0); SB();
        LD_KD(FA, 0); MM_QK(FB, 2); SB();
        LD_KD(FB, 2); MM_KD(FA, 0); SB();
        LD_KD(FA, 4); MM_KD(FB, 2); SB();
        LD_KD(FB, 6); MM_KD(FA, 4); SB();
        MM_KD(FB, 6);
#undef LD_W
#undef LD_Q
#undef MM_W
#undef MM_Q
#undef MM_QK
#undef MM_KD
#undef SB
#undef LD_QK
#undef LD_KD
        SEC(16);
#pragma unroll
        for (int mb = 0; mb < 4; ++mb)
#pragma unroll
            for (int j = 0; j < 4; ++j) *(LAS float*)(lds + CL_OT + ((16 * mb + 4 * fq + j) * 132 + e) * 4) = oacc[mb][j];
        __syncthreads();
        SEC(17);
        if (st + 1 < nsteps) { SCAN_STORE(); if (st + 2 < nsteps) SCAN_LOAD(exb + (size_t)(st + 2) * 8 * EX_ITEM); }
        {
            const int i = tid >> 3, c0 = (tid & 7) * 16;
            f32x4 ov[4]; float ssq = 0.f;
#pragma unroll
            for (int q4 = 0; q4 < 4; ++q4) { ov[q4] = *(const LAS f32x4*)(lds + CL_OT + (i * 132 + c0 + 4 * q4) * 4); ssq += (ov[q4][0] * ov[q4][0] + ov[q4][1] * ov[q4][1]) + (ov[q4][2] * ov[q4][2] + ov[q4][3] * ov[q4][3]); }
            ssq += __shfl_xor(ssq, 1); ssq += __shfl_xor(ssq, 2); ssq += __shfl_xor(ssq, 4);
            const float rstd = rsqrtf(ssq * (1.f / 128.f) + EPS);
            const LAS float* PR = (const LAS float*)(lds + CL_PR);
#pragma unroll
            for (int hh = 0; hh < 2; ++hh) {
                float z[8], ga[8], gb[8], os[8], r[8];
                unpack8(mg[0][hh], z); unpack8(mg[1][hh], ga); unpack8(mg[2][hh], gb); unpack8(mg[3][hh], os);
#pragma unroll
                for (int j = 0; j < 8; ++j) { const int cc = c0 + 8 * hh + j;
                    const float o = ov[2 * hh + (j >> 2)][j & 3] * rstd * PR[cc] * siluf_(z[j]);
                    r[j] = sigmoidf_(ga[j] + PR[128 + cc]) * o + sigmoidf_(gb[j] + PR[256 + cc]) * os[j]; }
                *(u32x4*)(PROJ + (size_t)(lr0 + i) * NPROJ + PC_Z + h * 128 + c0 + 8 * hh) = pack8(r);
            }
        }
        if (st + 1 < nsteps) SCAN_MG(cu + 1);
        __syncthreads();
        SEC(18);
    }
    {   float* So = p.out + (is_sample ? O_GDNS : O_GDNP) + ((size_t)bseq * 8 + h) * 16384;
#pragma unroll
        for (int db = 0; db < 8; ++db) { float* pb = So + (4 * fq) * 128 + e + db * 2048; asm volatile("" : "+v"(pb));
#pragma unroll
            for (int j = 0; j < 4; ++j) pb[j * 128] = sacc[db][j]; }
    }
#undef SCAN_LOAD
#undef SCAN_STORE
}
__global__ void __launch_bounds__(512, 2) mega_fwd(Params p) {
    extern __shared__ __attribute__((aligned(16))) unsigned char lds_raw[];
    if (threadIdx.x < 4) ((LAS unsigned*)((LAS unsigned char*)lds_raw + LDS_BARST))[threadIdx.x] = 0u;
    __syncthreads();
    const XcdBarrier xbar = xcd_barrier_post((unsigned*)(p.ws + WS_BAR), (volatile LAS unsigned*)((LAS unsigned char*)lds_raw + LDS_BARST));
    LAS unsigned char* lds = (LAS unsigned char*)lds_raw;
    const int G = gridDim.x;
    unsigned char* ws = p.ws;
    float* MOD = (float*)(ws + WS_MOD);
    bf16* H = (bf16*)(ws + WS_H); bf16* ACT = (bf16*)(ws + WS_BIG); bf16* PROJ = (bf16*)(ws + WS_BIG);
    float* Y = p.out + O_Y;

    enum { K_P0, K_MOD, K_SWIGLU, K_RES, K_PROJ, K_MIX, K_SCAN };
#pragma nounroll
    for (int ph = 0; ph < 17; ++ph) {
        int tid_ = threadIdx.x; asm volatile("" : "+v"(tid_));
        const int tid = tid_, lane = tid & 63, wave = __builtin_amdgcn_readfirstlane(tid >> 6);
        int bx_ = blockIdx.x; asm volatile("" : "+s"(bx_)); const int bx = bx_;
        int kind, g = -1, ffn = 0;
        if (ph == 0) kind = K_P0;
        else if (ph <= 3) { kind = ph == 1 ? K_MOD : (ph == 2 ? K_SWIGLU : K_RES); }
        else if (ph <= 13) { const int q = ph - 4; g = q / 5; const int r = q - 5 * g; kind = r == 0 ? K_MOD : (r == 1 ? K_PROJ : (r == 2 ? K_MIX : (r == 3 ? K_SCAN : K_RES))); }
        else { ffn = 1; kind = ph == 14 ? K_MOD : (ph == 15 ? K_SWIGLU : K_RES); }
        const bool first = (ph <= 3);
        switch (kind) {
        case K_P0: p0_phase(p, lds, tid, wave, lane); break;
        case K_MOD: {
            const float* xp = first ? p.x_prompt : Y; const float* xs = first ? p.x_sample : Y + (size_t)NPROMPT * D;
            const float* gain = g >= 0 ? p.norm_mix : (ffn ? p.norm_ffn2 : p.norm_ffn1);
            mod_phase(p, g >= 0, xp, xs, gain, g >= 0 ? 3072 : (ffn ? 6144 : 0), H, g, g >= 0 ? grows_of(g) : NROWS, lds, tid, wave, lane);
        } break;
        case K_SWIGLU: { pg8::Gemm gm{H, (const bf16*)(ws + (ffn ? WS_W2IN : WS_W1IN)), NROWS, 2 * FF, D, D, D, 128, 512 * D}; pg8::StaticOrder S; S.init(NROWS, 2 * FF, G, bx); EpiSwiglu E{ACT};
            pg8::gemm_phase<EpiSwiglu, pg8::StaticOrder, true, true>(lds, gm, S, E, tid); } break;
        case K_RES: {
            const float* xp = first ? p.x_prompt : Y; const float* xs = first ? p.x_sample : Y + (size_t)NPROMPT * D;
            pg8::Gemm gm; EpiRes E{xp, xs, Y, MOD, 0, 0.5f, g};
            if (g >= 0) { gm = pg8::Gemm{PROJ + PC_Z, (const bf16*)(ws + WS_WOUT), grows_of(g), D, D, NPROJ, D, 128, 512 * NPROJ}; E.goff = 5120; E.gscale = 1.0f; }
            else { gm = pg8::Gemm{ACT, (const bf16*)(ws + (ffn ? WS_W2OUT : WS_W1OUT)), NROWS, D, FF, 64, FF, 32768, 44 * 32768};   E.goff = ffn ? 8192 : 2048; }
            pg8::StaticOrder S; S.init(gm.M, gm.N, G, bx);
            pg8::gemm_phase<EpiRes, pg8::StaticOrder, true, true>(lds, gm, S, E, tid); } break;
        case K_PROJ: { pg8::Gemm gm{H, (const bf16*)(ws + WS_WIN), grows_of(g), NPROJ, D, D, D, 128, 512 * D}; pg8::StaticOrder S; S.init(grows_of(g), NPROJ, G, bx); EpiBf16Plain E{PROJ, NPROJ};
            pg8::gemm_phase<EpiBf16Plain, pg8::StaticOrder, true, true>(lds, gm, S, E, tid); } break;
        case K_MIX:
            gdn_prep_stage_cw(p, bx & 7, lds, tid); __syncthreads();
#pragma nounroll
            for (int it = bx; it < ncu_of(g) * 8; it += G) { int t2 = tid; asm volatile("" : "+v"(t2)); gdn_prep_item(p, g, it >> 3, it & 7, lds, t2, __builtin_amdgcn_readfirstlane(t2 >> 6), t2 & 63); }
#pragma nounroll
            for (int it = (bx + 128) % G; it < ncu_of(g) * 4; it += G) { int t2 = tid; asm volatile("" : "+v"(t2)); swa_item(p, g, it >> 2, it & 3, lds, t2, __builtin_amdgcn_readfirstlane(t2 >> 6), t2 & 63); }
            break;
        default:
#pragma nounroll
            for (int ch = bx; ch < (g == 0 ? 384 : 128); ch += G) { int t2 = tid; asm volatile("" : "+v"(t2)); scan_chain(p, g, ch >> 3, ch & 7, lds, t2, __builtin_amdgcn_readfirstlane(t2 >> 6), t2 & 63); }
            break;
        }
        if (ph != 16) xcd_barrier(xbar);
    }
#ifdef EXTRA_SYNCS
    grid.sync(); grid.sync(); grid.sync(); grid.sync(); grid.sync(); grid.sync(); grid.sync(); grid.sync(); grid.sync(); grid.sync();
#endif
}

extern "C" void kernel_launch(void* const* d_in, const int* in_sizes, int n_in, void* d_out, int out_size, void* d_ws, size_t ws_size, hipStream_t stream) {
    static int grid_blocks = 0;
    if (grid_blocks == 0) {
        if (n_in != 27 || ws_size < WS_END) { fprintf(stderr, "kernel_launch: unexpected n_in %d / ws_size %zu (need %zu)\n", n_in, ws_size, (size_t)WS_END); grid_blocks = -1; return; }
        int dev = 0, cus = 0, per_cu = 0;
        (void)hipGetDevice(&dev); (void)hipDeviceGetAttribute(&cus, hipDeviceAttributeMultiprocessorCount, dev);
        (void)hipFuncSetAttribute((const void*)mega_fwd, hipFuncAttributeMaxDynamicSharedMemorySize, LDS_BYTES);
        (void)hipOccupancyMaxActiveBlocksPerMultiprocessor(&per_cu, (const void*)mega_fwd, 512, LDS_BYTES);
        if (per_cu < 1) { fprintf(stderr, "kernel_launch: occupancy query says %d blocks per CU; the in-kernel barriers need every workgroup resident: nothing launched\n", per_cu); grid_blocks = -1; return; }
        grid_blocks = cus;
    }
    if (grid_blocks < 0) return;
    if (hipMemsetAsync((char*)d_ws + WS_BAR, 0, 16384, stream) != hipSuccess) { fprintf(stderr, "kernel_launch: memset of the barrier words failed\n"); return; }
    Params p{};
    const float** pp = (const float**)&p;
    for (int i = 0; i < 27; ++i) pp[i] = (const float*)d_in[i];
    p.out = (float*)d_out; p.ws = (unsigned char*)d_ws;
    void* args[] = {&p};
    hipError_t e = hipLaunchCooperativeKernel((const void*)mega_fwd, dim3(grid_blocks), dim3(512), args, LDS_BYTES, stream);
    if (e != hipSuccess) fprintf(stderr, "cooperative launch failed: %s (grid %d)\n", hipGetErrorString(e), grid_blocks);
}
```
